# Optimizing an MI355X kernel written in HIP

```python
import jax
import jax.numpy as jnp
from jax import lax
import numpy as np

D_MODEL = 1024
BATCH = 2
SEQ = 8192
DEPTH = 4

GRID_W = 64
CTX_LEN = 256
HEAD_DIM = 64
BLOCK = 128
WINDOW = 128
ROPE_BASE = 10000.0
NORM_EPS = 1e-6
NEG_INF = -1e30

N_BRANCH = 4
BRANCH_WIDTH = 256

RW_HEADS = 4
RW_WIDTH = RW_HEADS * HEAD_DIM
RW_DECAY_LORA = 64
RW_AAA_LORA = 64
RW_MV_LORA = 32
RW_GATE_LORA = 128
RW_GN_EPS = 64e-5

SW_HEADS = 4
SW_KV_HEADS = 2

MLA_HEADS = 4
MLA_NOPE = 64
MLA_ROPE = 32
MLA_V = 64
MLA_Q_RANK = 256
MLA_KV_RANK = 128

GA_HEADS = 4
GA_KV_HEADS = 2

D_FF = 3584
N_EXPERTS = 8
TOP_K = 2
D_FF_EXPERT = 3584
MOE_BLOCK = 128

IN_WIDTHS = (4 * RW_WIDTH,
             SW_HEADS * HEAD_DIM, SW_KV_HEADS * HEAD_DIM, SW_KV_HEADS * HEAD_DIM,
             MLA_Q_RANK, MLA_KV_RANK, MLA_ROPE,
             GA_HEADS * HEAD_DIM, GA_KV_HEADS * HEAD_DIM, GA_KV_HEADS * HEAD_DIM,
             N_BRANCH * D_MODEL)
IN_WIDTH = (4 * RW_WIDTH + (SW_HEADS + 2 * SW_KV_HEADS) * HEAD_DIM
            + MLA_Q_RANK + MLA_KV_RANK + MLA_ROPE
            + (GA_HEADS + 2 * GA_KV_HEADS) * HEAD_DIM + N_BRANCH * D_MODEL)

kernel_name = 'hybrid_flow_backbone'


def rms_norm(x, g):
    xf = x.astype(jnp.float32)
    y = xf * lax.rsqrt(jnp.mean(xf * xf, axis=-1, keepdims=True) + NORM_EPS)
    return (y * g.astype(jnp.float32)).astype(x.dtype)


def split_cols(p, widths):
    out, off = [], 0
    for w in widths:
        out.append(p[..., off:off + w])
        off += w
    return out


def axial_rope_tables(n_tokens, rot_dim):
    rows = n_tokens // GRID_W
    row = jnp.repeat(jnp.arange(rows, dtype=jnp.float32), GRID_W)
    col = jnp.tile(jnp.arange(GRID_W, dtype=jnp.float32), rows)
    n_freq = rot_dim // 4
    inv_freq = ROPE_BASE ** (-jnp.arange(n_freq, dtype=jnp.float32) / n_freq)
    ang = jnp.concatenate([row[:, None] * inv_freq, col[:, None] * inv_freq], axis=-1)
    return jnp.cos(ang), jnp.sin(ang)


def apply_rope(x, cos, sin):
    half = x.shape[-1] // 2
    c = cos[None, :, None, :].astype(x.dtype)
    s = sin[None, :, None, :].astype(x.dtype)
    x1, x2 = x[..., :half], x[..., half:]
    return jnp.concatenate([x1 * c - x2 * s, x1 * s + x2 * c], axis=-1)


def context_attention(q, k, v, scale, sink=None):
    b, n = q.shape[:2]
    s = jnp.einsum('bqhgd,bkhd->bhgqk', q, k).astype(jnp.float32) * scale
    if sink is not None:
        s_sink = jnp.broadcast_to(sink[None, :, :, None, None].astype(jnp.float32), s.shape[:-1] + (1,))
        p = jax.nn.softmax(jnp.concatenate([s_sink, s], axis=-1), axis=-1)[..., 1:]
    else:
        p = jax.nn.softmax(s, axis=-1)
    o = jnp.einsum('bhgqk,bkhd->bqhgd', p.astype(v.dtype), v)
    return o.reshape(b, n, -1)


def banded_window_attention(q, k, v, k_ctx, v_ctx, sink, scale):
    b, s_len, hk, g, d = q.shape
    nb = s_len // BLOCK
    qb = q.reshape(b, nb, BLOCK, hk, g, d)

    def neighbours(t):
        tb = jnp.pad(t.reshape(b, nb, BLOCK, hk, t.shape[-1]), ((0, 0), (1, 1), (0, 0), (0, 0), (0, 0)))
        return jnp.concatenate([tb[:, :-2], tb[:, 1:-1], tb[:, 2:]], axis=2)

    kb, vb = neighbours(k), neighbours(v)
    blk = jnp.arange(nb)
    q_pos = blk[:, None] * BLOCK + jnp.arange(BLOCK)[None, :]
    k_pos = (blk[:, None] - 1) * BLOCK + jnp.arange(3 * BLOCK)[None, :]
    valid = ((jnp.abs(q_pos[:, :, None] - k_pos[:, None, :]) <= WINDOW)
             & (k_pos >= 0)[:, None, :] & (k_pos < s_len)[:, None, :])
    s_win = jnp.einsum('bnqhgd,bnkhd->bnhgqk', qb, kb).astype(jnp.float32) * scale
    s_win = jnp.where(valid[None, :, None, None], s_win, NEG_INF)
    s_ctx = jnp.einsum('bnqhgd,bchd->bnhgqc', qb, k_ctx).astype(jnp.float32) * scale
    s_sink = jnp.broadcast_to(sink[None, None, :, :, None, None].astype(jnp.float32), s_ctx.shape[:-1] + (1,))
    p = jax.nn.softmax(jnp.concatenate([s_sink, s_ctx, s_win], axis=-1), axis=-1).astype(v.dtype)
    n_ctx = k_ctx.shape[1]
    o = (jnp.einsum('bnhgqc,bchd->bnqhgd', p[..., 1:1 + n_ctx], v_ctx)
         + jnp.einsum('bnhgqk,bnkhd->bnqhgd', p[..., 1 + n_ctx:], vb))
    return o.reshape(b, s_len, -1)


def dense_block_attention(q, k, v, scale):
    b, s_len, hk, g, dq = q.shape
    nb = s_len // BLOCK
    qb = jnp.moveaxis(q.reshape(b, nb, BLOCK, hk, g, dq), 1, 0)

    def one_block(qblk):
        s = jnp.einsum('bqhgd,bkhd->bhgqk', qblk, k).astype(jnp.float32) * scale
        p = jax.nn.softmax(s, axis=-1).astype(v.dtype)
        return jnp.einsum('bhgqk,bkhd->bqhgd', p, v)

    o = lax.map(one_block, qb)
    return jnp.moveaxis(o, 0, 1).reshape(b, s_len, -1)


def gqa_heads(q, k, v, n_heads, n_kv, rope=None, q_gain=None, k_gain=None):
    b, n, _ = q.shape
    q = q.reshape(b, n, n_heads, HEAD_DIM)
    k = k.reshape(b, n, n_kv, HEAD_DIM)
    v = v.reshape(b, n, n_kv, HEAD_DIM)
    if q_gain is not None:
        q = rms_norm(q, q_gain)
        k = rms_norm(k, k_gain)
    if rope is not None:
        q = apply_rope(q, rope[0], rope[1])
        k = apply_rope(k, rope[0], rope[1])
    return q.reshape(b, n, n_kv, n_heads // n_kv, HEAD_DIM), k, v


def window_mixer(pc, pl, sink, rope, ctx_out):
    scale = HEAD_DIM ** -0.5
    qc, kc, vc = gqa_heads(pc[0], pc[1], pc[2], SW_HEADS, SW_KV_HEADS)
    ql, kl, vl = gqa_heads(pl[0], pl[1], pl[2], SW_HEADS, SW_KV_HEADS, rope)
    sink = sink.reshape(SW_KV_HEADS, SW_HEADS // SW_KV_HEADS)
    y_lat = banded_window_attention(ql, kl, vl, kc, vc, sink, scale)
    y_ctx = context_attention(qc, kc, vc, scale, sink) if ctx_out else None
    return y_ctx, y_lat


def grid_attention_mixer(pc, pl, q_gain, k_gain, rope, ctx_out):
    scale = HEAD_DIM ** -0.5
    qc, kc, vc = gqa_heads(pc[0], pc[1], pc[2], GA_HEADS, GA_KV_HEADS, None, q_gain, k_gain)
    ql, kl, vl = gqa_heads(pl[0], pl[1], pl[2], GA_HEADS, GA_KV_HEADS, rope, q_gain, k_gain)
    y_lat = dense_block_attention(ql, jnp.concatenate([kc, kl], axis=1), jnp.concatenate([vc, vl], axis=1), scale)
    y_ctx = context_attention(qc, kc, vc, scale) if ctx_out else None
    return y_ctx, y_lat


def mla_mixer(pc, pl, q_gain, w_uq, kv_gain, w_ukv, rope, ctx_out):
    scale = (MLA_NOPE + MLA_ROPE) ** -0.5

    def project(cq, ckv, k_rope, rope_tab):
        b, n, _ = cq.shape
        q = (rms_norm(cq, q_gain) @ w_uq).reshape(b, n, MLA_HEADS, MLA_NOPE + MLA_ROPE)
        kv = (rms_norm(ckv, kv_gain) @ w_ukv).reshape(b, n, MLA_HEADS, MLA_NOPE + MLA_V)
        q_nope, q_pe = q[..., :MLA_NOPE], q[..., MLA_NOPE:]
        k_nope, v = kv[..., :MLA_NOPE], kv[..., MLA_NOPE:]
        k_pe = k_rope[:, :, None, :]
        if rope_tab is not None:
            q_pe = apply_rope(q_pe, rope_tab[0], rope_tab[1])
            k_pe = apply_rope(k_pe, rope_tab[0], rope_tab[1])
        q = jnp.concatenate([q_nope, q_pe], axis=-1)
        k = jnp.concatenate([k_nope, jnp.broadcast_to(k_pe, (b, n, MLA_HEADS, MLA_ROPE))], axis=-1)
        return q[:, :, :, None, :], k, v

    qc, kc, vc = project(pc[0], pc[1], pc[2], None)
    ql, kl, vl = project(pl[0], pl[1], pl[2], rope)
    y_lat = dense_block_attention(ql, jnp.concatenate([kc, kl], axis=1), jnp.concatenate([vc, vl], axis=1), scale)
    y_ctx = context_attention(qc, kc, vc, scale) if ctx_out else None
    return y_ctx, y_lat


def centred_token_shift(f, mu):
    prev = jnp.pad(f[:, :-1], ((0, 0), (1, 0), (0, 0)))
    nxt = jnp.pad(f[:, 1:], ((0, 0), (0, 1), (0, 0)))
    return f + mu[0] * (prev - f) + mu[1] * (nxt - f)


def rwkv7_scan(r, decay, k, v, a, b, state0, reverse):
    xs = tuple(jnp.moveaxis(t.astype(jnp.float32), 1, 0) for t in (r, decay, k, v, a, b))

    def step(state, inp):
        r_t, w_t, k_t, v_t, a_t, b_t = inp
        sa = jnp.einsum('bhvk,bhk->bhv', state, a_t)
        state = (state * w_t[:, :, None, :] + sa[..., None] * b_t[:, :, None, :]
                 + v_t[..., None] * k_t[:, :, None, :])
        return state, jnp.einsum('bhvk,bhk->bhv', state, r_t)

    final, y = lax.scan(step, state0, xs, reverse=reverse)
    return final, jnp.moveaxis(y, 0, 1)


def rwkv7_mixer(f_ctx, f_lat, vf_ctx, vf_lat, rw, ctx_out):
    def heads(t):
        return t.reshape(t.shape[:-1] + (RW_HEADS, HEAD_DIM))

    r_k = rw['r_k'].reshape(RW_HEADS, HEAD_DIM)

    def features(f, vf):
        f = centred_token_shift(f, rw['mu'])
        r, k, v, z = jnp.split(f, 4, axis=-1)
        if vf is None:
            vf = v
        else:
            v = v + (vf - v) * jax.nn.sigmoid(rw['v0'] + (z @ rw['v1']) @ rw['v2'])
        kk = heads(k * rw['k_k']).astype(jnp.float32)
        kk = (kk * lax.rsqrt(jnp.sum(kk * kk, axis=-1, keepdims=True) + 1e-12)).astype(f.dtype)
        g = jax.nn.sigmoid(z @ rw['g1']) @ rw['g2']
        per_dir = []
        for d in range(2):
            w = -jax.nn.softplus(-(rw['w0'][d] + jnp.tanh(z @ rw['w1'][d]) @ rw['w2'][d])) - 0.5
            decay = jnp.exp(-jnp.exp(w.astype(jnp.float32)))
            a = jax.nn.sigmoid(rw['a0'][d] + (z @ rw['a1'][d]) @ rw['a2'][d])
            k_d = k * (1 + (a - 1) * rw['k_a'])
            per_dir.append((heads(decay), heads(a), heads(k_d)))
        return heads(r), heads(v), kk, g, per_dir, vf

    r_c, v_c, kk_c, g_c, dir_c, vf_ctx = features(f_ctx, vf_ctx)
    r_l, v_l, kk_l, g_l, dir_l, vf_lat = features(f_lat, vf_lat)
    state0 = jnp.zeros((f_lat.shape[0], RW_HEADS, HEAD_DIM, HEAD_DIM), jnp.float32)
    y_c, y_l, bonus_c, bonus_l = 0.0, 0.0, 0.0, 0.0
    for d in range(2):
        rev = d == 1
        dec, a, k_d = dir_c[d]
        s_ctx, y = rwkv7_scan(r_c, dec, k_d, v_c, -kk_c, kk_c * a, state0, rev)
        if ctx_out:
            y_c = y_c + y
            bonus_c = bonus_c + jnp.sum(r_c * k_d * r_k, axis=-1, keepdims=True) * v_c
        dec, a, k_d = dir_l[d]
        _, y = rwkv7_scan(r_l, dec, k_d, v_l, -kk_l, kk_l * a, s_ctx, rev)
        y_l = y_l + y
        bonus_l = bonus_l + jnp.sum(r_l * k_d * r_k, axis=-1, keepdims=True) * v_l

    ln_w = rw['ln_w'].reshape(RW_HEADS, HEAD_DIM).astype(jnp.float32)
    ln_b = rw['ln_b'].reshape(RW_HEADS, HEAD_DIM).astype(jnp.float32)

    def finish(y, bonus, g):
        mu = jnp.mean(y, axis=-1, keepdims=True)
        var = jnp.mean(jnp.square(y - mu), axis=-1, keepdims=True)
        yn = (y - mu) * lax.rsqrt(var + RW_GN_EPS) * ln_w + ln_b
        o = yn.astype(g.dtype) + bonus
        return o.reshape(g.shape) * g

    y_lat = finish(y_l, bonus_l, g_l)
    y_ctx = finish(y_c, bonus_c, g_c) if ctx_out else None
    return y_ctx, y_lat, vf_ctx, vf_lat


def hybrid_token_mixer(h_ctx, h_lat, vf_ctx, vf_lat, w_in, w_branch, w_out, rw, sw_sink,
                       mla_q_norm, mla_w_uq, mla_kv_norm, mla_w_ukv, ga_q_norm, ga_k_norm,
                       rope64, rope32, ctx_out):
    pc = split_cols(h_ctx @ w_in, IN_WIDTHS)
    pl = split_cols(h_lat @ w_in, IN_WIDTHS)
    ya_c, ya_l, vf_ctx, vf_lat = rwkv7_mixer(pc[0], pl[0], vf_ctx, vf_lat, rw, ctx_out)
    yb_c, yb_l = window_mixer(pc[1:4], pl[1:4], sw_sink, rope64, ctx_out)
    yc_c, yc_l = mla_mixer(pc[4:7], pl[4:7], mla_q_norm, mla_w_uq, mla_kv_norm, mla_w_ukv, rope32, ctx_out)
    yd_c, yd_l = grid_attention_mixer(pc[7:10], pl[7:10], ga_q_norm, ga_k_norm, rope64, ctx_out)

    def merge(ys, gate_cols):
        gates = jax.nn.sigmoid(gate_cols.astype(jnp.float32)).astype(gate_cols.dtype)
        m = None
        for i, y in enumerate(ys):
            term = gates[..., i * D_MODEL:(i + 1) * D_MODEL] * (y @ w_branch[i])
            m = term if m is None else m + term
        return m @ w_out

    out_lat = merge([ya_l, yb_l, yc_l, yd_l], pl[10])
    out_ctx = merge([ya_c, yb_c, yc_c, yd_c], pc[10]) if ctx_out else None
    return out_ctx, out_lat, vf_ctx, vf_lat


def swiglu(h, w1, w3, w2):
    return (jax.nn.silu(h @ w1) * (h @ w3)) @ w2


def moe_swiglu(h, w_router, w1, w3, w2):
    n_tok, d = h.shape
    logits = (h @ w_router).astype(jnp.float32)
    top_logit, top_idx = lax.top_k(logits, TOP_K)
    gates = jax.nn.softmax(top_logit, axis=-1)
    n_assign = n_tok * TOP_K
    flat_e = top_idx.reshape(-1)
    order = jnp.argsort(flat_e)
    sorted_e = flat_e[order]
    sorted_tok = (order // TOP_K).astype(jnp.int32)
    sorted_gate = gates.reshape(-1)[order]
    counts = jnp.bincount(flat_e, length=N_EXPERTS)
    padded = (counts + MOE_BLOCK - 1) // MOE_BLOCK * MOE_BLOCK
    start = jnp.cumsum(counts) - counts
    pend = jnp.cumsum(padded)
    pstart = pend - padded
    dest = pstart[sorted_e] + jnp.arange(n_assign) - start[sorted_e]
    n_blocks = -(-n_assign // MOE_BLOCK) + N_EXPERTS
    n_rows = n_blocks * MOE_BLOCK
    tok = jnp.zeros((n_rows,), jnp.int32).at[dest].set(sorted_tok)
    gate = jnp.zeros((n_rows,), h.dtype).at[dest].set(sorted_gate.astype(h.dtype))
    block_e = jnp.minimum(jnp.searchsorted(pend, jnp.arange(n_blocks) * MOE_BLOCK, side='right'), N_EXPERTS - 1)
    xb = h[tok].reshape(n_blocks, MOE_BLOCK, d)

    def expert_block(args):
        xblk, e = args
        return (jax.nn.silu(xblk @ w1[e]) * (xblk @ w3[e])) @ w2[e]

    yb = lax.map(expert_block, (xb, block_e)).reshape(n_rows, d)
    return jnp.zeros_like(h).at[tok].add(yb * gate[:, None])


def setup_inputs(seed: int = 0) -> dict:
    key = jax.random.key(seed)
    keys = iter(jax.random.split(key, 64))
    f32 = jnp.float32

    def normal(shape, scale=1.0):
        return jax.random.normal(next(keys), shape, f32) * scale

    def gain(shape):
        return 1.0 + normal(shape, 0.05)

    L, D, W = DEPTH, D_MODEL, RW_WIDTH
    n_dense, n_moe = (DEPTH + 1) // 2, DEPTH // 2
    return {
        'x': normal((BATCH, SEQ, D)),
        'c': normal((BATCH, D)),
        'ctx': normal((BATCH, CTX_LEN, D)),
        'c_ctx': normal((D,)),
        'w_mod': normal((L, D, 6 * D), 0.02),
        'b_mod': normal((L, 6 * D), 0.02),
        'norm1': gain((L, D)),
        'norm2': gain((L, D)),
        'w_in': normal((L, D, IN_WIDTH), D ** -0.5),
        'w_branch': normal((L, N_BRANCH, BRANCH_WIDTH, D), BRANCH_WIDTH ** -0.5),
        'w_out': normal((L, D, D), D ** -0.5),
        'rw_mu': jax.random.uniform(next(keys), (L, 2, 4 * W), f32, 0.0, 0.5),
        'rw_w0': jnp.linspace(-6.0, -1.0, W, dtype=f32)[None, None, :] + normal((L, 2, W), 0.1),
        'rw_w1': normal((L, 2, W, RW_DECAY_LORA), W ** -0.5),
        'rw_w2': normal((L, 2, RW_DECAY_LORA, W), 0.3 * RW_DECAY_LORA ** -0.5),
        'rw_a0': normal((L, 2, W), 0.1),
        'rw_a1': normal((L, 2, W, RW_AAA_LORA), W ** -0.5),
        'rw_a2': normal((L, 2, RW_AAA_LORA, W), 0.5 * RW_AAA_LORA ** -0.5),
        'rw_v0': normal((L - 1, W), 0.3),
        'rw_v1': normal((L - 1, W, RW_MV_LORA), W ** -0.5),
        'rw_v2': normal((L - 1, RW_MV_LORA, W), 0.5 * RW_MV_LORA ** -0.5),
        'rw_g1': normal((L, W, RW_GATE_LORA), W ** -0.5),
        'rw_g2': normal((L, RW_GATE_LORA, W), RW_GATE_LORA ** -0.5),
        'rw_k_k': 0.85 + normal((L, W), 0.05),
        'rw_k_a': gain((L, W)),
        'rw_r_k': normal((L, W), 0.1),
        'rw_ln_w': gain((L, W)),
        'rw_ln_b': normal((L, W), 0.02),
        'sw_sink': normal((L, SW_HEADS), 0.5),
        'mla_q_norm': gain((L, MLA_Q_RANK)),
        'mla_w_uq': normal((L, MLA_Q_RANK, MLA_HEADS * (MLA_NOPE + MLA_ROPE)), MLA_Q_RANK ** -0.5),
        'mla_kv_norm': gain((L, MLA_KV_RANK)),
        'mla_w_ukv': normal((L, MLA_KV_RANK, MLA_HEADS * (MLA_NOPE + MLA_V)), MLA_KV_RANK ** -0.5),
        'ga_q_norm': gain((L, HEAD_DIM)),
        'ga_k_norm': gain((L, HEAD_DIM)),
        'ffn_w1': normal((n_dense, D, D_FF), D ** -0.5),
        'ffn_w3': normal((n_dense, D, D_FF), D ** -0.5),
        'ffn_w2': normal((n_dense, D_FF, D), D_FF ** -0.5),
        'moe_router': normal((n_moe, D, N_EXPERTS), D ** -0.5),
        'moe_w1': normal((n_moe, N_EXPERTS, D, D_FF_EXPERT), D ** -0.5),
        'moe_w3': normal((n_moe, N_EXPERTS, D, D_FF_EXPERT), D ** -0.5),
        'moe_w2': normal((n_moe, N_EXPERTS, D_FF_EXPERT, D), D_FF_EXPERT ** -0.5),
        'final_norm': gain((D,)),
    }


def reference(x, c, ctx, c_ctx, w_mod, b_mod, norm1, norm2, w_in, w_branch, w_out,
              rw_mu, rw_w0, rw_w1, rw_w2, rw_a0, rw_a1, rw_a2, rw_v0, rw_v1, rw_v2,
              rw_g1, rw_g2, rw_k_k, rw_k_a, rw_r_k, rw_ln_w, rw_ln_b, sw_sink,
              mla_q_norm, mla_w_uq, mla_kv_norm, mla_w_ukv, ga_q_norm, ga_k_norm,
              ffn_w1, ffn_w3, ffn_w2, moe_router, moe_w1, moe_w3, moe_w2, final_norm):
    b, s_len, d = x.shape
    n_ctx_tok = ctx.shape[1]
    rope64 = axial_rope_tables(s_len, HEAD_DIM)
    rope32 = axial_rope_tables(s_len, MLA_ROPE)
    silu_c = jax.nn.silu(c)
    silu_cc = jax.nn.silu(c_ctx)
    x_lat, x_ctx = x, ctx
    vf_lat, vf_ctx = None, None
    for l in range(DEPTH):
        ctx_out = l < DEPTH - 1
        mod_l = silu_c @ w_mod[l] + b_mod[l]
        mod_c = silu_cc @ w_mod[l] + b_mod[l]
        sh1, sc1, g1, sh2, sc2, g2 = jnp.split(mod_l[:, None, :], 6, axis=-1)
        csh1, csc1, cg1, csh2, csc2, cg2 = jnp.split(mod_c, 6, axis=-1)

        h_lat = rms_norm(x_lat, norm1[l]) * (1 + sc1) + sh1
        h_ctx = rms_norm(x_ctx, norm1[l]) * (1 + csc1) + csh1
        rw = dict(mu=rw_mu[l], w0=rw_w0[l], w1=rw_w1[l], w2=rw_w2[l],
                  a0=rw_a0[l], a1=rw_a1[l], a2=rw_a2[l],
                  v0=rw_v0[l - 1] if l > 0 else None,
                  v1=rw_v1[l - 1] if l > 0 else None,
                  v2=rw_v2[l - 1] if l > 0 else None,
                  g1=rw_g1[l], g2=rw_g2[l], k_k=rw_k_k[l], k_a=rw_k_a[l], r_k=rw_r_k[l],
                  ln_w=rw_ln_w[l], ln_b=rw_ln_b[l])
        out_ctx, out_lat, vf_ctx, vf_lat = hybrid_token_mixer(
            h_ctx, h_lat, vf_ctx, vf_lat, w_in[l], w_branch[l], w_out[l], rw, sw_sink[l],
            mla_q_norm[l], mla_w_uq[l], mla_kv_norm[l], mla_w_ukv[l], ga_q_norm[l], ga_k_norm[l],
            rope64, rope32, ctx_out)
        x_lat = x_lat + g1 * out_lat

        f_lat = rms_norm(x_lat, norm2[l]) * (1 + sc2) + sh2
        if ctx_out:
            x_ctx = x_ctx + cg1 * out_ctx
            f_ctx = rms_norm(x_ctx, norm2[l]) * (1 + csc2) + csh2
            tokens = jnp.concatenate([f_ctx.reshape(-1, d), f_lat.reshape(-1, d)], axis=0)
            n_c = b * n_ctx_tok
        else:
            tokens = f_lat.reshape(-1, d)
            n_c = 0
        if l % 2 == 0:
            ffn_out = swiglu(tokens, ffn_w1[l // 2], ffn_w3[l // 2], ffn_w2[l // 2])
        else:
            ffn_out = moe_swiglu(tokens, moe_router[l // 2], moe_w1[l // 2], moe_w3[l // 2], moe_w2[l // 2])
        x_lat = x_lat + g2 * ffn_out[n_c:].reshape(b, s_len, d)
        if ctx_out:
            x_ctx = x_ctx + cg2 * ffn_out[:n_c].reshape(b, n_ctx_tok, d)
    return rms_norm(x_lat, final_norm)
```

```cpp
#include <hip/hip_runtime.h>
#include <cstdio>
#include <cstdint>

#ifndef MK_N_LAUNCHES
#define MK_N_LAUNCHES 0
#endif

#define GAS __attribute__((address_space(1)))
#define LAS __attribute__((address_space(3)))
#define DI __device__ __forceinline__
typedef unsigned short bf16_t;
typedef short bf16x8 __attribute__((ext_vector_type(8)));
typedef short s16x4 __attribute__((ext_vector_type(4)));
typedef float f32x2 __attribute__((ext_vector_type(2)));
typedef float f32x4 __attribute__((ext_vector_type(4)));
typedef float f32x16 __attribute__((ext_vector_type(16)));
typedef unsigned u32x2 __attribute__((ext_vector_type(2)));
typedef unsigned u32x4 __attribute__((ext_vector_type(4)));

constexpr int DM = 1024, NB = 2, SEQ = 8192, DEPTH = 4, CTXL = 256, GRIDW = 64;
constexpr int TPB = CTXL + SEQ;
constexpr int NROW = NB * TPB;
constexpr int NPANEL = NROW / 256;
constexpr int DFF = 3584, NEXP = 8;
constexpr int IN_W = 6560;
constexpr int PC_F = 0, PC_SWQ = 1024, PC_SWK = 1280, PC_SWV = 1408, PC_CQ = 1536, PC_CKV = 1792, PC_KR = 1920,
              PC_GAQ = 2048, PC_GAK = 2304, PC_GAV = 2432, PC_GATE = 2560, PC_Z = 6656, NP_GEMM = 6656, LDP = 6912;
constexpr float LOG2E = 1.4426950408889634f;
constexpr float QS64 = 0.125f * LOG2E;
constexpr float QS96 = 0.10206207261596577f * LOG2E;
constexpr int NSPLIT = 2;
constexpr int MOE_MAXROWS = 35840;

constexpr size_t MiB = 1u << 20;
constexpr size_t WS_CTL = 0, CTL_BYTES = 1 * MiB;
constexpr size_t WS_MOD = 1 * MiB;
constexpr size_t WS_ROPE64 = 2 * MiB;
constexpr size_t WS_ROPE32 = 4 * MiB;
constexpr size_t WS_ASG = 5 * MiB;
constexpr size_t WS_ASG_GATE = 5 * MiB + 512 * 1024;
constexpr size_t WS_ASG_DST = 6 * MiB;
constexpr size_t WS_ROWGATE = 6 * MiB + 512 * 1024;
constexpr size_t WS_WL = 8 * MiB;
constexpr size_t WL_WIN = 0;
constexpr size_t WL_WBR = WL_WIN + (size_t)NP_GEMM * 1024 * 2;
constexpr size_t WL_WOUT = WL_WBR + (size_t)4 * 1024 * 256 * 2;
constexpr size_t WL_L1 = WL_WOUT + (size_t)1024 * 1024 * 2;
constexpr size_t WL_L2 = WL_L1 + (size_t)1536 * 256 * 2;
constexpr size_t WL_UQ = WL_L2 + (size_t)1536 * 256 * 2;
constexpr size_t WL_UKV = WL_UQ + (size_t)512 * 256 * 2;
constexpr size_t WL_W13 = WL_UKV + (size_t)512 * 256 * 2;
constexpr size_t WL_W2 = WL_W13 + (size_t)NEXP * 7168 * 1024 * 2;
constexpr size_t WL_END = WL_W2 + (size_t)NEXP * 1024 * 3584 * 2;
static_assert(WL_END <= 200 * MiB, "weights region");
constexpr size_t WS_X = 208 * MiB;
constexpr size_t WS_HB = 274 * MiB;
constexpr size_t WS_VF = 307 * MiB;
constexpr size_t WS_REG = 316 * MiB;
constexpr size_t WS_P = WS_REG;
constexpr size_t WS_RR = WS_REG + 223 * MiB;
constexpr size_t WS_KK = WS_RR + 9 * MiB;
constexpr size_t WS_KR = WS_KK + 9 * MiB;
constexpr size_t WS_V = WS_KR + 9 * MiB;
constexpr size_t WS_KD = WS_V + 9 * MiB;
constexpr size_t WS_BB = WS_KD + 17 * MiB;
constexpr size_t WS_W = WS_BB + 17 * MiB;
constexpr size_t WS_G = WS_W + 33 * MiB;
constexpr size_t WS_T = WS_G + 9 * MiB;
constexpr size_t WS_OPART = WS_T;
constexpr size_t WS_ML = WS_OPART + 66 * MiB;
constexpr size_t WS_YDIR = WS_ML + 3 * MiB;
constexpr size_t WS_QMLA = WS_YDIR + 33 * MiB;
constexpr size_t WS_KMLA = WS_QMLA + 13 * MiB;
constexpr size_t WS_VMLA = WS_KMLA + 13 * MiB;
constexpr size_t WS_YALL = WS_VMLA + 9 * MiB;
constexpr size_t WS_MIX_END = WS_YALL + 33 * MiB;
constexpr size_t WS_U = WS_REG;
constexpr size_t WS_XG = WS_REG;
constexpr size_t WS_UG = WS_REG + 70 * MiB;
constexpr size_t WS_YG = WS_UG + 245 * MiB;
constexpr size_t WS_FFN_END = WS_YG + 70 * MiB;
constexpr size_t WS_END = (WS_MIX_END > WS_FFN_END ? WS_MIX_END : WS_FFN_END);
static_assert(WS_KR + (size_t)NROW * 256 * 2 <= WS_V && WS_T + (size_t)NROW * 1536 * 2 <= WS_ML && WS_OPART + (size_t)2 * NSPLIT * NROW * 256 * 4 <= WS_ML, "map");
static_assert((size_t)2 * NSPLIT * NROW * 8 * 4 <= 3 * MiB && (size_t)NROW * 384 * 2 <= 13 * MiB && (size_t)NROW * LDP * 2 <= 223 * MiB, "map");
static_assert((size_t)MOE_MAXROWS * 1024 * 2 <= 70 * MiB && (size_t)MOE_MAXROWS * 3584 * 2 <= 245 * MiB, "map");

constexpr int CW_BAR = 4096;
constexpr int CW_MOECNT = 16384;
constexpr int CW_ATTQ = 20480;
constexpr int CW_WGBASE = 32768;

constexpr int RING_BYTES = 131072;
constexpr int MISC_OFF = RING_BYTES;
constexpr int LDS_BYTES = 147456;

#define LDS_WAIT() asm volatile("s_waitcnt lgkmcnt(0)" ::: "memory")
#define VM_WAIT() asm volatile("s_waitcnt vmcnt(0)" ::: "memory")
DI unsigned f2bf(float f) { unsigned u = __builtin_bit_cast(unsigned, f); return (u + 0x7fffu + ((u >> 16) & 1u)) >> 16; }
DI unsigned pk2(float lo, float hi) { return f2bf(lo) | (f2bf(hi) << 16); }
DI float bflo(unsigned w) { return __builtin_bit_cast(float, w << 16); }
DI float bfhi(unsigned w) { return __builtin_bit_cast(float, w & 0xffff0000u); }
DI float bf2f(bf16_t b) { return __builtin_bit_cast(float, ((unsigned)b) << 16); }
DI unsigned cvt_pk_bf16(float lo, float hi) { unsigned r; asm volatile("v_cvt_pk_bf16_f32 %0, %1, %2" : "=v"(r) : "v"(lo), "v"(hi)); return r; }
DI float fast_exp2(float x) { return __builtin_amdgcn_exp2f(x); }
DI float fast_rcp(float x) { return __builtin_amdgcn_rcpf(x); }
DI float sigmoidf_(float x) { return fast_rcp(1.0f + fast_exp2(-x * LOG2E)); }
DI float siluf_(float x) { return x * sigmoidf_(x); }
DI float tanhf_(float x) { const float e = fast_exp2(-2.0f * LOG2E * __builtin_fabsf(x)); const float t = (1.0f - e) * fast_rcp(1.0f + e); return x < 0.f ? -t : t; }
DI float wave_sum(float v) {
#pragma unroll
    for (int o = 1; o < 64; o <<= 1) v += __shfl_xor(v, o);
    return v;
}
DI float sum16(float v) {
    v += __shfl_xor(v, 1); v += __shfl_xor(v, 2); v += __shfl_xor(v, 4); v += __shfl_xor(v, 8); return v;
}
DI int row_vec(int row) { return (row % TPB) < CTXL ? 2 : row / TPB; }
#define XB_TMO      128
#define XB_XCNT(j)  (256  + 64 * (j))
#define XB_XSUB(j)  (1280 + 64 * (j))
#define XB_XGEN(j)  (2304 + 64 * (j))
#define XB_TOP      3328
#define XB_TOPGEN   3392
#define XCD_BAR_WORDS 3456
#define XB_SPIN_CAP (1u << 25)
DI unsigned xb_ld(unsigned* p)              { return __hip_atomic_load(p, __ATOMIC_RELAXED, __HIP_MEMORY_SCOPE_AGENT); }
DI unsigned xb_add(unsigned* p, unsigned v) { return __hip_atomic_fetch_add(p, v, __ATOMIC_RELAXED, __HIP_MEMORY_SCOPE_AGENT); }
DI unsigned xb_xcc_id() { return (unsigned)__builtin_amdgcn_s_getreg((3 << 11) | 20) & 0xFu; }
#define XB_SPIN(cond, bar) do { unsigned _sp = 0; while (cond) { __builtin_amdgcn_s_sleep(1); \
    if ((++_sp & 255u) == 0u) { if (xb_ld(&(bar)[XB_TMO])) break; if (_sp > XB_SPIN_CAP) { atomicAdd(&(bar)[XB_TMO], 1u); break; } } } } while (0)
struct XcdBarrier { unsigned* bar; unsigned x; volatile LAS unsigned* st; };
DI XcdBarrier xcd_barrier_post(unsigned* bar, volatile LAS unsigned* st) {
    XcdBarrier b; b.bar = bar; b.x = xb_xcc_id(); b.st = st;
    if (threadIdx.x == 0) (void)xb_add(&bar[XB_XCNT(b.x)], 1u);
    return b;
}
DI void xcd_barrier_complete(unsigned* bar, unsigned x, unsigned& nloc, unsigned& nx) {
    const unsigned G = gridDim.x * gridDim.y * gridDim.z;
    unsigned sum, cnt, mine, sp = 0u;
    for (;;) {
        sum = 0u; cnt = 0u; mine = 0u;
#pragma unroll
        for (unsigned j = 0; j < 16; ++j) { const unsigned c = xb_ld(&bar[XB_XCNT(j)]); sum += c; cnt += (c > 0u) ? 1u : 0u; mine = (j == x) ? c : mine; }
        if (sum == G) break;
        __builtin_amdgcn_s_sleep(1);
        if ((++sp & 255u) == 0u) { if (xb_ld(&bar[XB_TMO])) break; if (sp > XB_SPIN_CAP) { atomicAdd(&bar[XB_TMO], 1u); break; } }
    }
    nloc = mine > 0u ? mine : 1u; nx = cnt > 0u ? cnt : 1u;
}
template <bool FIRST>
DI void xcd_barrier_t(const XcdBarrier& b) {
    asm volatile("s_waitcnt vmcnt(0)" ::: "memory");
    __syncthreads();
    if (threadIdx.x == 0) {
        unsigned* bar = b.bar; asm volatile("" : "+s"(bar));
        __builtin_amdgcn_s_waitcnt(0);
        unsigned nloc = b.st[0], nx = b.st[1];
        if (FIRST) { if (nloc == 0u) { xcd_barrier_complete(bar, b.x, nloc, nx); b.st[0] = nloc; b.st[1] = nx; } }
        else if (nloc == 0u) { atomicAdd(&bar[XB_TMO], 1u); nloc = 1u; nx = 1u; }
        const unsigned old = xb_add(&bar[XB_XSUB(b.x)], 1u);
        const unsigned gen = old / nloc;
        if (old + 1u == (gen + 1u) * nloc) {
            __builtin_amdgcn_fence(__ATOMIC_RELEASE, "agent");
            asm volatile("s_waitcnt vmcnt(0)" ::: "memory");
            const unsigned og = xb_add(&bar[XB_TOP], 1u);
            const unsigned tg = og / nx;
            if (og + 1u == (tg + 1u) * nx) xb_add(&bar[XB_TOPGEN], 1u);
            else XB_SPIN(xb_ld(&bar[XB_TOPGEN]) == tg, bar);
            __builtin_amdgcn_fence(__ATOMIC_ACQUIRE, "agent");
            xb_add(&bar[XB_XGEN(b.x)], 1u);
            asm volatile("s_waitcnt vmcnt(0)" ::: "memory");
        } else {
            XB_SPIN(xb_ld(&bar[XB_XGEN(b.x)]) == gen, bar);
            __builtin_amdgcn_fence(__ATOMIC_ACQUIRE, "agent");
            asm volatile("s_waitcnt vmcnt(0)" ::: "memory");
        }
    }
    __syncthreads();
}

namespace pg8 {
constexpr int BM = 256, BK = 64, HALF = 128, HTB = HALF * BK * 2, STAGE_BYTES = 8 * HTB, NXCD = 8, WGM = 8;
__host__ __device__ __forceinline__ int lds_byte(int r, int c) { const int st = (r >> 4) * 2 + (c >> 5), rr = r & 15, cc = c & 31, ob = rr * 64 + cc * 2; return st * 1024 + (ob ^ (((ob >> 9) & 1) << 5)); }
__host__ __device__ __forceinline__ void stage_rc(int b, int& R, int& C) { const int st = b / 1024, sb = b % 1024, swz = sb ^ (((sb >> 9) & 1) << 5); R = (st >> 1) * 16 + swz / 64; C = (st & 1) * 32 + (swz % 64) / 2; }
__host__ __device__ __forceinline__ int perm32(int rho) { const int n = rho >> 4, i = rho & 15; return 8 * (i >> 2) + 4 * n + (i & 3); }

struct Unit { int pm, pn, aux; size_t aoff, boff; };
struct Gemm { const char* A; const char* Bt; int lda, ldb, K; };

struct TileOrder {
    int nM, nN, nwg, G, c;
    DI void init(int nM_, int nN_, int G_, int c_) { nM = nM_; nN = nN_; nwg = nM * nN; G = G_; c = c_; }
    DI bool tile(int i, int& pm, int& pn) const {
        const long L = (long)i * G + c; if (L >= nwg) return false;
        int wgid = (int)L; { const int q = nwg / NXCD, r = nwg % NXCD, xcd = wgid % NXCD, off = wgid / NXCD; wgid = (xcd < r ? xcd * (q + 1) : r * (q + 1) + (xcd - r) * q) + off; }
        const int nig = WGM * nN, gid = wgid / nig, fm = gid * WGM, gsz = (nM - fm) < WGM ? (nM - fm) : WGM;
        pm = fm + ((wgid % nig) % gsz); pn = (wgid % nig) / gsz; return true;
    }
};

template <class Epi, class Sched>
DI void gemm_phase(LAS unsigned char* lds, const Gemm g, const Sched& S, const Epi& E, const int wave_id) {
    int lane = (int)__builtin_amdgcn_mbcnt_hi(~0u, __builtin_amdgcn_mbcnt_lo(~0u, 0u)); asm volatile("" : "+v"(lane));
    const int wid = wave_id, tid = wid * 64 + lane, wr = wid >> 2, wc = wid & 3, fr = lane & 15, fq = lane >> 4;
    const int K = g.K, nt = K / BK;
    unsigned voffA[2], voffB[2];
#pragma unroll
    for (int i = 0; i < 2; ++i) { int R, C; stage_rc(tid * 16 + i * 8192, R, C); const int Rb = (R & ~31) + perm32(R & 31);
        voffA[i] = (unsigned)(R * g.lda + C) * 2u; voffB[i] = (unsigned)(Rb * g.ldb + C) * 2u; }
    const size_t kstep = (size_t)(BK * 2);
    const size_t hstepA = (size_t)HALF * g.lda * 2, hstepB = (size_t)HALF * g.ldb * 2;
    const unsigned ldsw = (unsigned)wid * 1024u;
    const int aoff = lds_byte(wr * 64 + fr, fq * 8), boff = lds_byte(wc * 32 + fr, fq * 8);
#define PG8_SA(b, h) (((b) * 2 + (h)) * HTB)
#define PG8_SB(b, h) ((4 + (b) * 2 + (h)) * HTB)
#define PG8_STAGE(bufoff, gbase, voff) do { _Pragma("unroll") for (int _i = 0; _i < 2; ++_i) \
        __builtin_amdgcn_global_load_lds((const unsigned*)((const char*)(gbase) + (voff)[_i]), (LAS unsigned*)(lds + (bufoff) + ldsw + _i * 8192), 16, 0, 0); } while (0)
#define PG8_LDA(dst, b, h) do { _Pragma("unroll") for (int m = 0; m < 4; ++m) _Pragma("unroll") for (int k = 0; k < 2; ++k) dst[m][k] = *(const LAS bf16x8*)(lds + PG8_SA(b, h) + aoff + m * 2048 + k * 1024); } while (0)
#define PG8_LDB(dst, b, h) do { _Pragma("unroll") for (int n = 0; n < 2; ++n) _Pragma("unroll") for (int k = 0; k < 2; ++k) dst[n][k] = *(const LAS bf16x8*)(lds + PG8_SB(b, h) + boff + n * 2048 + k * 1024); } while (0)
#define PG8_MMA(ai, bj, At, Bt) do { __builtin_amdgcn_s_setprio(1); _Pragma("unroll") for (int m = 0; m < 4; ++m) _Pragma("unroll") for (int n = 0; n < 2; ++n) _Pragma("unroll") for (int k = 0; k < 2; ++k) \
        acc[ai][bj][m][n] = __builtin_amdgcn_mfma_f32_16x16x32_bf16(Bt[n][k], At[m][k], acc[ai][bj][m][n], 0, 0, 0); __builtin_amdgcn_s_setprio(0); } while (0)
#define PG8_WAIT_V(n) asm volatile("s_waitcnt vmcnt(" #n ")" ::: "memory")
#define PG8_WAIT_L(n) asm volatile("s_waitcnt lgkmcnt(" #n ")" ::: "memory")
#define PG8_BAR __builtin_amdgcn_s_barrier()
#define PG8_SCHED __builtin_amdgcn_sched_barrier(0)
    Unit cur, nxt; int ui = 0;
    if (!S.next(0, cur)) return;
    f32x4 acc[2][2][4][2];
#pragma unroll
    for (int a = 0; a < 2; ++a)
#pragma unroll
        for (int b = 0; b < 2; ++b)
#pragma unroll
            for (int m = 0; m < 4; ++m)
#pragma unroll
                for (int n = 0; n < 2; ++n) acc[a][b][m][n] = (f32x4){0.f, 0.f, 0.f, 0.f};
    bf16x8 At[4][2], B0[2][2], B1[2][2];
    const char* cA = g.A + cur.aoff; const char* cB = g.Bt + cur.boff;
    {
        PG8_STAGE(PG8_SB(0, 0), cB, voffB); PG8_STAGE(PG8_SB(0, 1), cB + hstepB, voffB); PG8_STAGE(PG8_SA(0, 0), cA, voffA); PG8_STAGE(PG8_SA(0, 1), cA + hstepA, voffA);
        if (wr == 1) PG8_BAR;
        PG8_WAIT_V(2); PG8_BAR;
        PG8_STAGE(PG8_SB(1, 0), cB + kstep, voffB); PG8_STAGE(PG8_SA(1, 0), cA + kstep, voffA); PG8_STAGE(PG8_SB(1, 1), cB + hstepB + kstep, voffB);
        PG8_WAIT_V(6); PG8_BAR;
    }
    for (;;) {
        const bool has_next = S.next(ui + 1, nxt);
        const char* nA = has_next ? g.A + nxt.aoff : cA; const char* nB = has_next ? g.Bt + nxt.boff : cB;
#pragma nounroll
        for (int t = 0; t < nt; t += 2) {
            const bool last = (t == nt - 2);
            const char* a1 = cA + (size_t)(t + 1) * kstep;
            const char* a2 = last ? nA : cA + (size_t)(t + 2) * kstep; const char* b2 = last ? nB : cB + (size_t)(t + 2) * kstep;
            const char* a3 = a2 + kstep; const char* b3 = b2 + kstep;
            PG8_LDB(B0, 0, 0); PG8_LDB(B1, 0, 1); PG8_SCHED; PG8_LDA(At, 0, 0); PG8_STAGE(PG8_SA(1, 1), a1 + hstepA, voffA);
            PG8_WAIT_V(8); PG8_WAIT_L(0); PG8_BAR; PG8_MMA(0, 0, At, B0); PG8_MMA(0, 1, At, B1); PG8_BAR; PG8_SCHED;
            PG8_LDA(At, 0, 1); PG8_STAGE(PG8_SB(0, 0), b2, voffB); PG8_STAGE(PG8_SB(0, 1), b2 + hstepB, voffB); PG8_STAGE(PG8_SA(0, 0), a2, voffA);
            PG8_WAIT_V(8); PG8_WAIT_L(0); PG8_BAR; PG8_MMA(1, 0, At, B0); PG8_MMA(1, 1, At, B1); PG8_BAR; PG8_SCHED;
            PG8_LDB(B0, 1, 0); PG8_LDB(B1, 1, 1); PG8_SCHED; PG8_LDA(At, 1, 0); PG8_STAGE(PG8_SA(0, 1), a2 + hstepA, voffA);
            PG8_WAIT_V(8); PG8_WAIT_L(0); PG8_BAR; PG8_MMA(0, 0, At, B0); PG8_MMA(0, 1, At, B1); PG8_BAR; PG8_SCHED;
            PG8_LDA(At, 1, 1); PG8_STAGE(PG8_SB(1, 0), b3, voffB); PG8_STAGE(PG8_SB(1, 1), b3 + hstepB, voffB); PG8_STAGE(PG8_SA(1, 0), a3, voffA);
            PG8_WAIT_V(8); PG8_WAIT_L(0); PG8_BAR; PG8_MMA(1, 0, At, B0); PG8_MMA(1, 1, At, B1); PG8_BAR; PG8_SCHED;
        }
        if (wr == 0) PG8_BAR;
        E(acc, cur, wr, wc, fr, fq);
        if (!has_next) break;
#pragma unroll
        for (int a = 0; a < 2; ++a)
#pragma unroll
            for (int b = 0; b < 2; ++b)
#pragma unroll
                for (int m = 0; m < 4; ++m)
#pragma unroll
                    for (int n = 0; n < 2; ++n) acc[a][b][m][n] = (f32x4){0.f, 0.f, 0.f, 0.f};
        cur = nxt; cA = nA; cB = nB; ++ui;
        if (wr == 1) PG8_BAR;
    }
    PG8_WAIT_V(0);
    PG8_BAR;
#undef PG8_SA
#undef PG8_SB
#undef PG8_STAGE
#undef PG8_LDA
#undef PG8_LDB
#undef PG8_MMA
#undef PG8_WAIT_V
#undef PG8_WAIT_L
#undef PG8_BAR
#undef PG8_SCHED
}
}
struct Frame {
    LAS unsigned char* lds;
    volatile LAS unsigned* MISC;
    unsigned* ctl;
    unsigned char* ws;
    int tid, lane, wave, vcu, G;
    float* out;
};
DI Frame relane(const Frame& F) { Frame Q = F; int ln = (int)__builtin_amdgcn_mbcnt_hi(~0u, __builtin_amdgcn_mbcnt_lo(~0u, 0u)); unsigned char* w = F.ws; int wv = F.wave;
    asm volatile("" : "+v"(ln), "+s"(w), "+s"(wv)); Q.ws = w; Q.ctl = (unsigned*)w; Q.lane = ln; Q.wave = wv; Q.tid = wv * 64 + ln; return Q; }
typedef const float* cfp_t;
DI cfp_t inp(int i) { unsigned long long kp = (unsigned long long)__builtin_amdgcn_kernarg_segment_ptr(); asm volatile("" : "+s"(kp)); return ((const __attribute__((address_space(4))) cfp_t*)kp)[i]; }
#define FX(F) ((float*)((F).ws + WS_X))
#define FHB(F) ((bf16_t*)((F).ws + WS_HB))
#define FP(F) ((bf16_t*)((F).ws + WS_P))
#define FMOD(F) ((float*)((F).ws + WS_MOD))
enum { I_X = 0, I_C, I_CTX, I_CCTX, I_WMOD, I_BMOD, I_NORM1, I_NORM2, I_WIN, I_WBR, I_WOUT, I_MU, I_W0, I_W1, I_W2, I_A0, I_A1, I_A2, I_V0, I_V1, I_V2,
       I_G1, I_G2, I_KK, I_KA, I_RK, I_LNW, I_LNB, I_SINK, I_MQN, I_WUQ, I_MKVN, I_WUKV, I_GQN, I_GKN, I_FW1, I_FW3, I_FW2, I_ROUTER, I_MW1, I_MW3, I_MW2, I_FNORM };

DI const float* modp(const Frame& F, int l, int vec, int which) { return FMOD(F) + ((size_t)(l * 3 + vec) * 6 + which) * 1024; }

using pg8::Unit;
struct SchedGrid {
    pg8::TileOrder T; int lda, ldb, acol;
    DI bool next(int i, Unit& u) const { int pm, pn; if (!T.tile(i, pm, pn)) return false; u.pm = pm; u.pn = pn; u.aux = 0;
        u.aoff = ((size_t)pm * 256 * lda + acol) * 2; u.boff = (size_t)pn * 256 * ldb * 2; return true; }
};
struct SchedL3B {
    int G, c;
    DI bool next(int i, Unit& u) const {
        int L = i * G + c; if (L >= 660) return false;
        int grp, pm, pn; size_t bb; int acol;
        if (L < 396) { grp = 0; pm = L % 66; pn = L / 66; bb = 0; acol = PC_Z; }
        else if (L < 528) { L -= 396; grp = 1; pm = L % 66; pn = L / 66; bb = WL_UQ - WL_L1; acol = PC_CQ; }
        else { L -= 528; grp = 2; pm = L % 66; pn = L / 66; bb = WL_UKV - WL_L1; acol = PC_CKV; }
        u.pm = pm; u.pn = pn; u.aux = grp; u.aoff = ((size_t)pm * 256 * LDP + acol) * 2; u.boff = bb + (size_t)pn * 256 * 256 * 2; return true;
    }
};
struct SchedL3C {
    int G, c, layer;
    DI bool next(int i, Unit& u) const {
        const int L = i * G + c; const int ntile = layer == 0 ? 5 : 6; if (L >= 66 * ntile) return false;
        const int pm = L % 66; int pn = L / 66; if (layer == 0 && pn >= 4) pn = 5;
        u.pm = pm; u.pn = pn; u.aux = 0; u.aoff = ((size_t)pm * 256 * 1536 + pn * 256) * 2; u.boff = (size_t)pn * 256 * 256 * 2; return true;
    }
};
struct SchedMerge {
    int G, c;
    DI bool next(int i, Unit& u) const {
        const int ti = (i >> 2) * G + c; if (ti >= 264) return false; const int br = i & 3;
        const int pm = ti % 66, pn = ti / 66;
        u.pm = pm; u.pn = pn; u.aux = br; u.aoff = ((size_t)pm * 256 * 1024 + br * 256) * 2; u.boff = ((size_t)(br * 1024 + pn * 256) * 256) * 2; return true;
    }
};
struct SchedMoe {
    int G, c, ncol, lda, ldb, nrowB; int cp[9];
    DI bool next(int i, Unit& u) const {
        const int L = i * G + c; if (L >= cp[8] * ncol) return false;
        const int p = L / ncol, j = L % ncol; int e = 0;
#pragma unroll
        for (int q = 1; q < 8; ++q) e += (p >= cp[q]) ? 1 : 0;
        u.pm = p; u.pn = e; u.aux = j; u.aoff = (size_t)p * 256 * lda * 2; u.boff = ((size_t)e * nrowB + (size_t)j * 256) * ldb * 2; return true;
    }
};

typedef const f32x4 (&AccRef)[2][2][4][2];
#define EPI_ROWS(u) _Pragma("unroll") for (int ai = 0; ai < 2; ++ai) _Pragma("unroll") for (int m = 0; m < 4; ++m)
#define EPI_ROW(u) ((u).pm * 256 + ai * 128 + wr * 64 + m * 16 + fr)
DI u32x4 pack8(const f32x4 a, const f32x4 b) { u32x4 w; w.x = cvt_pk_bf16(a[0], a[1]); w.y = cvt_pk_bf16(a[2], a[3]); w.z = cvt_pk_bf16(b[0], b[1]); w.w = cvt_pk_bf16(b[2], b[3]); return w; }
DI void unpack8(const u32x4 w, f32x4& a, f32x4& b) { a = (f32x4){bflo(w.x), bfhi(w.x), bflo(w.y), bfhi(w.y)}; b = (f32x4){bflo(w.z), bfhi(w.z), bflo(w.w), bfhi(w.w)}; }

struct EpiWin {
    bf16_t* P;
    DI void operator()(AccRef acc, const Unit& u, int wr, int wc, int fr, int fq) const {
        asm volatile("" : "+v"(fr), "+v"(fq));
        const bool sig = u.pn >= 10;
        EPI_ROWS(u) { bf16_t* rp = P + (size_t)EPI_ROW(u) * LDP + u.pn * 256 + wc * 32 + fq * 8;
#pragma unroll
            for (int bj = 0; bj < 2; ++bj) { f32x4 a = acc[ai][bj][m][0], b = acc[ai][bj][m][1];
                if (sig) {
#pragma unroll
                    for (int j = 0; j < 4; ++j) { a[j] = sigmoidf_(a[j]); b[j] = sigmoidf_(b[j]); } }
                *(u32x4*)(rp + bj * 128) = pack8(a, b); } }
    }
};
struct EpiL3B {
    bf16_t* T; bf16_t* Qm; bf16_t* Km; bf16_t* Vm; const float* rope32;
    DI void operator()(AccRef acc, const Unit& u, int wr, int wc, int fr, int fq) const {
        asm volatile("" : "+v"(fr), "+v"(fq));
        const int grp = u.aux, pn = u.pn;
        EPI_ROWS(u) { const int row = EPI_ROW(u);
#pragma unroll
            for (int bj = 0; bj < 2; ++bj) { f32x4 a = acc[ai][bj][m][0], b = acc[ai][bj][m][1]; const int ct = bj * 128 + wc * 32 + fq * 8;
                if (grp == 0) {
                    if (pn < 2) {
#pragma unroll
                        for (int j = 0; j < 4; ++j) { a[j] = tanhf_(a[j]); b[j] = tanhf_(b[j]); } }
                    else if (pn == 5) {
#pragma unroll
                        for (int j = 0; j < 4; ++j) { a[j] = sigmoidf_(a[j]); b[j] = sigmoidf_(b[j]); } }
                    *(u32x4*)(T + (size_t)row * 1536 + pn * 256 + ct) = pack8(a, b);
                } else if (grp == 1) {
                    const int col = pn * 256 + ct;
                    if (col < 384) {
                        const int within = col % 96; const int pos = row % TPB;
                        if (within >= 64 && pos >= CTXL) {
                            const float* rt = rope32 + ((size_t)(pos - CTXL) * 16 + ((within - 64) >> 1)) * 2;
                            const f32x4 cs0 = *(const f32x4*)rt, cs1 = *(const f32x4*)(rt + 4);
                            const f32x4 a2 = (f32x4){a[0] * cs0[0] - a[1] * cs0[1], a[0] * cs0[1] + a[1] * cs0[0], a[2] * cs0[2] - a[3] * cs0[3], a[2] * cs0[3] + a[3] * cs0[2]};
                            const f32x4 b2 = (f32x4){b[0] * cs1[0] - b[1] * cs1[1], b[0] * cs1[1] + b[1] * cs1[0], b[2] * cs1[2] - b[3] * cs1[3], b[2] * cs1[3] + b[3] * cs1[2]};
                            a = a2; b = b2;
                        }
                        a = a * QS96; b = b * QS96;
                        *(u32x4*)(Qm + (size_t)row * 384 + col) = pack8(a, b);
                    }
                } else {
                    const int col = pn * 256 + ct, head = col >> 7, within = col & 127;
                    if (within < 64) *(u32x4*)(Km + (size_t)row * 384 + head * 96 + within) = pack8(a, b);
                    else *(u32x4*)(Vm + (size_t)row * 256 + head * 64 + (within - 64)) = pack8(a, b);
                }
            } asm volatile("" ::: "memory"); }
    }
};
struct EpiL3C {
    int layer; const float* w0; const float* a0; const float* v0; const float* k_a;
    float* W; bf16_t* KD; bf16_t* BB; const bf16_t* Kr; const bf16_t* KK; bf16_t* V; const bf16_t* VF; bf16_t* Gg;
    DI void operator()(AccRef acc, const Unit& u, int wr, int wc, int fr, int fq) const {
        asm volatile("" : "+v"(fr), "+v"(fq));
        const int pn = u.pn;
        EPI_ROWS(u) { const int row = EPI_ROW(u);
#pragma unroll
            for (int bj = 0; bj < 2; ++bj) { f32x4 a = acc[ai][bj][m][0], b = acc[ai][bj][m][1]; const int ct = bj * 128 + wc * 32 + fq * 8;
                if (pn < 2) {
                    const f32x4 wa = *(const f32x4*)(w0 + pn * 256 + ct), wb = *(const f32x4*)(w0 + pn * 256 + ct + 4);
                    f32x4 oa, ob;
#pragma unroll
                    for (int j = 0; j < 4; ++j) { oa[j] = fast_exp2(-0.6065306597f * LOG2E * sigmoidf_(wa[j] + a[j])); ob[j] = fast_exp2(-0.6065306597f * LOG2E * sigmoidf_(wb[j] + b[j])); }
                    float* wp = W + (size_t)row * 512 + pn * 256 + ct; *(f32x4*)wp = oa; *(f32x4*)(wp + 4) = ob;
                } else if (pn < 4) {
                    const int d = pn - 2;
                    const f32x4 aa = *(const f32x4*)(a0 + d * 256 + ct), ab = *(const f32x4*)(a0 + d * 256 + ct + 4);
                    const f32x4 ka = *(const f32x4*)(k_a + ct), kb = *(const f32x4*)(k_a + ct + 4);
                    f32x4 k0, k1, q0, q1; unpack8(*(const u32x4*)(Kr + (size_t)row * 256 + ct), k0, k1); unpack8(*(const u32x4*)(KK + (size_t)row * 256 + ct), q0, q1);
                    f32x4 kd0, kd1, bb0, bb1;
#pragma unroll
                    for (int j = 0; j < 4; ++j) { const float s0 = sigmoidf_(aa[j] + a[j]), s1 = sigmoidf_(ab[j] + b[j]);
                        kd0[j] = k0[j] * (1.0f + (s0 - 1.0f) * ka[j]); kd1[j] = k1[j] * (1.0f + (s1 - 1.0f) * kb[j]); bb0[j] = q0[j] * s0; bb1[j] = q1[j] * s1; }
                    *(u32x4*)(KD + (size_t)row * 512 + d * 256 + ct) = pack8(kd0, kd1); *(u32x4*)(BB + (size_t)row * 512 + d * 256 + ct) = pack8(bb0, bb1);
                } else if (pn == 4) {
                    const f32x4 va = *(const f32x4*)(v0 + ct), vb = *(const f32x4*)(v0 + ct + 4);
                    f32x4 r0, r1, f0, f1; unpack8(*(const u32x4*)(V + (size_t)row * 256 + ct), r0, r1); unpack8(*(const u32x4*)(VF + (size_t)row * 256 + ct), f0, f1);
#pragma unroll
                    for (int j = 0; j < 4; ++j) { r0[j] = r0[j] + (f0[j] - r0[j]) * sigmoidf_(va[j] + a[j]); r1[j] = r1[j] + (f1[j] - r1[j]) * sigmoidf_(vb[j] + b[j]); }
                    *(u32x4*)(V + (size_t)row * 256 + ct) = pack8(r0, r1);
                } else {
                    *(u32x4*)(Gg + (size_t)row * 256 + ct) = pack8(a, b);
                }
                asm volatile("" ::: "memory");
            } }
    }
};
struct EpiMerge {
    const bf16_t* P; bf16_t* MB;
    DI void operator()(AccRef acc, const Unit& u, int wr, int wc, int fr, int fq) const {
        asm volatile("" : "+v"(fr), "+v"(fq));
        const int br = u.aux;
        EPI_ROWS(u) { const int row = EPI_ROW(u);
#pragma unroll
            for (int bj = 0; bj < 2; ++bj) { f32x4 a = acc[ai][bj][m][0], b = acc[ai][bj][m][1]; const int col = u.pn * 256 + bj * 128 + wc * 32 + fq * 8;
                f32x4 g0, g1; unpack8(*(const u32x4*)(P + (size_t)row * LDP + PC_GATE + br * 1024 + col), g0, g1);
                a = a * g0; b = b * g1;
                bf16_t* mp = MB + (size_t)row * 1024 + col;
                if (br > 0) { f32x4 p0, p1; unpack8(*(const u32x4*)mp, p0, p1); a = a + p0; b = b + p1; }
                *(u32x4*)mp = pack8(a, b); } asm volatile("" ::: "memory"); }
    }
};
struct EpiResid {
    float* X; const float* mod_l; int which;
    DI void operator()(AccRef acc, const Unit& u, int wr, int wc, int fr, int fq) const {
        asm volatile("" : "+v"(fr), "+v"(fq));
        const int vec = (u.pm % 33 == 0) ? 2 : u.pm / 33;
        const float* gv = mod_l + ((size_t)vec * 6 + which) * 1024 + u.pn * 256 + wc * 32 + fq * 8;
        f32x4 g[2][2];
#pragma unroll
        for (int bj = 0; bj < 2; ++bj) { g[bj][0] = *(const f32x4*)(gv + bj * 128); g[bj][1] = *(const f32x4*)(gv + bj * 128 + 4); }
        EPI_ROWS(u) { float* xp = X + (size_t)EPI_ROW(u) * 1024 + u.pn * 256 + wc * 32 + fq * 8;
#pragma unroll
            for (int bj = 0; bj < 2; ++bj) { f32x4 x0 = *(f32x4*)(xp + bj * 128), x1 = *(f32x4*)(xp + bj * 128 + 4);
                x0 = x0 + g[bj][0] * acc[ai][bj][m][0]; x1 = x1 + g[bj][1] * acc[ai][bj][m][1];
                *(f32x4*)(xp + bj * 128) = x0; *(f32x4*)(xp + bj * 128 + 4) = x1; } asm volatile("" ::: "memory"); }
    }
};
struct EpiSwiGlu {
    bf16_t* U; int moe;
    DI void operator()(AccRef acc, const Unit& u, int wr, int wc, int fr, int fq) const {
        asm volatile("" : "+v"(fr), "+v"(fq));
        const int tile = moe ? u.aux : u.pn;
        EPI_ROWS(u) { bf16_t* up = U + (size_t)EPI_ROW(u) * DFF + tile * 128 + wc * 32 + fq * 8;
            f32x4 a = acc[ai][0][m][0], b = acc[ai][0][m][1]; const f32x4 c = acc[ai][1][m][0], d = acc[ai][1][m][1];
#pragma unroll
            for (int j = 0; j < 4; ++j) { a[j] = siluf_(a[j]) * c[j]; b[j] = siluf_(b[j]) * d[j]; }
            *(u32x4*)up = pack8(a, b); }
    }
};
struct EpiMoeDown {
    bf16_t* Yg; const float* rowgate;
    DI void operator()(AccRef acc, const Unit& u, int wr, int wc, int fr, int fq) const {
        asm volatile("" : "+v"(fr), "+v"(fq));
        EPI_ROWS(u) { const int row = EPI_ROW(u); const float gt = rowgate[row]; bf16_t* yp = Yg + (size_t)row * 1024 + u.aux * 256 + wc * 32 + fq * 8;
#pragma unroll
            for (int bj = 0; bj < 2; ++bj) *(u32x4*)(yp + bj * 128) = pack8(acc[ai][bj][m][0] * gt, acc[ai][bj][m][1] * gt); }
    }
};
struct ConvMat { const float* s0; const float* s1; int ld; int ksrc; bf16_t* dst; int N; int K; int kind; int nvalid; };
DI int perm64(int i) { return (i >> 1) + 32 * (i & 1); }
DI int perm32r(int i) { return (i >> 1) + 16 * (i & 1); }
DI const float* conv_col(const ConvMat& M, int n) {
    if (M.kind == 0) return n < M.nvalid ? M.s0 + n : nullptr;
    if (M.kind == 1) {
        int col;
        if (n < 1024) col = n;
        else if (n < 1280) { const int j = n - 1024; col = 1024 + (j & ~63) + perm64(j & 63); }
        else if (n < 1408) { const int j = n - 1280; col = 1280 + (j & ~63) + perm64(j & 63); }
        else if (n < 1920) col = n;
        else if (n < 1952) col = 1920 + perm32r(n - 1920);
        else if (n < 2048) return nullptr;
        else if (n < 2304) { const int j = n - 2048; col = 1952 + (j & ~63) + perm64(j & 63); }
        else if (n < 2432) { const int j = n - 2304; col = 2208 + (j & ~63) + perm64(j & 63); }
        else if (n < 2560) col = 2336 + (n - 2432);
        else col = 2464 + (n - 2560);
        return M.s0 + col;
    }
    if (M.kind == 2) {
        if (n >= 384) return nullptr;
        const int h = n / 96, w = n % 96;
        return M.s0 + (w < 64 ? n : h * 96 + 64 + perm32r(w - 64));
    }
    {
        const int t = n >> 8, half = (n >> 7) & 1, j = n & 127;
        return (const float*)((uintptr_t)M.s0 + (uintptr_t)half * ((uintptr_t)M.s1 - (uintptr_t)M.s0)) + t * 128 + j;
    }
}
DI void conv_item(const ConvMat& M, int item, LAS float* scr, int lane) {
    const int nkb = M.K / 64, nb = item / nkb, kb = item % nkb, n0 = nb * 32, k0 = kb * 64;
    const float* cp = conv_col(M, n0 + (lane & 31));
#pragma unroll 8
    for (int i = 0; i < 32; ++i) { const int kk = 2 * i + (lane >> 5); const int k = k0 + kk;
        float v = 0.f; if (cp != nullptr && k < M.ksrc) v = cp[(size_t)k * M.ld];
        scr[kk * 33 + (lane & 31)] = v; }
    LDS_WAIT(); asm volatile("" ::: "memory");
    const int c = lane & 7;
#pragma unroll
    for (int j = 0; j < 4; ++j) { const int n = (lane >> 3) + 8 * j; const LAS float* s = scr + (8 * c) * 33 + n;
        u32x4 o; o.x = pk2(s[0 * 33], s[1 * 33]); o.y = pk2(s[2 * 33], s[3 * 33]); o.z = pk2(s[4 * 33], s[5 * 33]); o.w = pk2(s[6 * 33], s[7 * 33]);
        *(u32x4*)(M.dst + (size_t)(n0 + n) * M.K + k0 + 8 * c) = o; }
    LDS_WAIT(); asm volatile("" ::: "memory");
}
DI ConvMat mkmat(const float* s0, const float* s1, int ld, int ksrc, bf16_t* dst, int N, int K, int kind, int nvalid) { ConvMat M; M.s0 = s0; M.s1 = s1; M.ld = ld; M.ksrc = ksrc; M.dst = dst; M.N = N; M.K = K; M.kind = kind; M.nvalid = nvalid; return M; }
DI void conv_run(Frame& F, const ConvMat M, int& start) {
    LAS float* scr = (LAS float*)(F.lds + F.wave * 16384);
    const int gw = F.vcu * 8 + F.wave, NGW = F.G * 8;
    const int nitems = (M.N / 32) * (M.K / 64);
    int it = (gw - start) % NGW; if (it < 0) it += NGW;
    for (; it < nitems; it += NGW) conv_item(M, it, scr, F.lane);
    start = (start + nitems) % NGW;
}
DI void convert_layer_weights(Frame& F, int l) {
    unsigned char* wl = F.ws + WS_WL;
    int start = 0;
    conv_run(F, mkmat(inp(I_WIN) + (size_t)l * 1024 * IN_W, nullptr, IN_W, 1024, (bf16_t*)(wl + WL_WIN), NP_GEMM, 1024, 1, NP_GEMM), start);
    for (int i = 0; i < 4; ++i) conv_run(F, mkmat(inp(I_WBR) + (size_t)(l * 4 + i) * 256 * 1024, nullptr, 1024, 256, (bf16_t*)(wl + WL_WBR) + (size_t)i * 1024 * 256, 1024, 256, 0, 1024), start);
    conv_run(F, mkmat(inp(I_WOUT) + (size_t)l * 1024 * 1024, nullptr, 1024, 1024, (bf16_t*)(wl + WL_WOUT), 1024, 1024, 0, 1024), start);
    for (int d = 0; d < 2; ++d) conv_run(F, mkmat(inp(I_W1) + (size_t)(l * 2 + d) * 256 * 64, nullptr, 64, 256, (bf16_t*)(wl + WL_L1) + (size_t)d * 256 * 256, 256, 256, 0, 64), start);
    for (int d = 0; d < 2; ++d) conv_run(F, mkmat(inp(I_A1) + (size_t)(l * 2 + d) * 256 * 64, nullptr, 64, 256, (bf16_t*)(wl + WL_L1) + (size_t)(2 + d) * 256 * 256, 256, 256, 0, 64), start);
    conv_run(F, mkmat(inp(I_V1) + (size_t)(l > 0 ? l - 1 : 0) * 256 * 32, nullptr, 32, 256, (bf16_t*)(wl + WL_L1) + (size_t)4 * 256 * 256, 256, 256, 0, l > 0 ? 32 : 0), start);
    conv_run(F, mkmat(inp(I_G1) + (size_t)l * 256 * 128, nullptr, 128, 256, (bf16_t*)(wl + WL_L1) + (size_t)5 * 256 * 256, 256, 256, 0, 128), start);
    for (int d = 0; d < 2; ++d) conv_run(F, mkmat(inp(I_W2) + (size_t)(l * 2 + d) * 64 * 256, nullptr, 256, 64, (bf16_t*)(wl + WL_L2) + (size_t)d * 256 * 256, 256, 256, 0, 256), start);
    for (int d = 0; d < 2; ++d) conv_run(F, mkmat(inp(I_A2) + (size_t)(l * 2 + d) * 64 * 256, nullptr, 256, 64, (bf16_t*)(wl + WL_L2) + (size_t)(2 + d) * 256 * 256, 256, 256, 0, 256), start);
    conv_run(F, mkmat(inp(I_V2) + (size_t)(l > 0 ? l - 1 : 0) * 32 * 256, nullptr, 256, l > 0 ? 32 : 0, (bf16_t*)(wl + WL_L2) + (size_t)4 * 256 * 256, 256, 256, 0, 256), start);
    conv_run(F, mkmat(inp(I_G2) + (size_t)l * 128 * 256, nullptr, 256, 128, (bf16_t*)(wl + WL_L2) + (size_t)5 * 256 * 256, 256, 256, 0, 256), start);
    conv_run(F, mkmat(inp(I_WUQ) + (size_t)l * 256 * 384, nullptr, 384, 256, (bf16_t*)(wl + WL_UQ), 512, 256, 2, 384), start);
    conv_run(F, mkmat(inp(I_WUKV) + (size_t)l * 128 * 512, nullptr, 512, 128, (bf16_t*)(wl + WL_UKV), 512, 256, 0, 512), start);
    if ((l & 1) == 0) {
        conv_run(F, mkmat(inp(I_FW1) + (size_t)(l >> 1) * 1024 * DFF, inp(I_FW3) + (size_t)(l >> 1) * 1024 * DFF, DFF, 1024, (bf16_t*)(wl + WL_W13), 7168, 1024, 3, 7168), start);
        conv_run(F, mkmat(inp(I_FW2) + (size_t)(l >> 1) * DFF * 1024, nullptr, 1024, DFF, (bf16_t*)(wl + WL_W2), 1024, DFF, 0, 1024), start);
    } else {
        for (int e = 0; e < NEXP; ++e) { const size_t eo = (size_t)((l >> 1) * NEXP + e) * 1024 * DFF;
            conv_run(F, mkmat(inp(I_MW1) + eo, inp(I_MW3) + eo, DFF, 1024, (bf16_t*)(wl + WL_W13) + (size_t)e * 7168 * 1024, 7168, 1024, 3, 7168), start); }
        for (int e = 0; e < NEXP; ++e)
            conv_run(F, mkmat(inp(I_MW2) + (size_t)((l >> 1) * NEXP + e) * DFF * 1024, nullptr, 1024, DFF, (bf16_t*)(wl + WL_W2) + (size_t)e * 1024 * DFF, 1024, DFF, 0, 1024), start);
    }
}

DI void p0_prologue(Frame& F) {
    const int gw = F.vcu * 8 + F.wave, NGW = F.G * 8;
    for (int r = gw; r < NROW; r += NGW) {
        const int b = r / TPB, pos = r % TPB;
        const float* src = pos < CTXL ? inp(I_CTX) + ((size_t)b * CTXL + pos) * 1024 : inp(I_X) + ((size_t)b * SEQ + (pos - CTXL)) * 1024;
        const f32x4* s4 = (const f32x4*)src + F.lane; f32x4* d4 = (f32x4*)(FX(F) + (size_t)r * 1024) + F.lane;
#pragma unroll
        for (int j = 0; j < 4; ++j) d4[64 * j] = s4[64 * j];
    }
    {
        float* r64 = (float*)(F.ws + WS_ROPE64); float* r32 = (float*)(F.ws + WS_ROPE32);
        const int gt = (F.vcu * 512 + F.tid), NT = F.G * 512;
        for (int i = gt; i < SEQ * 48; i += NT) {
            const int t = i / 48, q = i % 48; const float row = (float)(t / GRIDW), col = (float)(t % GRIDW);
            float ang;
            if (q < 32) { const int f = q & 15; ang = (q < 16 ? row : col) * powf(10000.0f, -(float)f / 16.0f); }
            else { const int p = q - 32, f = p & 7; ang = (p < 8 ? row : col) * powf(10000.0f, -(float)f / 8.0f); }
            float sn, cs; sincosf(ang, &sn, &cs);
            if (q < 32) { r64[((size_t)t * 32 + q) * 2] = cs; r64[((size_t)t * 32 + q) * 2 + 1] = sn; }
            else { r32[((size_t)t * 16 + (q - 32)) * 2] = cs; r32[((size_t)t * 16 + (q - 32)) * 2 + 1] = sn; }
        }
    }
    {
        LAS float* sl = (LAS float*)F.lds;
        LAS float* red = sl + 3072;
        for (int i = F.tid; i < 3072; i += 512) { const int v = i >> 10, k = i & 1023; const float cvv = v < 2 ? inp(I_C)[v * 1024 + k] : inp(I_CCTX)[k]; sl[i] = siluf_(cvv); }
        __syncthreads();
        const int j = F.tid & 63, ks = F.tid >> 6;
        for (int ch = F.vcu; ch < 4 * 96; ch += F.G) {
            const int l = ch / 96, jb = (ch % 96) * 64 + j;
            const float* wp = inp(I_WMOD) + (size_t)l * 1024 * 6144 + jb;
            float a0 = 0.f, a1 = 0.f, a2 = 0.f;
            for (int k = ks * 128; k < ks * 128 + 128; ++k) { const float w = wp[(size_t)k * 6144]; a0 += sl[k] * w; a1 += sl[1024 + k] * w; a2 += sl[2048 + k] * w; }
            red[(ks * 3 + 0) * 64 + j] = a0; red[(ks * 3 + 1) * 64 + j] = a1; red[(ks * 3 + 2) * 64 + j] = a2;
            __syncthreads();
            if (F.tid < 192) { const int v = F.tid >> 6; float s = 0.f;
#pragma unroll
                for (int q = 0; q < 8; ++q) s += red[(q * 3 + v) * 64 + j];
                FMOD(F)[(size_t)(l * 3 + v) * 6144 + jb] = s + inp(I_BMOD)[l * 6144 + jb]; }
            __syncthreads();
        }
    }
}

template <int MODE>
DI void norm_phase(Frame& F, int l) {
    const int rpw = (NROW + F.G - 1) / F.G;
    const int bid = blockIdx.x;
    const int r0 = bid * rpw, r1 = (r0 + rpw) < NROW ? (r0 + rpw) : NROW;
    const bool combine = (MODE == 0 && l > 0 && ((l - 1) & 1)) || MODE == 2;
    const int lprev = MODE == 2 ? DEPTH - 1 : l - 1;
    const bool moe = (MODE == 1) && (l & 1);
    const float* nw = MODE == 0 ? inp(I_NORM1) + l * 1024 : MODE == 1 ? inp(I_NORM2) + l * 1024 : inp(I_FNORM);
    const bf16_t* Yg = (const bf16_t*)(F.ws + WS_YG);
    const int* dstp = (const int*)(F.ws + WS_ASG_DST);
    volatile LAS int* hist = (volatile LAS int*)(F.lds + MISC_OFF + 64);
    if (moe) { if (F.tid < 8) hist[F.tid] = 0; __syncthreads(); }
    for (int r = r0 + F.wave; r < r1; r += 8) {
        const int vec = row_vec(r);
        float* xr = FX(F) + (size_t)r * 1024;
        f32x4 x[4];
#pragma unroll
        for (int j = 0; j < 4; ++j) x[j] = *((const f32x4*)xr + F.lane + 64 * j);
        if (combine) {
            const int d0 = dstp[r * 2], d1 = dstp[r * 2 + 1];
            const float* g2 = modp(F, lprev, vec, 5);
#pragma unroll
            for (int j = 0; j < 4; ++j) { const int c = 4 * F.lane + 256 * j;
                const u32x2 y0 = *(const u32x2*)(Yg + (size_t)d0 * 1024 + c), y1 = *(const u32x2*)(Yg + (size_t)d1 * 1024 + c); const f32x4 g = *(const f32x4*)(g2 + c);
                x[j][0] += g[0] * (bflo(y0.x) + bflo(y1.x)); x[j][1] += g[1] * (bfhi(y0.x) + bfhi(y1.x)); x[j][2] += g[2] * (bflo(y0.y) + bflo(y1.y)); x[j][3] += g[3] * (bfhi(y0.y) + bfhi(y1.y));
                if (MODE == 0) *((f32x4*)xr + F.lane + 64 * j) = x[j]; }
        }
        float ss = 0.f;
#pragma unroll
        for (int j = 0; j < 4; ++j) ss += (x[j][0] * x[j][0] + x[j][1] * x[j][1]) + (x[j][2] * x[j][2] + x[j][3] * x[j][3]);
        const float rstd = 1.0f / sqrtf(wave_sum(ss) * (1.0f / 1024.0f) + 1e-6f);
        if (MODE == 2) {
            const int pos = r % TPB;
            if (pos >= CTXL) { float* op = F.out + ((size_t)(r / TPB) * SEQ + (pos - CTXL)) * 1024;
#pragma unroll
                for (int j = 0; j < 4; ++j) { const f32x4 w = *(const f32x4*)(nw + 4 * F.lane + 256 * j); *((f32x4*)op + F.lane + 64 * j) = x[j] * rstd * w; } }
            continue;
        }
        const float* sc = modp(F, l, vec, MODE == 0 ? 1 : 4); const float* sh = modp(F, l, vec, MODE == 0 ? 0 : 3);
        f32x4 h[4];
#pragma unroll
        for (int j = 0; j < 4; ++j) { const int c = 4 * F.lane + 256 * j; const f32x4 w = *(const f32x4*)(nw + c), s1 = *(const f32x4*)(sc + c), s0 = *(const f32x4*)(sh + c);
            h[j] = (x[j] * rstd * w) * (1.0f + s1) + s0;
            u32x2 o; o.x = pk2(h[j][0], h[j][1]); o.y = pk2(h[j][2], h[j][3]); *(u32x2*)(FHB(F) + (size_t)r * 1024 + c) = o; }
        if (moe) {
            const float* wr = inp(I_ROUTER) + (size_t)(l >> 1) * 1024 * NEXP;
            float lg[8];
#pragma unroll
            for (int e = 0; e < 8; ++e) lg[e] = 0.f;
#pragma unroll
            for (int j = 0; j < 4; ++j)
#pragma unroll
                for (int q = 0; q < 4; ++q) { const int c = 4 * F.lane + 256 * j + q; const f32x4 w0 = *(const f32x4*)(wr + (size_t)c * 8), w1 = *(const f32x4*)(wr + (size_t)c * 8 + 4); const float hv = h[j][q];
                    lg[0] += hv * w0[0]; lg[1] += hv * w0[1]; lg[2] += hv * w0[2]; lg[3] += hv * w0[3]; lg[4] += hv * w1[0]; lg[5] += hv * w1[1]; lg[6] += hv * w1[2]; lg[7] += hv * w1[3]; }
#pragma unroll
            for (int e = 0; e < 8; ++e) lg[e] = wave_sum(lg[e]);
            int e1 = 0; float l1 = lg[0];
#pragma unroll
            for (int e = 1; e < 8; ++e) if (lg[e] > l1) { l1 = lg[e]; e1 = e; }
            int e2 = -1; float l2 = -3.0e38f;
#pragma unroll
            for (int e = 0; e < 8; ++e) if (e != e1 && lg[e] > l2) { l2 = lg[e]; e2 = e; }
            if (e2 < 0) e2 = (e1 + 1) & 7;
            if (F.lane == 0) {
                const float ex = __expf(l2 - l1); const float g1v = 1.0f / (1.0f + ex), g2v = ex / (1.0f + ex);
                const int lp1 = __hip_atomic_fetch_add((LAS int*)&hist[e1], 1, __ATOMIC_RELAXED, __HIP_MEMORY_SCOPE_WORKGROUP);
                const int lp2 = __hip_atomic_fetch_add((LAS int*)&hist[e2], 1, __ATOMIC_RELAXED, __HIP_MEMORY_SCOPE_WORKGROUP);
                int* asg = (int*)(F.ws + WS_ASG) + (size_t)r * 4; asg[0] = e1 | (e2 << 8); asg[1] = lp1; asg[2] = lp2;
                float* ag = (float*)(F.ws + WS_ASG_GATE) + (size_t)r * 2; ag[0] = g1v; ag[1] = g2v;
            }
        }
    }
    if (moe) {
        __syncthreads();
        if (F.tid < 8) { const int cnt = hist[F.tid]; const int bank = l >> 1;
            const unsigned base = cnt > 0 ? __hip_atomic_fetch_add(F.ctl + CW_MOECNT + bank * 64 + F.tid, (unsigned)cnt, __ATOMIC_RELAXED, __HIP_MEMORY_SCOPE_AGENT) : 0u;
            F.ctl[CW_WGBASE + (bank * 256 + bid) * 8 + F.tid] = base; }
    }
}
DI void moe_panels(const Frame& F, int l, int (&cp)[9]) {
    int acc = 0;
#pragma unroll
    for (int e = 0; e < 8; ++e) { cp[e] = acc; const unsigned c = __hip_atomic_load(F.ctl + CW_MOECNT + (l >> 1) * 64 + e, __ATOMIC_RELAXED, __HIP_MEMORY_SCOPE_AGENT); acc += (int)((c + 255u) >> 8); }
    cp[8] = acc;
#pragma unroll
    for (int e = 0; e < 9; ++e) cp[e] = __builtin_amdgcn_readfirstlane(cp[e]);
}
DI void moe_gather(Frame& F, int l) {
    int cp[9]; moe_panels(F, l, cp);
    const int rpw = (NROW + F.G - 1) / F.G; const int bid = blockIdx.x;
    const int r0 = bid * rpw, r1 = (r0 + rpw) < NROW ? (r0 + rpw) : NROW;
    bf16_t* Xg = (bf16_t*)(F.ws + WS_XG); float* rowgate = (float*)(F.ws + WS_ROWGATE); int* dstp = (int*)(F.ws + WS_ASG_DST);
    const unsigned* wgb = F.ctl + CW_WGBASE + ((l >> 1) * 256 + bid) * 8;
    for (int r = r0 + F.wave; r < r1; r += 8) {
        const int* asg = (const int*)(F.ws + WS_ASG) + (size_t)r * 4; const float* ag = (const float*)(F.ws + WS_ASG_GATE) + (size_t)r * 2;
        const int ee = asg[0], e1 = ee & 255, e2 = ee >> 8;
        int cpa = 0, cpb = 0;
#pragma unroll
        for (int e = 0; e < 8; ++e) { cpa = (e == e1) ? cp[e] : cpa; cpb = (e == e2) ? cp[e] : cpb; }
        const int d0 = cpa * 256 + (int)wgb[e1] + asg[1], d1 = cpb * 256 + (int)wgb[e2] + asg[2];
        const u32x4* src = (const u32x4*)(FHB(F) + (size_t)r * 1024) + F.lane;
        const u32x4 v0 = src[0], v1 = src[64];
        u32x4* p0 = (u32x4*)(Xg + (size_t)d0 * 1024) + F.lane; u32x4* p1 = (u32x4*)(Xg + (size_t)d1 * 1024) + F.lane;
        p0[0] = v0; p0[64] = v1; p1[0] = v0; p1[64] = v1;
        if (F.lane == 0) { rowgate[d0] = ag[0]; rowgate[d1] = ag[1]; dstp[r * 2] = d0; dstp[r * 2 + 1] = d1; }
    }
}

DI f32x4 ld4bf(const bf16_t* p) { const u32x2 w = *(const u32x2*)p; return (f32x4){bflo(w.x), bfhi(w.x), bflo(w.y), bfhi(w.y)}; }
DI void st4bf(bf16_t* p, const f32x4 v) { u32x2 o; o.x = pk2(v[0], v[1]); o.y = pk2(v[2], v[3]); *(u32x2*)p = o; }
DI f32x4 rope2(const f32x4 v, const float* cs) {
    const f32x4 t = *(const f32x4*)cs;
    return (f32x4){v[0] * t[0] - v[1] * t[1], v[0] * t[1] + v[1] * t[0], v[2] * t[2] - v[3] * t[3], v[2] * t[3] + v[3] * t[2]};
}
DI void prep_phase(Frame& F, int l) {
    const int gw = F.vcu * 8 + F.wave, NGW = F.G * 8, lane = F.lane;
    bf16_t* RR = (bf16_t*)(F.ws + WS_RR); bf16_t* KK = (bf16_t*)(F.ws + WS_KK); bf16_t* KR = (bf16_t*)(F.ws + WS_KR); bf16_t* V = (bf16_t*)(F.ws + WS_V); bf16_t* VF = (bf16_t*)(F.ws + WS_VF);
    bf16_t* Km = (bf16_t*)(F.ws + WS_KMLA);
    const float* r64 = (const float*)(F.ws + WS_ROPE64); const float* r32 = (const float*)(F.ws + WS_ROPE32);
    const float* mu = inp(I_MU) + (size_t)l * 2048;
    const int c4 = 4 * lane;
    for (int r = gw; r < NROW; r += NGW) {
        const int pos = r % TPB; const bool isctx = pos < CTXL; const int t = pos - CTXL;
        const bool hasp = isctx ? (pos > 0) : (t > 0), hasn = isctx ? (pos < CTXL - 1) : (t < SEQ - 1);
        bf16_t* pr = FP(F) + (size_t)r * LDP;
#pragma unroll
        for (int s = 0; s < 4; ++s) {
            const f32x4 f = ld4bf(pr + s * 256 + c4);
            const f32x4 fp = hasp ? ld4bf(pr - LDP + s * 256 + c4) : (f32x4){0.f, 0.f, 0.f, 0.f};
            const f32x4 fn = hasn ? ld4bf(pr + LDP + s * 256 + c4) : (f32x4){0.f, 0.f, 0.f, 0.f};
            const f32x4 m0 = *(const f32x4*)(mu + s * 256 + c4), m1 = *(const f32x4*)(mu + 1024 + s * 256 + c4);
            const f32x4 o = f + m0 * (fp - f) + m1 * (fn - f);
            if (s == 0) st4bf(RR + (size_t)r * 256 + c4, o);
            else if (s == 1) {
                st4bf(KR + (size_t)r * 256 + c4, o);
                const f32x4 kx = o * *(const f32x4*)(inp(I_KK) + l * 256 + c4);
                const float ss = sum16((kx[0] * kx[0] + kx[1] * kx[1]) + (kx[2] * kx[2] + kx[3] * kx[3]));
                st4bf(KK + (size_t)r * 256 + c4, kx * (1.0f / sqrtf(ss + 1e-12f)));
            } else if (s == 2) { st4bf(V + (size_t)r * 256 + c4, o); if (l == 0) st4bf(VF + (size_t)r * 256 + c4, o); }
            else st4bf(pr + PC_Z + c4, o);
        }
        {
            f32x4 q = ld4bf(pr + PC_SWQ + c4);
            const int pi = (c4 & 63) >> 1;
            if (!isctx) q = rope2(q, r64 + ((size_t)t * 32 + pi) * 2);
            st4bf(pr + PC_SWQ + c4, q * QS64);
            if (lane < 32) { f32x4 k = ld4bf(pr + PC_SWK + c4); if (!isctx) { k = rope2(k, r64 + ((size_t)t * 32 + pi) * 2); st4bf(pr + PC_SWK + c4, k); } }
        }
        {
            f32x4 q = ld4bf(pr + PC_CQ + c4);
            const float ss = wave_sum((q[0] * q[0] + q[1] * q[1]) + (q[2] * q[2] + q[3] * q[3]));
            q = q * (1.0f / sqrtf(ss * (1.0f / 256.0f) + 1e-6f)) * *(const f32x4*)(inp(I_MQN) + l * 256 + c4);
            st4bf(pr + PC_CQ + c4, q);
            f32x4 kv = lane < 32 ? ld4bf(pr + PC_CKV + c4) : (f32x4){0.f, 0.f, 0.f, 0.f};
            const float s2 = wave_sum((kv[0] * kv[0] + kv[1] * kv[1]) + (kv[2] * kv[2] + kv[3] * kv[3]));
            if (lane < 32) { kv = kv * (1.0f / sqrtf(s2 * (1.0f / 128.0f) + 1e-6f)) * *(const f32x4*)(inp(I_MKVN) + l * 128 + c4); st4bf(pr + PC_CKV + c4, kv); }
            if (lane < 8) { f32x4 kr = ld4bf(pr + PC_KR + c4); if (!isctx) kr = rope2(kr, r32 + ((size_t)t * 16 + 2 * lane) * 2);
#pragma unroll
                for (int h = 0; h < 4; ++h) st4bf(Km + (size_t)r * 384 + h * 96 + 64 + c4, kr); }
        }
        {
            const int i0 = c4 & 63; const int pi = i0 >> 1;
            f32x4 gq, gk;
#pragma unroll
            for (int j = 0; j < 4; ++j) { gq[j] = inp(I_GQN)[l * 64 + perm64(i0 + j)]; gk[j] = inp(I_GKN)[l * 64 + perm64(i0 + j)]; }
            f32x4 q = ld4bf(pr + PC_GAQ + c4);
            const float ss = sum16((q[0] * q[0] + q[1] * q[1]) + (q[2] * q[2] + q[3] * q[3]));
            q = q * (1.0f / sqrtf(ss * (1.0f / 64.0f) + 1e-6f)) * gq;
            if (!isctx) q = rope2(q, r64 + ((size_t)t * 32 + pi) * 2);
            st4bf(pr + PC_GAQ + c4, q * QS64);
            f32x4 k = lane < 32 ? ld4bf(pr + PC_GAK + c4) : (f32x4){0.f, 0.f, 0.f, 0.f};
            const float s2 = sum16((k[0] * k[0] + k[1] * k[1]) + (k[2] * k[2] + k[3] * k[3]));
            if (lane < 32) { k = k * (1.0f / sqrtf(s2 * (1.0f / 64.0f) + 1e-6f)) * gk; if (!isctx) k = rope2(k, r64 + ((size_t)t * 32 + pi) * 2); st4bf(pr + PC_GAK + c4, k); }
        }
    }
}

DI void finish_phase(Frame& F, int l) {
    const int gw = F.vcu * 8 + F.wave, NGW = F.G * 8, lane = F.lane, c4 = 4 * lane, hd = lane >> 4;
    const bf16_t* RR = (const bf16_t*)(F.ws + WS_RR); const bf16_t* KD = (const bf16_t*)(F.ws + WS_KD); const bf16_t* V = (const bf16_t*)(F.ws + WS_V); const bf16_t* Gg = (const bf16_t*)(F.ws + WS_G);
    const float* Y0 = (const float*)(F.ws + WS_YDIR); const float* Y1 = Y0 + (size_t)NROW * 256;
    const float* OP = (const float*)(F.ws + WS_OPART); const float* ML = (const float*)(F.ws + WS_ML);
    bf16_t* YA = (bf16_t*)(F.ws + WS_YALL);
    const f32x4 rk = *(const f32x4*)(inp(I_RK) + l * 256 + c4), lw = *(const f32x4*)(inp(I_LNW) + l * 256 + c4), lb = *(const f32x4*)(inp(I_LNB) + l * 256 + c4);
    for (int r = gw; r < NROW; r += NGW) {
        {
            const f32x4 y = *(const f32x4*)(Y0 + (size_t)r * 256 + c4) + *(const f32x4*)(Y1 + (size_t)r * 256 + c4);
            const float mean = sum16((y[0] + y[1]) + (y[2] + y[3])) * (1.0f / 64.0f);
            const f32x4 d = y - mean;
            const float var = sum16((d[0] * d[0] + d[1] * d[1]) + (d[2] * d[2] + d[3] * d[3])) * (1.0f / 64.0f);
            const f32x4 yn = d * (1.0f / sqrtf(var + 64e-5f)) * lw + lb;
            const f32x4 rr = ld4bf(RR + (size_t)r * 256 + c4), k0 = ld4bf(KD + (size_t)r * 512 + c4), k1 = ld4bf(KD + (size_t)r * 512 + 256 + c4), v = ld4bf(V + (size_t)r * 256 + c4), g = ld4bf(Gg + (size_t)r * 256 + c4);
            const f32x4 pr = rr * (k0 + k1) * rk;
            const float bon = sum16((pr[0] + pr[1]) + (pr[2] + pr[3]));
            st4bf(YA + (size_t)r * 1024 + c4, (yn + bon * v) * g);
        }
#pragma unroll
        for (int kind = 0; kind < 2; ++kind) {
            const float* m0p = ML + (((size_t)(kind * NSPLIT + 0) * NROW + r) * 4 + hd) * 2; const float* m1p = ML + (((size_t)(kind * NSPLIT + 1) * NROW + r) * 4 + hd) * 2;
            const float m0 = m0p[0], l0 = m0p[1], m1 = m1p[0], l1 = m1p[1];
            const float mm = m0 > m1 ? m0 : m1; const float w0 = fast_exp2(m0 - mm), w1 = fast_exp2(m1 - mm);
            const f32x4 o0 = *(const f32x4*)(OP + ((size_t)(kind * NSPLIT + 0) * NROW + r) * 256 + c4), o1 = *(const f32x4*)(OP + ((size_t)(kind * NSPLIT + 1) * NROW + r) * 256 + c4);
            const float inv = 1.0f / (w0 * l0 + w1 * l1);
            st4bf(YA + (size_t)r * 1024 + 512 + kind * 256 + c4, (o0 * w0 + o1 * w1) * inv);
        }
    }
}
typedef short v4i16_t __attribute__((ext_vector_type(4)));
DI s16x4 vtr(const LAS unsigned char* p) { return __builtin_bit_cast(s16x4, __builtin_amdgcn_ds_read_tr16_b64_v4i16((LAS v4i16_t*)p)); }
DI int crow(int r, int hi) { return (r & 3) + 8 * (r >> 2) + 4 * hi; }

struct AttnArgs {
    const bf16_t* Q; int qpitch;
    const bf16_t* K; int kpitch;
    const bf16_t* V; int vpitch;
    int ka0, ka1, kb0, kb1;
    int window;
    int qlat0;
    int use_sink; float sink_l2;
    int out_mode;
    bf16_t* obf; float* opf; float* mlp;
    int empty_part; float* opf2; float* mlp2;
};

template <int DQK>
DI void attn_unit(Frame& F, const AttnArgs& A) {
    constexpr int NCH = DQK / 8, KB = NCH * 1024, BUF = KB + 8192, ND = DQK / 16;
    const int tid = F.tid, lane = F.lane, wid = F.wave, r32 = lane & 31, hi = lane >> 5;
    LAS unsigned char* lds = F.lds;
    bf16x8 qr[ND];
    { const bf16_t* qp = A.Q + (size_t)(wid * 32 + r32) * A.qpitch + 8 * hi;
#pragma unroll
      for (int d0 = 0; d0 < ND; ++d0) qr[d0] = *(const bf16x8*)(qp + 16 * d0); }
    const int na = (A.ka1 - A.ka0) >> 6, nb = (A.kb1 - A.kb0) >> 6, nt = na + nb;
    const bf16_t* ksrc = A.K + (size_t)lane * A.kpitch + wid * 8;
    const bf16_t* ksrc2 = A.K + (size_t)lane * A.kpitch + (8 + wid) * 8;
    const bf16_t* vsrc = A.V + (size_t)(16 * (wid & 3) + (lane >> 2)) * A.vpitch + (wid >> 2) * 32 + (lane & 3) * 8;
#define ATT_DMA(t) do { const int kr_ = (t) < na ? A.ka0 + 64 * (t) : A.kb0 + 64 * ((t) - na); LAS unsigned char* bb_ = lds + ((t) & 1) * BUF; \
        __builtin_amdgcn_global_load_lds((const unsigned*)(ksrc + (size_t)kr_ * A.kpitch), (LAS unsigned*)(bb_ + wid * 1024), 16, 0, 0); \
        if (DQK == 96 && wid < 4) __builtin_amdgcn_global_load_lds((const unsigned*)(ksrc2 + (size_t)kr_ * A.kpitch), (LAS unsigned*)(bb_ + (8 + wid) * 1024), 16, 0, 0); \
        __builtin_amdgcn_global_load_lds((const unsigned*)(vsrc + (size_t)kr_ * A.vpitch), (LAS unsigned*)(bb_ + KB + wid * 1024), 16, 0, 0); } while (0)
    float m_run = -INFINITY, l_run = 0.f;
    f32x16 o0, o1;
#pragma unroll
    for (int i = 0; i < 16; ++i) { o0[i] = 0.f; o1[i] = 0.f; }
    const int qw0 = A.qlat0 + wid * 32;
    if (nt > 0) ATT_DMA(0);
    for (int t = 0; t < nt; ++t) {
        asm volatile("s_waitcnt vmcnt(0)" ::: "memory");
        __syncthreads();
        if (t + 1 < nt) ATT_DMA(t + 1);
        const int keyrow = t < na ? A.ka0 + 64 * t : A.kb0 + 64 * (t - na);
        const bool banded = A.window && t >= na;
        const int kj0 = keyrow - CTXL;
        if (banded && (kj0 + 63 < qw0 - 128 || kj0 > qw0 + 31 + 128)) continue;
        const LAS unsigned char* kb = lds + (t & 1) * BUF;
        const LAS unsigned char* vb = kb + KB;
        f32x16 p0, p1;
#pragma unroll
        for (int i = 0; i < 16; ++i) { p0[i] = 0.f; p1[i] = 0.f; }
        const LAS unsigned char* kf = kb + hi * 1024 + r32 * 16;
#pragma unroll
        for (int d0 = 0; d0 < ND; ++d0) {
            const bf16x8 a0 = *(const LAS bf16x8*)(kf + d0 * 2048), a1 = *(const LAS bf16x8*)(kf + d0 * 2048 + 512);
            p0 = __builtin_amdgcn_mfma_f32_32x32x16_bf16(a0, qr[d0], p0, 0, 0, 0);
            p1 = __builtin_amdgcn_mfma_f32_32x32x16_bf16(a1, qr[d0], p1, 0, 0, 0);
        }
        if (banded) {
            const int qi = qw0 + r32;
#pragma unroll
            for (int i = 0; i < 16; ++i) { const int kj = kj0 + crow(i, hi); const int d0_ = qi - kj, d1_ = qi - (kj + 32);
                if (d0_ > 128 || d0_ < -128) p0[i] = -INFINITY; if (d1_ > 128 || d1_ < -128) p1[i] = -INFINITY; }
        }
        float mx = p0[0];
#pragma unroll
        for (int i = 1; i < 16; ++i) mx = __builtin_fmaxf(mx, p0[i]);
#pragma unroll
        for (int i = 0; i < 16; ++i) mx = __builtin_fmaxf(mx, p1[i]);
        mx = __builtin_fmaxf(mx, __shfl_xor(mx, 32));
        const float m_new = __builtin_fmaxf(m_run, mx);
        const float alpha = fast_exp2(m_run - m_new);
        m_run = m_new;
        float ps = 0.f;
#pragma unroll
        for (int i = 0; i < 16; ++i) { p0[i] = fast_exp2(p0[i] - m_new); p1[i] = fast_exp2(p1[i] - m_new); ps += p0[i] + p1[i]; }
        l_run = l_run * alpha + ps;
#pragma unroll
        for (int i = 0; i < 16; ++i) { o0[i] *= alpha; o1[i] *= alpha; }
        bf16x8 pb[4];
#pragma unroll
        for (int s = 0; s < 2; ++s) {
            u32x4 w0, w1;
            w0.x = cvt_pk_bf16(p0[8 * s + 0], p0[8 * s + 1]); w0.y = cvt_pk_bf16(p0[8 * s + 2], p0[8 * s + 3]); w0.z = cvt_pk_bf16(p0[8 * s + 4], p0[8 * s + 5]); w0.w = cvt_pk_bf16(p0[8 * s + 6], p0[8 * s + 7]);
            w1.x = cvt_pk_bf16(p1[8 * s + 0], p1[8 * s + 1]); w1.y = cvt_pk_bf16(p1[8 * s + 2], p1[8 * s + 3]); w1.z = cvt_pk_bf16(p1[8 * s + 4], p1[8 * s + 5]); w1.w = cvt_pk_bf16(p1[8 * s + 6], p1[8 * s + 7]);
            pb[s] = __builtin_bit_cast(bf16x8, w0); pb[2 + s] = __builtin_bit_cast(bf16x8, w1);
        }
        const LAS unsigned char* vp = vb + ((lane >> 4) & 1) * 32 + (lane & 3) * 8 + (4 * hi + ((lane & 15) >> 2)) * 64;
#pragma unroll
        for (int ks = 0; ks < 4; ++ks) {
            const s16x4 l0 = vtr(vp + ks * 1024), h0 = vtr(vp + ks * 1024 + 512), l1 = vtr(vp + 4096 + ks * 1024), h1 = vtr(vp + 4096 + ks * 1024 + 512);
            const bf16x8 va = (bf16x8){l0[0], l0[1], l0[2], l0[3], h0[0], h0[1], h0[2], h0[3]}, vb2 = (bf16x8){l1[0], l1[1], l1[2], l1[3], h1[0], h1[1], h1[2], h1[3]};
            o0 = __builtin_amdgcn_mfma_f32_32x32x16_bf16(va, pb[ks], o0, 0, 0, 0);
            o1 = __builtin_amdgcn_mfma_f32_32x32x16_bf16(vb2, pb[ks], o1, 0, 0, 0);
        }
    }
#undef ATT_DMA
    float l_tot = l_run + __shfl_xor(l_run, 32);
    if (A.use_sink) l_tot += fast_exp2(A.sink_l2 - m_run);
    const int qrow = wid * 32 + r32;
    if (A.out_mode == 0) {
        const float inv = 1.0f / l_tot;
        bf16_t* op = A.obf + (size_t)qrow * 1024 + 4 * hi;
#pragma unroll
        for (int g = 0; g < 4; ++g) {
            u32x2 w; w.x = cvt_pk_bf16(o0[4 * g] * inv, o0[4 * g + 1] * inv); w.y = cvt_pk_bf16(o0[4 * g + 2] * inv, o0[4 * g + 3] * inv); *(u32x2*)(op + 8 * g) = w;
            u32x2 w2; w2.x = cvt_pk_bf16(o1[4 * g] * inv, o1[4 * g + 1] * inv); w2.y = cvt_pk_bf16(o1[4 * g + 2] * inv, o1[4 * g + 3] * inv); *(u32x2*)(op + 32 + 8 * g) = w2;
        }
    } else {
        float* op = A.opf + (size_t)qrow * 256 + 4 * hi;
#pragma unroll
        for (int g = 0; g < 4; ++g) {
            *(f32x4*)(op + 8 * g) = (f32x4){o0[4 * g], o0[4 * g + 1], o0[4 * g + 2], o0[4 * g + 3]};
            *(f32x4*)(op + 32 + 8 * g) = (f32x4){o1[4 * g], o1[4 * g + 1], o1[4 * g + 2], o1[4 * g + 3]};
        }
        if (hi == 0) { float* mp = A.mlp + (size_t)qrow * 8; mp[0] = m_run; mp[1] = l_tot; }
        if (A.empty_part) {
            float* op2 = A.opf2 + (size_t)qrow * 256 + 4 * hi;
#pragma unroll
            for (int g = 0; g < 4; ++g) { *(f32x4*)(op2 + 8 * g) = (f32x4){0.f, 0.f, 0.f, 0.f}; *(f32x4*)(op2 + 32 + 8 * g) = (f32x4){0.f, 0.f, 0.f, 0.f}; }
            if (hi == 0) { float* mp = A.mlp2 + (size_t)qrow * 8; mp[0] = -1.0e30f; mp[1] = 0.f; }
        }
    }
    __syncthreads();
}

constexpr int ATT_NUNITS = 1304;
DI void attn_run_unit(Frame& F, int l, int idx) {
    AttnArgs A;
    const bf16_t* P = FP(F); bf16_t* YA = (bf16_t*)(F.ws + WS_YALL);
    float* OP = (float*)(F.ws + WS_OPART); float* ML = (float*)(F.ws + WS_ML);
    A.window = 0; A.qlat0 = 0; A.use_sink = 0; A.sink_l2 = 0.f; A.empty_part = 0; A.opf2 = nullptr; A.mlp2 = nullptr; A.obf = nullptr; A.opf = nullptr; A.mlp = nullptr;
    A.kb0 = 0; A.kb1 = 0;
    if (idx < 1024) {
        const int kind = idx >> 9, i = idx & 511, split = i & 1, qb = (i >> 1) & 31, h = (i >> 6) & 3, b = i >> 8;
        const size_t row0 = (size_t)b * TPB + CTXL + qb * 256, brow = (size_t)b * TPB;
        A.ka0 = split * (TPB / 2); A.ka1 = A.ka0 + TPB / 2;
        A.out_mode = 1; A.opf = OP + ((size_t)(kind * NSPLIT + split) * NROW + row0) * 256 + h * 64; A.mlp = ML + (((size_t)(kind * NSPLIT + split) * NROW + row0) * 4 + h) * 2;
        if (kind == 0) {
            const bf16_t* Qm = (const bf16_t*)(F.ws + WS_QMLA); const bf16_t* Km = (const bf16_t*)(F.ws + WS_KMLA); const bf16_t* Vm = (const bf16_t*)(F.ws + WS_VMLA);
            A.Q = Qm + row0 * 384 + h * 96; A.qpitch = 384; A.K = Km + brow * 384 + h * 96; A.kpitch = 384; A.V = Vm + brow * 256 + h * 64; A.vpitch = 256;
            attn_unit<96>(F, A);
        } else {
            A.Q = P + row0 * LDP + PC_GAQ + h * 64; A.qpitch = LDP; A.K = P + brow * LDP + PC_GAK + (h >> 1) * 64; A.kpitch = LDP; A.V = P + brow * LDP + PC_GAV + (h >> 1) * 64; A.vpitch = LDP;
            attn_unit<64>(F, A);
        }
    } else if (idx < 1280) {
        const int i = idx - 1024, qb = i & 31, h = (i >> 5) & 3, b = i >> 7;
        const size_t row0 = (size_t)b * TPB + CTXL + qb * 256, brow = (size_t)b * TPB;
        const int q0 = qb * 256; int lo = q0 - 128; if (lo < 0) lo = 0; int hi_ = q0 + 256 + 128; if (hi_ > SEQ) hi_ = SEQ;
        A.ka0 = 0; A.ka1 = CTXL; A.kb0 = CTXL + lo; A.kb1 = CTXL + hi_; A.window = 1; A.qlat0 = q0;
        A.use_sink = 1; A.sink_l2 = inp(I_SINK)[l * 4 + h] * LOG2E;
        A.Q = P + row0 * LDP + PC_SWQ + h * 64; A.qpitch = LDP; A.K = P + brow * LDP + PC_SWK + (h >> 1) * 64; A.kpitch = LDP; A.V = P + brow * LDP + PC_SWV + (h >> 1) * 64; A.vpitch = LDP;
        A.out_mode = 0; A.obf = YA + row0 * 1024 + 256 + h * 64;
        attn_unit<64>(F, A);
    } else {
        const int i = idx - 1280, ck = i >> 3, b = (i >> 2) & 1, h = i & 3;
        const size_t row0 = (size_t)b * TPB, brow = row0;
        A.ka0 = 0; A.ka1 = CTXL;
        if (ck == 0) {
            const bf16_t* Qm = (const bf16_t*)(F.ws + WS_QMLA); const bf16_t* Km = (const bf16_t*)(F.ws + WS_KMLA); const bf16_t* Vm = (const bf16_t*)(F.ws + WS_VMLA);
            A.Q = Qm + row0 * 384 + h * 96; A.qpitch = 384; A.K = Km + brow * 384 + h * 96; A.kpitch = 384; A.V = Vm + brow * 256 + h * 64; A.vpitch = 256;
            A.out_mode = 1; A.opf = OP + ((size_t)(0 * NSPLIT + 0) * NROW + row0) * 256 + h * 64; A.mlp = ML + (((size_t)(0 * NSPLIT + 0) * NROW + row0) * 4 + h) * 2;
            A.empty_part = 1; A.opf2 = OP + ((size_t)(0 * NSPLIT + 1) * NROW + row0) * 256 + h * 64; A.mlp2 = ML + (((size_t)(0 * NSPLIT + 1) * NROW + row0) * 4 + h) * 2;
            attn_unit<96>(F, A);
        } else if (ck == 1) {
            A.Q = P + row0 * LDP + PC_GAQ + h * 64; A.qpitch = LDP; A.K = P + brow * LDP + PC_GAK + (h >> 1) * 64; A.kpitch = LDP; A.V = P + brow * LDP + PC_GAV + (h >> 1) * 64; A.vpitch = LDP;
            A.out_mode = 1; A.opf = OP + ((size_t)(1 * NSPLIT + 0) * NROW + row0) * 256 + h * 64; A.mlp = ML + (((size_t)(1 * NSPLIT + 0) * NROW + row0) * 4 + h) * 2;
            A.empty_part = 1; A.opf2 = OP + ((size_t)(1 * NSPLIT + 1) * NROW + row0) * 256 + h * 64; A.mlp2 = ML + (((size_t)(1 * NSPLIT + 1) * NROW + row0) * 4 + h) * 2;
            attn_unit<64>(F, A);
        } else {
            A.use_sink = 1; A.sink_l2 = inp(I_SINK)[l * 4 + h] * LOG2E;
            A.Q = P + row0 * LDP + PC_SWQ + h * 64; A.qpitch = LDP; A.K = P + brow * LDP + PC_SWK + (h >> 1) * 64; A.kpitch = LDP; A.V = P + brow * LDP + PC_SWV + (h >> 1) * 64; A.vpitch = LDP;
            A.out_mode = 0; A.obf = YA + row0 * 1024 + 256 + h * 64;
            attn_unit<64>(F, A);
        }
    }
}

constexpr int SC_CH = 32, SC_STEP = 1536, SC_BUF = SC_CH * SC_STEP;
DI int scan_row(int b, int d, int n) { return b * TPB + (d == 0 ? n : (n < CTXL ? CTXL - 1 - n : TPB + CTXL - 1 - n)); }
#define DPP_ADD(x, ctrl) ((x) + __builtin_bit_cast(float, __builtin_amdgcn_update_dpp(0, __builtin_bit_cast(int, (x)), (ctrl), 0xf, 0xf, false)))
DI float rsum16(float x) { x = DPP_ADD(x, 0x128); x = DPP_ADD(x, 0x124); x = DPP_ADD(x, 0x122); x = DPP_ADD(x, 0x121); return x; }

DI void scan_fill(Frame& F, int b, int d, int h, int chunk, int lt, int nlt) {
    const float* W = (const float*)(F.ws + WS_W); const bf16_t* KD = (const bf16_t*)(F.ws + WS_KD); const bf16_t* BB = (const bf16_t*)(F.ws + WS_BB);
    const bf16_t* KK = (const bf16_t*)(F.ws + WS_KK); const bf16_t* RR = (const bf16_t*)(F.ws + WS_RR); const bf16_t* V = (const bf16_t*)(F.ws + WS_V);
    LAS unsigned char* buf = F.lds + (chunk & 1) * SC_BUF;
    for (int item = lt; item < SC_CH * 96; item += nlt) {
        const int piece = item & 15, vs = item >> 4, vec = vs % 6, s = vs / 6;
        const int row = scan_row(b, d, chunk * SC_CH + s);
        f32x4 val;
        if (vec == 0) val = *(const f32x4*)(W + (size_t)row * 512 + d * 256 + h * 64 + 4 * piece);
        else if (vec == 1) val = ld4bf(KD + (size_t)row * 512 + d * 256 + h * 64 + 4 * piece);
        else if (vec == 2) val = ld4bf(BB + (size_t)row * 512 + d * 256 + h * 64 + 4 * piece);
        else if (vec == 3) val = ld4bf(KK + (size_t)row * 256 + h * 64 + 4 * piece);
        else if (vec == 4) val = ld4bf(RR + (size_t)row * 256 + h * 64 + 4 * piece);
        else val = ld4bf(V + (size_t)row * 256 + h * 64 + 4 * piece);
        *(LAS f32x4*)(buf + s * SC_STEP + vec * 256 + piece * 16) = val;
    }
}
DI void scan_phase(Frame& F, int sw) {
    const int chain = sw >> 2, quarter = sw & 3, b = chain >> 3, d = (chain >> 2) & 1, h = chain & 3;
    const int lane = F.lane, wid = F.wave, g = lane >> 4, kq = lane & 15;
    const int vrow = quarter * 16 + (wid & 3) * 4 + g;
    float* Y = (float*)(F.ws + WS_YDIR) + (size_t)d * NROW * 256;
    constexpr int NCHUNK = TPB / SC_CH;
    f32x4 S = (f32x4){0.f, 0.f, 0.f, 0.f};
    scan_fill(F, b, d, h, 0, F.tid, 512);
    __syncthreads();
    for (int c = 0; c < NCHUNK; ++c) {
        if (wid >= 4) { if (c + 1 < NCHUNK) scan_fill(F, b, d, h, c + 1, F.tid - 256, 256); }
        else {
            const LAS unsigned char* buf = F.lds + (c & 1) * SC_BUF;
#pragma unroll
            for (int half = 0; half < 2; ++half) {
                float ykeep = 0.f;
#pragma unroll
                for (int s16 = 0; s16 < 16; ++s16) {
                    const LAS unsigned char* sp = buf + (half * 16 + s16) * SC_STEP;
                    const f32x4 w4 = *(const LAS f32x4*)(sp + kq * 16), kd4 = *(const LAS f32x4*)(sp + 256 + kq * 16), bb4 = *(const LAS f32x4*)(sp + 512 + kq * 16),
                                kk4 = *(const LAS f32x4*)(sp + 768 + kq * 16), r4 = *(const LAS f32x4*)(sp + 1024 + kq * 16);
                    const float vv = *(const LAS float*)(sp + 1280 + vrow * 4);
                    const f32x4 t = S * kk4;
                    const float sa = -rsum16((t[0] + t[1]) + (t[2] + t[3]));
                    S = S * w4 + sa * bb4 + vv * kd4;
                    const f32x4 u = S * r4;
                    const float y = rsum16((u[0] + u[1]) + (u[2] + u[3]));
                    ykeep = (s16 == kq) ? y : ykeep;
                }
                const int n = c * SC_CH + half * 16 + kq;
                Y[(size_t)scan_row(b, d, n) * 256 + h * 64 + vrow] = ykeep;
            }
        }
        __syncthreads();
    }
}
constexpr int NPH_LAYER = 13, NPHASE = 1 + NPH_LAYER * DEPTH + 1;
struct Args { const float* in[43]; float* out; unsigned char* ws; int ph_lo, ph_hi; };
__global__ void __launch_bounds__(512, 2) hfb_fwd(Args args) {
    extern __shared__ __attribute__((aligned(16))) unsigned char lds_raw[];
    Frame F;
    F.lds = (LAS unsigned char*)lds_raw;
    F.MISC = (volatile LAS unsigned*)(F.lds + MISC_OFF);
    F.tid = threadIdx.x; F.lane = F.tid & 63; F.wave = __builtin_amdgcn_readfirstlane(F.tid >> 6);
    F.G = gridDim.x; { const int bx = blockIdx.x; F.vcu = (F.G % 8 == 0) ? (bx % 8) * (F.G / 8) + bx / 8 : bx; }
    F.ws = args.ws; F.ctl = (unsigned*)(args.ws + WS_CTL); F.out = args.out;
    for (int u = F.tid; u < (LDS_BYTES - MISC_OFF) / 4; u += 512) ((LAS unsigned*)(F.lds + MISC_OFF))[u] = 0u;
    __syncthreads();
    const int lo = args.ph_lo, hi = args.ph_hi;
    XcdBarrier bar; bar.bar = F.ctl + CW_BAR; bar.x = 0; bar.st = nullptr;
    if (hi - lo > 1) bar = xcd_barrier_post(F.ctl + CW_BAR, F.MISC + 8);
#ifndef PH_MASK
#define PH_MASK 0xFFFFF
#endif
#define IN(k) (lo <= (k) && (k) < hi)
#define INL(j) ((((PH_MASK) >> (j)) & 1) && IN(pb + (j)))
#define SEAM(k) do { if (IN(k) && IN((k) + 1)) xcd_barrier_t<false>(bar); } while (0)
    const int bx = blockIdx.x;

    if (((PH_MASK >> 16) & 1) && IN(0)) { Frame Q = relane(F); p0_prologue(Q); }
    if (hi - lo > 1) xcd_barrier_t<true>(bar);

    for (int l = 0; l < DEPTH; ++l) {
        const int pb = 1 + NPH_LAYER * l;
        if (INL(0)) { Frame Q = relane(F); convert_layer_weights(Q, l); norm_phase<0>(Q, l); } SEAM(pb + 0);
        if (INL(1)) {
            Frame Q = relane(F); unsigned char* wl = Q.ws + WS_WL;
            pg8::Gemm g{(const char*)FHB(Q), (const char*)(wl + WL_WIN), 1024, 1024, 1024};
            SchedGrid S; S.T.init(NPANEL, NP_GEMM / 256, Q.G, bx); S.lda = 1024; S.ldb = 1024; S.acol = 0;
            EpiWin E{FP(Q)};
            pg8::gemm_phase(Q.lds, g, S, E, Q.wave);
        } SEAM(pb + 1);
        if (INL(2)) { Frame Q = relane(F); prep_phase(Q, l); } SEAM(pb + 2);
        if (INL(3)) {
            Frame Q = relane(F); unsigned char* wl = Q.ws + WS_WL;
            pg8::Gemm g{(const char*)FP(Q), (const char*)(wl + WL_L1), LDP, 256, 256};
            SchedL3B S{Q.G, bx};
            EpiL3B E{(bf16_t*)(Q.ws + WS_T), (bf16_t*)(Q.ws + WS_QMLA), (bf16_t*)(Q.ws + WS_KMLA), (bf16_t*)(Q.ws + WS_VMLA), (const float*)(Q.ws + WS_ROPE32)};
            pg8::gemm_phase(Q.lds, g, S, E, Q.wave);
        } SEAM(pb + 3);
        if (INL(4)) {
            Frame Q = relane(F); unsigned char* wl = Q.ws + WS_WL;
            pg8::Gemm g{(const char*)(Q.ws + WS_T), (const char*)(wl + WL_L2), 1536, 256, 256};
            SchedL3C S{Q.G, bx, l};
            EpiL3C E{l, inp(I_W0) + l * 512, inp(I_A0) + l * 512, inp(I_V0) + (l > 0 ? l - 1 : 0) * 256, inp(I_KA) + l * 256,
                     (float*)(Q.ws + WS_W), (bf16_t*)(Q.ws + WS_KD), (bf16_t*)(Q.ws + WS_BB), (const bf16_t*)(Q.ws + WS_KR), (const bf16_t*)(Q.ws + WS_KK),
                     (bf16_t*)(Q.ws + WS_V), (const bf16_t*)(Q.ws + WS_VF), (bf16_t*)(Q.ws + WS_G)};
            pg8::gemm_phase(Q.lds, g, S, E, Q.wave);
        } SEAM(pb + 4);
        if (INL(5)) {
            Frame Q = relane(F); unsigned char* wl = Q.ws + WS_WL;

            if (bx < 64) scan_phase(Q, bx);
            for (;;) {
                if (Q.tid == 0) Q.MISC[16] = __hip_atomic_fetch_add(Q.ctl + CW_ATTQ + l * 64, 1u, __ATOMIC_RELAXED, __HIP_MEMORY_SCOPE_AGENT);
                __syncthreads();
                const int idx = (int)Q.MISC[16];
                __syncthreads();
                if (idx >= ATT_NUNITS) break;
                attn_run_unit(Q, l, idx);
            }
        } SEAM(pb + 5);
        if (INL(6)) { Frame Q = relane(F); finish_phase(Q, l); } SEAM(pb + 6);
        if (INL(7)) {
            Frame Q = relane(F); unsigned char* wl = Q.ws + WS_WL;
            pg8::Gemm g{(const char*)(Q.ws + WS_YALL), (const char*)(wl + WL_WBR), 1024, 256, 256};
            SchedMerge S{Q.G, bx};
            EpiMerge E{FP(Q), FHB(Q)};
            pg8::gemm_phase(Q.lds, g, S, E, Q.wave);
        } SEAM(pb + 7);
        if (INL(8)) {
            Frame Q = relane(F); unsigned char* wl = Q.ws + WS_WL;
            pg8::Gemm g{(const char*)FHB(Q), (const char*)(wl + WL_WOUT), 1024, 1024, 1024};
            SchedGrid S; S.T.init(NPANEL, 4, Q.G, bx); S.lda = 1024; S.ldb = 1024; S.acol = 0;
            EpiResid E{FX(Q), FMOD(Q) + (size_t)l * 3 * 6144, 2};
            pg8::gemm_phase(Q.lds, g, S, E, Q.wave);
        } SEAM(pb + 8);
        if (INL(9)) { Frame Q = relane(F); norm_phase<1>(Q, l); } SEAM(pb + 9);
#ifndef DIAG_DENSE_ONLY
#define DIAG_DENSE_ONLY 0
#endif
#ifndef DIAG_MOE_ONLY
#define DIAG_MOE_ONLY 0
#endif
        if (!DIAG_DENSE_ONLY && ((l & 1) || DIAG_MOE_ONLY)) {
            if (INL(10)) { Frame Q = relane(F); moe_gather(Q, l); } SEAM(pb + 10);
            if (INL(11)) {
                Frame Q = relane(F); unsigned char* wl = Q.ws + WS_WL;
                pg8::Gemm g{(const char*)(Q.ws + WS_XG), (const char*)(wl + WL_W13), 1024, 1024, 1024};
                SchedMoe S; S.G = Q.G; S.c = bx; S.ncol = 28; S.lda = 1024; S.ldb = 1024; S.nrowB = 7168; moe_panels(Q, l, S.cp);
                EpiSwiGlu E{(bf16_t*)(Q.ws + WS_UG), 1};
                pg8::gemm_phase(Q.lds, g, S, E, Q.wave);
            } SEAM(pb + 11);
            if (INL(12)) {
                Frame Q = relane(F); unsigned char* wl = Q.ws + WS_WL;
                pg8::Gemm g{(const char*)(Q.ws + WS_UG), (const char*)(wl + WL_W2), DFF, DFF, DFF};
                SchedMoe S; S.G = Q.G; S.c = bx; S.ncol = 4; S.lda = DFF; S.ldb = DFF; S.nrowB = 1024; moe_panels(Q, l, S.cp);
                EpiMoeDown E{(bf16_t*)(Q.ws + WS_YG), (const float*)(Q.ws + WS_ROWGATE)};
                pg8::gemm_phase(Q.lds, g, S, E, Q.wave);
            } SEAM(pb + 12);
        } else {
            SEAM(pb + 10);
            if (INL(11)) {
                Frame Q = relane(F); unsigned char* wl = Q.ws + WS_WL;
                pg8::Gemm g{(const char*)FHB(Q), (const char*)(wl + WL_W13), 1024, 1024, 1024};
                SchedGrid S; S.T.init(NPANEL, 28, Q.G, bx); S.lda = 1024; S.ldb = 1024; S.acol = 0;
                EpiSwiGlu E{(bf16_t*)(Q.ws + WS_U), 0};
                pg8::gemm_phase(Q.lds, g, S, E, Q.wave);
            } SEAM(pb + 11);
            if (INL(12)) {
                Frame Q = relane(F); unsigned char* wl = Q.ws + WS_WL;
                pg8::Gemm g{(const char*)(Q.ws + WS_U), (const char*)(wl + WL_W2), DFF, DFF, DFF};
                SchedGrid S; S.T.init(NPANEL, 4, Q.G, bx); S.lda = DFF; S.ldb = DFF; S.acol = 0;
                EpiResid E{FX(Q), FMOD(Q) + (size_t)l * 3 * 6144, 5};
                pg8::gemm_phase(Q.lds, g, S, E, Q.wave);
            } SEAM(pb + 12);
        }
    }
    if (((PH_MASK >> 17) & 1) && IN(NPHASE - 1)) { Frame Q = relane(F); norm_phase<2>(Q, DEPTH - 1); }
#undef IN
#undef SEAM
}

extern "C" void kernel_launch(void* const* d_in, const int* in_sizes, int n_in, void* d_out, int out_size, void* d_ws, size_t ws_size, hipStream_t stream) {
    static int grid = 0;
    if (grid == 0) {
        if (n_in != 43 || out_size != NB * SEQ * DM || ws_size < WS_END) { fprintf(stderr, "kernel_launch: unexpected problem (n_in %d, out %d, ws %zu < %zu)\n", n_in, out_size, ws_size, (size_t)WS_END); grid = -1; return; }
        int dev = 0, cus = 0, per_cu = 0;
        if (hipGetDevice(&dev) != hipSuccess || hipDeviceGetAttribute(&cus, hipDeviceAttributeMultiprocessorCount, dev) != hipSuccess) { grid = -1; return; }
        if (hipFuncSetAttribute((const void*)hfb_fwd, hipFuncAttributeMaxDynamicSharedMemorySize, LDS_BYTES) != hipSuccess) { fprintf(stderr, "kernel_launch: hipFuncSetAttribute failed\n"); grid = -1; return; }
        if (hipOccupancyMaxActiveBlocksPerMultiprocessor(&per_cu, (const void*)hfb_fwd, 512, LDS_BYTES) != hipSuccess || per_cu < 1) { fprintf(stderr, "kernel_launch: occupancy query says %d\n", per_cu); }
        (void)hipGetLastError();
        grid = cus < 256 ? cus : 256;
        if (grid < 64) { grid = -1; return; }
    }
    if (grid < 0) return;
    (void)in_sizes;
    hipMemsetAsync((char*)d_ws + WS_CTL, 0, CTL_BYTES, stream);
    Args a{};
    for (int i = 0; i < 43; ++i) a.in[i] = (const float*)d_in[i];
    a.out = (float*)d_out; a.ws = (unsigned char*)d_ws;
#if MK_N_LAUNCHES == 1
    a.ph_lo = 0; a.ph_hi = NPHASE;
    hipLaunchKernelGGL(hfb_fwd, dim3(grid), dim3(512), LDS_BYTES, stream, a);
#else
    for (int p = 0; p < NPHASE; ++p) {
        const int l = (p - 1) / NPH_LAYER, k = (p - 1) % NPH_LAYER;
        if (p >= 1 && p < NPHASE - 1 && k == 10 && !(l & 1)) continue;
        a.ph_lo = p; a.ph_hi = p + 1;
        hipLaunchKernelGGL(hfb_fwd, dim3(grid), dim3(512), LDS_BYTES, stream, a);
    }
#endif
}
```

```cpp
#include <hip/hip_runtime.h>
#include <cstdio>
#include <cstdint>

#ifndef MK_N_LAUNCHES
#define MK_N_LAUNCHES 1
#endif

#define GAS __attribute__((address_space(1)))
#define LAS __attribute__((address_space(3)))
#define DI __device__ __forceinline__
typedef unsigned short bf16_t;
typedef short bf16x8 __attribute__((ext_vector_type(8)));
typedef short s16x4 __attribute__((ext_vector_type(4)));
typedef float f32x2 __attribute__((ext_vector_type(2)));
typedef float f32x4 __attribute__((ext_vector_type(4)));
typedef float f32x16 __attribute__((ext_vector_type(16)));
typedef unsigned u32x2 __attribute__((ext_vector_type(2)));
typedef unsigned u32x4 __attribute__((ext_vector_type(4)));

constexpr int DM = 1024, NB = 2, SEQ = 8192, DEPTH = 4, CTXL = 256, GRIDW = 64;
constexpr int TPB = CTXL + SEQ;
constexpr int NROW = NB * TPB;
constexpr int NPANEL = NROW / 256;
constexpr int DFF = 3584, NEXP = 8;
constexpr int IN_W = 6560;
constexpr int PC_F = 0, PC_SWQ = 1024, PC_SWK = 1280, PC_SWV = 1408, PC_CQ = 1536, PC_CKV = 1792, PC_KR = 1920,
              PC_GAQ = 2048, PC_GAK = 2304, PC_GAV = 2432, PC_GATE = 2560, PC_Z = 6656, NP_GEMM = 6656, LDP = 6912;
constexpr float LOG2E = 1.4426950408889634f;
constexpr float QS64 = 0.125f * LOG2E;
constexpr float QS96 = 0.10206207261596577f * LOG2E;
constexpr int NSPLIT = 2;
constexpr int MOE_MAXROWS = 35840;

constexpr size_t MiB = 1u << 20;
constexpr size_t WS_CTL = 0, CTL_BYTES = 1 * MiB;
constexpr size_t WS_MOD = 1 * MiB;
constexpr size_t WS_ROPE64 = 2 * MiB;
constexpr size_t WS_ROPE32 = 4 * MiB;
constexpr size_t WS_ASG = 5 * MiB;
constexpr size_t WS_ASG_GATE = 5 * MiB + 512 * 1024;
constexpr size_t WS_ASG_DST = 6 * MiB;
constexpr size_t WS_ROWGATE = 6 * MiB + 512 * 1024;
constexpr size_t WS_WL = 8 * MiB;
constexpr size_t WL_WIN = 0;
constexpr size_t WL_WBR = WL_WIN + (size_t)NP_GEMM * 1024 * 2;
constexpr size_t WL_WOUT = WL_WBR + (size_t)4 * 1024 * 256 * 2;
constexpr size_t WL_L1 = WL_WOUT + (size_t)1024 * 1024 * 2;
constexpr size_t WL_L2 = WL_L1 + (size_t)1536 * 256 * 2;
constexpr size_t WL_UQ = WL_L2 + (size_t)1536 * 256 * 2;
constexpr size_t WL_UKV = WL_UQ + (size_t)512 * 256 * 2;
constexpr size_t WL_W13 = WL_UKV + (size_t)512 * 256 * 2;
constexpr size_t WL_W2 = WL_W13 + (size_t)NEXP * 7168 * 1024 * 2;
constexpr size_t WL_END = WL_W2 + (size_t)NEXP * 1024 * 3584 * 2;
static_assert(WL_END <= 200 * MiB, "weights region");
constexpr size_t WS_X = 208 * MiB;
constexpr size_t WS_HB = 274 * MiB;
constexpr size_t WS_VF = 307 * MiB;
constexpr size_t WS_REG = 316 * MiB;
constexpr size_t WS_P = WS_REG;
constexpr size_t WS_RR = WS_REG + 223 * MiB;
constexpr size_t WS_KK = WS_RR + 9 * MiB;
constexpr size_t WS_KR = WS_KK + 9 * MiB;
constexpr size_t WS_V = WS_KR + 9 * MiB;
constexpr size_t WS_KD = WS_V + 9 * MiB;
constexpr size_t WS_BB = WS_KD + 17 * MiB;
constexpr size_t WS_W = WS_BB + 17 * MiB;
constexpr size_t WS_G = WS_W + 33 * MiB;
constexpr size_t WS_T = WS_G + 9 * MiB;
constexpr size_t WS_OPART = WS_T;
constexpr size_t WS_ML = WS_OPART + 66 * MiB;
constexpr size_t WS_YDIR = WS_ML + 3 * MiB;
constexpr size_t WS_QMLA = WS_YDIR + 33 * MiB;
constexpr size_t WS_KMLA = WS_QMLA + 13 * MiB;
constexpr size_t WS_VMLA = WS_KMLA + 13 * MiB;
constexpr size_t WS_YALL = WS_VMLA + 9 * MiB;
constexpr size_t WS_MIX_END = WS_YALL + 33 * MiB;
constexpr size_t WS_U = WS_REG;
constexpr size_t WS_XG = WS_REG;
constexpr size_t WS_UG = WS_REG + 70 * MiB;
constexpr size_t WS_YG = WS_UG + 245 * MiB;
constexpr size_t WS_FFN_END = WS_YG + 70 * MiB;
constexpr size_t WS_END = (WS_MIX_END > WS_FFN_END ? WS_MIX_END : WS_FFN_END);
static_assert(WS_KR + (size_t)NROW * 256 * 2 <= WS_V && WS_T + (size_t)NROW * 1536 * 2 <= WS_ML && WS_OPART + (size_t)2 * NSPLIT * NROW * 256 * 4 <= WS_ML, "map");
static_assert((size_t)2 * NSPLIT * NROW * 8 * 4 <= 3 * MiB && (size_t)NROW * 384 * 2 <= 13 * MiB && (size_t)NROW * LDP * 2 <= 223 * MiB, "map");
static_assert((size_t)MOE_MAXROWS * 1024 * 2 <= 70 * MiB && (size_t)MOE_MAXROWS * 3584 * 2 <= 245 * MiB, "map");

constexpr int CW_BAR = 4096;
constexpr int CW_MOECNT = 16384;
constexpr int CW_ATTQ = 20480;
constexpr int CW_WGBASE = 32768;

constexpr int RING_BYTES = 131072;
constexpr int MISC_OFF = RING_BYTES;
constexpr int LDS_BYTES = 147456;

#define LDS_WAIT() asm volatile("s_waitcnt lgkmcnt(0)" ::: "memory")
#define VM_WAIT() asm volatile("s_waitcnt vmcnt(0)" ::: "memory")
DI unsigned f2bf(float f) { unsigned u = __builtin_bit_cast(unsigned, f); return (u + 0x7fffu + ((u >> 16) & 1u)) >> 16; }
DI unsigned pk2(float lo, float hi) { return f2bf(lo) | (f2bf(hi) << 16); }
DI float bflo(unsigned w) { return __builtin_bit_cast(float, w << 16); }
DI float bfhi(unsigned w) { return __builtin_bit_cast(float, w & 0xffff0000u); }
DI float bf2f(bf16_t b) { return __builtin_bit_cast(float, ((unsigned)b) << 16); }
DI unsigned cvt_pk_bf16(float lo, float hi) { unsigned r; asm volatile("v_cvt_pk_bf16_f32 %0, %1, %2" : "=v"(r) : "v"(lo), "v"(hi)); return r; }
DI float fast_exp2(float x) { return __builtin_amdgcn_exp2f(x); }
DI float fast_rcp(float x) { return __builtin_amdgcn_rcpf(x); }
DI float sigmoidf_(float x) { return fast_rcp(1.0f + fast_exp2(-x * LOG2E)); }
DI float siluf_(float x) { return x * sigmoidf_(x); }
DI float tanhf_(float x) { const float e = fast_exp2(-2.0f * LOG2E * __builtin_fabsf(x)); const float t = (1.0f - e) * fast_rcp(1.0f + e); return x < 0.f ? -t : t; }
DI float wave_sum(float v) {
#pragma unroll
    for (int o = 1; o < 64; o <<= 1) v += __shfl_xor(v, o);
    return v;
}
DI float sum16(float v) {
    v += __shfl_xor(v, 1); v += __shfl_xor(v, 2); v += __shfl_xor(v, 4); v += __shfl_xor(v, 8); return v;
}
DI int row_vec(int row) { return (row % TPB) < CTXL ? 2 : row / TPB; }
#define XB_TMO      128
#define XB_XCNT(j)  (256  + 64 * (j))
#define XB_XSUB(j)  (1280 + 64 * (j))
#define XB_XGEN(j)  (2304 + 64 * (j))
#define XB_TOP      3328
#define XB_TOPGEN   3392
#define XCD_BAR_WORDS 3456
#define XB_SPIN_CAP (1u << 25)
DI unsigned xb_ld(unsigned* p)              { return __hip_atomic_load(p, __ATOMIC_RELAXED, __HIP_MEMORY_SCOPE_AGENT); }
DI unsigned xb_add(unsigned* p, unsigned v) { return __hip_atomic_fetch_add(p, v, __ATOMIC_RELAXED, __HIP_MEMORY_SCOPE_AGENT); }
DI unsigned xb_xcc_id() { return (unsigned)__builtin_amdgcn_s_getreg((3 << 11) | 20) & 0xFu; }
#define XB_SPIN(cond, bar) do { unsigned _sp = 0; while (cond) { __builtin_amdgcn_s_sleep(1); \
    if ((++_sp & 255u) == 0u) { if (xb_ld(&(bar)[XB_TMO])) break; if (_sp > XB_SPIN_CAP) { atomicAdd(&(bar)[XB_TMO], 1u); break; } } } } while (0)
struct XcdBarrier { unsigned* bar; unsigned x; volatile LAS unsigned* st; };
DI XcdBarrier xcd_barrier_post(unsigned* bar, volatile LAS unsigned* st) {
    XcdBarrier b; b.bar = bar; b.x = xb_xcc_id(); b.st = st;
    if (threadIdx.x == 0) (void)xb_add(&bar[XB_XCNT(b.x)], 1u);
    return b;
}
DI void xcd_barrier_complete(unsigned* bar, unsigned x, unsigned& nloc, unsigned& nx) {
    const unsigned G = gridDim.x * gridDim.y * gridDim.z;
    unsigned sum, cnt, mine, sp = 0u;
    for (;;) {
        sum = 0u; cnt = 0u; mine = 0u;
#pragma unroll
        for (unsigned j = 0; j < 16; ++j) { const unsigned c = xb_ld(&bar[XB_XCNT(j)]); sum += c; cnt += (c > 0u) ? 1u : 0u; mine = (j == x) ? c : mine; }
        if (sum == G) break;
        __builtin_amdgcn_s_sleep(1);
        if ((++sp & 255u) == 0u) { if (xb_ld(&bar[XB_TMO])) break; if (sp > XB_SPIN_CAP) { atomicAdd(&bar[XB_TMO], 1u); break; } }
    }
    nloc = mine > 0u ? mine : 1u; nx = cnt > 0u ? cnt : 1u;
}
template <bool FIRST>
DI void xcd_barrier_t(const XcdBarrier& b) {
    asm volatile("s_waitcnt vmcnt(0)" ::: "memory");
    __syncthreads();
    if (threadIdx.x == 0) {
        unsigned* bar = b.bar; asm volatile("" : "+s"(bar));
        __builtin_amdgcn_s_waitcnt(0);
        unsigned nloc = b.st[0], nx = b.st[1];
        if (FIRST) { if (nloc == 0u) { xcd_barrier_complete(bar, b.x, nloc, nx); b.st[0] = nloc; b.st[1] = nx; } }
        else if (nloc == 0u) { atomicAdd(&bar[XB_TMO], 1u); nloc = 1u; nx = 1u; }
        const unsigned old = xb_add(&bar[XB_XSUB(b.x)], 1u);
        const unsigned gen = old / nloc;
        if (old + 1u == (gen + 1u) * nloc) {
            __builtin_amdgcn_fence(__ATOMIC_RELEASE, "agent");
            asm volatile("s_waitcnt vmcnt(0)" ::: "memory");
            const unsigned og = xb_add(&bar[XB_TOP], 1u);
            const unsigned tg = og / nx;
            if (og + 1u == (tg + 1u) * nx) xb_add(&bar[XB_TOPGEN], 1u);
            else XB_SPIN(xb_ld(&bar[XB_TOPGEN]) == tg, bar);
            __builtin_amdgcn_fence(__ATOMIC_ACQUIRE, "agent");
            xb_add(&bar[XB_XGEN(b.x)], 1u);
            asm volatile("s_waitcnt vmcnt(0)" ::: "memory");
        } else {
            XB_SPIN(xb_ld(&bar[XB_XGEN(b.x)]) == gen, bar);
            __builtin_amdgcn_fence(__ATOMIC_ACQUIRE, "agent");
            asm volatile("s_waitcnt vmcnt(0)" ::: "memory");
        }
    }
    __syncthreads();
}

namespace pg8 {
constexpr int BM = 256, BK = 64, HALF = 128, HTB = HALF * BK * 2, STAGE_BYTES = 8 * HTB, NXCD = 8, WGM = 8;
__host__ __device__ __forceinline__ int lds_byte(int r, int c) { const int st = (r >> 4) * 2 + (c >> 5), rr = r & 15, cc = c & 31, ob = rr * 64 + cc * 2; return st * 1024 + (ob ^ (((ob >> 9) & 1) << 5)); }
__host__ __device__ __forceinline__ void stage_rc(int b, int& R, int& C) { const int st = b / 1024, sb = b % 1024, swz = sb ^ (((sb >> 9) & 1) << 5); R = (st >> 1) * 16 + swz / 64; C = (st & 1) * 32 + (swz % 64) / 2; }
__host__ __device__ __forceinline__ int perm32(int rho) { const int n = rho >> 4, i = rho & 15; return 8 * (i >> 2) + 4 * n + (i & 3); }

struct Unit { int pm, pn, aux; size_t aoff, boff; };
struct Gemm { const char* A; const char* Bt; int lda, ldb, K; };

struct TileOrder {
    int nM, nN, nwg, G, c;
    DI void init(int nM_, int nN_, int G_, int c_) { nM = nM_; nN = nN_; nwg = nM * nN; G = G_; c = c_; }
    DI bool tile(int i, int& pm, int& pn) const {
        const long L = (long)i * G + c; if (L >= nwg) return false;
        int wgid = (int)L; { const int q = nwg / NXCD, r = nwg % NXCD, xcd = wgid % NXCD, off = wgid / NXCD; wgid = (xcd < r ? xcd * (q + 1) : r * (q + 1) + (xcd - r) * q) + off; }
        const int nig = WGM * nN, gid = wgid / nig, fm = gid * WGM, gsz = (nM - fm) < WGM ? (nM - fm) : WGM;
        pm = fm + ((wgid % nig) % gsz); pn = (wgid % nig) / gsz; return true;
    }
};

template <class Epi, class Sched>
DI void gemm_phase(LAS unsigned char* lds, const Gemm g, const Sched& S, const Epi& E, const int wave_id) {
    int lane = (int)__builtin_amdgcn_mbcnt_hi(~0u, __builtin_amdgcn_mbcnt_lo(~0u, 0u)); asm volatile("" : "+v"(lane));
    const int wid = wave_id, tid = wid * 64 + lane, wr = wid >> 2, wc = wid & 3, fr = lane & 15, fq = lane >> 4;
    const int K = g.K, nt = K / BK;
    unsigned voffA[2], voffB[2];
#pragma unroll
    for (int i = 0; i < 2; ++i) { int R, C; stage_rc(tid * 16 + i * 8192, R, C); const int Rb = (R & ~31) + perm32(R & 31);
        voffA[i] = (unsigned)(R * g.lda + C) * 2u; voffB[i] = (unsigned)(Rb * g.ldb + C) * 2u; }
    const size_t kstep = (size_t)(BK * 2);
    const size_t hstepA = (size_t)HALF * g.lda * 2, hstepB = (size_t)HALF * g.ldb * 2;
    const unsigned ldsw = (unsigned)wid * 1024u;
    const int aoff = lds_byte(wr * 64 + fr, fq * 8), boff = lds_byte(wc * 32 + fr, fq * 8);
#define PG8_SA(b, h) (((b) * 2 + (h)) * HTB)
#define PG8_SB(b, h) ((4 + (b) * 2 + (h)) * HTB)
#define PG8_STAGE(bufoff, gbase, voff) do { _Pragma("unroll") for (int _i = 0; _i < 2; ++_i) \
        __builtin_amdgcn_global_load_lds((const unsigned*)((const char*)(gbase) + (voff)[_i]), (LAS unsigned*)(lds + (bufoff) + ldsw + _i * 8192), 16, 0, 0); } while (0)
#define PG8_LDA(dst, b, h) do { _Pragma("unroll") for (int m = 0; m < 4; ++m) _Pragma("unroll") for (int k = 0; k < 2; ++k) dst[m][k] = *(const LAS bf16x8*)(lds + PG8_SA(b, h) + aoff + m * 2048 + k * 1024); } while (0)
#define PG8_LDB(dst, b, h) do { _Pragma("unroll") for (int n = 0; n < 2; ++n) _Pragma("unroll") for (int k = 0; k < 2; ++k) dst[n][k] = *(const LAS bf16x8*)(lds + PG8_SB(b, h) + boff + n * 2048 + k * 1024); } while (0)
#define PG8_MMA(ai, bj, At, Bt) do { __builtin_amdgcn_s_setprio(1); _Pragma("unroll") for (int m = 0; m < 4; ++m) _Pragma("unroll") for (int n = 0; n < 2; ++n) _Pragma("unroll") for (int k = 0; k < 2; ++k) \
        acc[ai][bj][m][n] = __builtin_amdgcn_mfma_f32_16x16x32_bf16(Bt[n][k], At[m][k], acc[ai][bj][m][n], 0, 0, 0); __builtin_amdgcn_s_setprio(0); } while (0)
#define PG8_WAIT_V(n) asm volatile("s_waitcnt vmcnt(" #n ")" ::: "memory")
#define PG8_WAIT_L(n) asm volatile("s_waitcnt lgkmcnt(" #n ")" ::: "memory")
#define PG8_BAR __builtin_amdgcn_s_barrier()
#define PG8_SCHED __builtin_amdgcn_sched_barrier(0)
    Unit cur, nxt; int ui = 0;
    if (!S.next(0, cur)) return;
    f32x4 acc[2][2][4][2];
#pragma unroll
    for (int a = 0; a < 2; ++a)
#pragma unroll
        for (int b = 0; b < 2; ++b)
#pragma unroll
            for (int m = 0; m < 4; ++m)
#pragma unroll
                for (int n = 0; n < 2; ++n) acc[a][b][m][n] = (f32x4){0.f, 0.f, 0.f, 0.f};
    bf16x8 At[4][2], B0[2][2], B1[2][2];
    const char* cA = g.A + cur.aoff; const char* cB = g.Bt + cur.boff;
    {
        PG8_STAGE(PG8_SB(0, 0), cB, voffB); PG8_STAGE(PG8_SB(0, 1), cB + hstepB, voffB); PG8_STAGE(PG8_SA(0, 0), cA, voffA); PG8_STAGE(PG8_SA(0, 1), cA + hstepA, voffA);
        if (wr == 1) PG8_BAR;
        PG8_WAIT_V(2); PG8_BAR;
        PG8_STAGE(PG8_SB(1, 0), cB + kstep, voffB); PG8_STAGE(PG8_SA(1, 0), cA + kstep, voffA); PG8_STAGE(PG8_SB(1, 1), cB + hstepB + kstep, voffB);
        PG8_WAIT_V(6); PG8_BAR;
    }
    for (;;) {
        const bool has_next = S.next(ui + 1, nxt);
        const char* nA = has_next ? g.A + nxt.aoff : cA; const char* nB = has_next ? g.Bt + nxt.boff : cB;
#pragma nounroll
        for (int t = 0; t < nt; t += 2) {
            const bool last = (t == nt - 2);
            const char* a1 = cA + (size_t)(t + 1) * kstep;
            const char* a2 = last ? nA : cA + (size_t)(t + 2) * kstep; const char* b2 = last ? nB : cB + (size_t)(t + 2) * kstep;
            const char* a3 = a2 + kstep; const char* b3 = b2 + kstep;
            PG8_LDB(B0, 0, 0); PG8_LDB(B1, 0, 1); PG8_SCHED; PG8_LDA(At, 0, 0); PG8_STAGE(PG8_SA(1, 1), a1 + hstepA, voffA);
            PG8_WAIT_V(8); PG8_WAIT_L(0); PG8_BAR; PG8_MMA(0, 0, At, B0); PG8_MMA(0, 1, At, B1); PG8_BAR; PG8_SCHED;
            PG8_LDA(At, 0, 1); PG8_STAGE(PG8_SB(0, 0), b2, voffB); PG8_STAGE(PG8_SB(0, 1), b2 + hstepB, voffB); PG8_STAGE(PG8_SA(0, 0), a2, voffA);
            PG8_WAIT_V(8); PG8_WAIT_L(0); PG8_BAR; PG8_MMA(1, 0, At, B0); PG8_MMA(1, 1, At, B1); PG8_BAR; PG8_SCHED;
            PG8_LDB(B0, 1, 0); PG8_LDB(B1, 1, 1); PG8_SCHED; PG8_LDA(At, 1, 0); PG8_STAGE(PG8_SA(0, 1), a2 + hstepA, voffA);
            PG8_WAIT_V(8); PG8_WAIT_L(0); PG8_BAR; PG8_MMA(0, 0, At, B0); PG8_MMA(0, 1, At, B1); PG8_BAR; PG8_SCHED;
            PG8_LDA(At, 1, 1); PG8_STAGE(PG8_SB(1, 0), b3, voffB); PG8_STAGE(PG8_SB(1, 1), b3 + hstepB, voffB); PG8_STAGE(PG8_SA(1, 0), a3, voffA);
            PG8_WAIT_V(8); PG8_WAIT_L(0); PG8_BAR; PG8_MMA(1, 0, At, B0); PG8_MMA(1, 1, At, B1); PG8_BAR; PG8_SCHED;
        }
        if (wr == 0) PG8_BAR;
        E(acc, cur, wr, wc, fr, fq);
        if (!has_next) break;
#pragma unroll
        for (int a = 0; a < 2; ++a)
#pragma unroll
            for (int b = 0; b < 2; ++b)
#pragma unroll
                for (int m = 0; m < 4; ++m)
#pragma unroll
                    for (int n = 0; n < 2; ++n) acc[a][b][m][n] = (f32x4){0.f, 0.f, 0.f, 0.f};
        cur = nxt; cA = nA; cB = nB; ++ui;
        if (wr == 1) PG8_BAR;
    }
    PG8_WAIT_V(0);
    PG8_BAR;
#undef PG8_SA
#undef PG8_SB
#undef PG8_STAGE
#undef PG8_LDA
#undef PG8_LDB
#undef PG8_MMA
#undef PG8_WAIT_V
#undef PG8_WAIT_L
#undef PG8_BAR
#undef PG8_SCHED
}
}
struct Frame {
    LAS unsigned char* lds;
    volatile LAS unsigned* MISC;
    unsigned* ctl;
    unsigned char* ws;
    int tid, lane, wave, vcu, G;
    float* out;
};
DI Frame relane(const Frame& F) { Frame Q = F; int ln = (int)__builtin_amdgcn_mbcnt_hi(~0u, __builtin_amdgcn_mbcnt_lo(~0u, 0u)); unsigned char* w = F.ws; int wv = F.wave;
    asm volatile("" : "+v"(ln), "+s"(w), "+s"(wv)); Q.ws = w; Q.ctl = (unsigned*)w; Q.lane = ln; Q.wave = wv; Q.tid = wv * 64 + ln; return Q; }
typedef const float* cfp_t;
DI cfp_t inp(int i) { unsigned long long kp = (unsigned long long)__builtin_amdgcn_kernarg_segment_ptr(); asm volatile("" : "+s"(kp)); return ((const __attribute__((address_space(4))) cfp_t*)kp)[i]; }
#define FX(F) ((float*)((F).ws + WS_X))
#define FHB(F) ((bf16_t*)((F).ws + WS_HB))
#define FP(F) ((bf16_t*)((F).ws + WS_P))
#define FMOD(F) ((float*)((F).ws + WS_MOD))
enum { I_X = 0, I_C, I_CTX, I_CCTX, I_WMOD, I_BMOD, I_NORM1, I_NORM2, I_WIN, I_WBR, I_WOUT, I_MU, I_W0, I_W1, I_W2, I_A0, I_A1, I_A2, I_V0, I_V1, I_V2,
       I_G1, I_G2, I_KK, I_KA, I_RK, I_LNW, I_LNB, I_SINK, I_MQN, I_WUQ, I_MKVN, I_WUKV, I_GQN, I_GKN, I_FW1, I_FW3, I_FW2, I_ROUTER, I_MW1, I_MW3, I_MW2, I_FNORM };

DI const float* modp(const Frame& F, int l, int vec, int which) { return FMOD(F) + ((size_t)(l * 3 + vec) * 6 + which) * 1024; }

using pg8::Unit;
struct SchedGrid {
    pg8::TileOrder T; int lda, ldb, acol;
    DI bool next(int i, Unit& u) const { int pm, pn; if (!T.tile(i, pm, pn)) return false; u.pm = pm; u.pn = pn; u.aux = 0;
        u.aoff = ((size_t)pm * 256 * lda + acol) * 2; u.boff = (size_t)pn * 256 * ldb * 2; return true; }
};
struct SchedL3B {
    int G, c;
    DI bool next(int i, Unit& u) const {
        int L = i * G + c; if (L >= 660) return false;
        int grp, pm, pn; size_t bb; int acol;
        if (L < 396) { grp = 0; pm = L % 66; pn = L / 66; bb = 0; acol = PC_Z; }
        else if (L < 528) { L -= 396; grp = 1; pm = L % 66; pn = L / 66; bb = WL_UQ - WL_L1; acol = PC_CQ; }
        else { L -= 528; grp = 2; pm = L % 66; pn = L / 66; bb = WL_UKV - WL_L1; acol = PC_CKV; }
        u.pm = pm; u.pn = pn; u.aux = grp; u.aoff = ((size_t)pm * 256 * LDP + acol) * 2; u.boff = bb + (size_t)pn * 256 * 256 * 2; return true;
    }
};
struct SchedL3C {
    int G, c, layer;
    DI bool next(int i, Unit& u) const {
        const int L = i * G + c; const int ntile = layer == 0 ? 5 : 6; if (L >= 66 * ntile) return false;
        const int pm = L % 66; int pn = L / 66; if (layer == 0 && pn >= 4) pn = 5;
        u.pm = pm; u.pn = pn; u.aux = 0; u.aoff = ((size_t)pm * 256 * 1536 + pn * 256) * 2; u.boff = (size_t)pn * 256 * 256 * 2; return true;
    }
};
struct SchedMerge {
    int G, c;
    DI bool next(int i, Unit& u) const {
        const int ti = (i >> 2) * G + c; if (ti >= 264) return false; const int br = i & 3;
        const int pm = ti % 66, pn = ti / 66;
        u.pm = pm; u.pn = pn; u.aux = br; u.aoff = ((size_t)pm * 256 * 1024 + br * 256) * 2; u.boff = ((size_t)(br * 1024 + pn * 256) * 256) * 2; return true;
    }
};
struct SchedMoe {
    int G, c, ncol, lda, ldb, nrowB; int cp[9];
    DI bool next(int i, Unit& u) const {
        const int L = i * G + c; if (L >= cp[8] * ncol) return false;
        const int p = L / ncol, j = L % ncol; int e = 0;
#pragma unroll
        for (int q = 1; q < 8; ++q) e += (p >= cp[q]) ? 1 : 0;
        u.pm = p; u.pn = e; u.aux = j; u.aoff = (size_t)p * 256 * lda * 2; u.boff = ((size_t)e * nrowB + (size_t)j * 256) * ldb * 2; return true;
    }
};

typedef const f32x4 (&AccRef)[2][2][4][2];
#define EPI_ROWS(u) _Pragma("unroll") for (int ai = 0; ai < 2; ++ai) _Pragma("unroll") for (int m = 0; m < 4; ++m)
#define EPI_ROW(u) ((u).pm * 256 + ai * 128 + wr * 64 + m * 16 + fr)
DI u32x4 pack8(const f32x4 a, const f32x4 b) { u32x4 w; w.x = cvt_pk_bf16(a[0], a[1]); w.y = cvt_pk_bf16(a[2], a[3]); w.z = cvt_pk_bf16(b[0], b[1]); w.w = cvt_pk_bf16(b[2], b[3]); return w; }
DI void unpack8(const u32x4 w, f32x4& a, f32x4& b) { a = (f32x4){bflo(w.x), bfhi(w.x), bflo(w.y), bfhi(w.y)}; b = (f32x4){bflo(w.z), bfhi(w.z), bflo(w.w), bfhi(w.w)}; }

struct EpiWin {
    bf16_t* P;
    DI void operator()(AccRef acc, const Unit& u, int wr, int wc, int fr, int fq) const {
        asm volatile("" : "+v"(fr), "+v"(fq));
        const bool sig = u.pn >= 10;
        EPI_ROWS(u) { bf16_t* rp = P + (size_t)EPI_ROW(u) * LDP + u.pn * 256 + wc * 32 + fq * 8;
#pragma unroll
            for (int bj = 0; bj < 2; ++bj) { f32x4 a = acc[ai][bj][m][0], b = acc[ai][bj][m][1];
                if (sig) {
#pragma unroll
                    for (int j = 0; j < 4; ++j) { a[j] = sigmoidf_(a[j]); b[j] = sigmoidf_(b[j]); } }
                *(u32x4*)(rp + bj * 128) = pack8(a, b); } }
    }
};
struct EpiL3B {
    bf16_t* T; bf16_t* Qm; bf16_t* Km; bf16_t* Vm; const float* rope32;
    DI void operator()(AccRef acc, const Unit& u, int wr, int wc, int fr, int fq) const {
        asm volatile("" : "+v"(fr), "+v"(fq));
        const int grp = u.aux, pn = u.pn;
        EPI_ROWS(u) { const int row = EPI_ROW(u);
#pragma unroll
            for (int bj = 0; bj < 2; ++bj) { f32x4 a = acc[ai][bj][m][0], b = acc[ai][bj][m][1]; const int ct = bj * 128 + wc * 32 + fq * 8;
                if (grp == 0) {
                    if (pn < 2) {
#pragma unroll
                        for (int j = 0; j < 4; ++j) { a[j] = tanhf_(a[j]); b[j] = tanhf_(b[j]); } }
                    else if (pn == 5) {
#pragma unroll
                        for (int j = 0; j < 4; ++j) { a[j] = sigmoidf_(a[j]); b[j] = sigmoidf_(b[j]); } }
                    *(u32x4*)(T + (size_t)row * 1536 + pn * 256 + ct) = pack8(a, b);
                } else if (grp == 1) {
                    const int col = pn * 256 + ct;
                    if (col < 384) {
                        const int within = col % 96; const int pos = row % TPB;
                        if (within >= 64 && pos >= CTXL) {
                            const float* rt = rope32 + ((size_t)(pos - CTXL) * 16 + ((within - 64) >> 1)) * 2;
                            const f32x4 cs0 = *(const f32x4*)rt, cs1 = *(const f32x4*)(rt + 4);
                            const f32x4 a2 = (f32x4){a[0] * cs0[0] - a[1] * cs0[1], a[0] * cs0[1] + a[1] * cs0[0], a[2] * cs0[2] - a[3] * cs0[3], a[2] * cs0[3] + a[3] * cs0[2]};
                            const f32x4 b2 = (f32x4){b[0] * cs1[0] - b[1] * cs1[1], b[0] * cs1[1] + b[1] * cs1[0], b[2] * cs1[2] - b[3] * cs1[3], b[2] * cs1[3] + b[3] * cs1[2]};
                            a = a2; b = b2;
                        }
                        a = a * QS96; b = b * QS96;
                        *(u32x4*)(Qm + (size_t)row * 384 + col) = pack8(a, b);
                    }
                } else {
                    const int col = pn * 256 + ct, head = col >> 7, within = col & 127;
                    if (within < 64) *(u32x4*)(Km + (size_t)row * 384 + head * 96 + within) = pack8(a, b);
                    else *(u32x4*)(Vm + (size_t)row * 256 + head * 64 + (within - 64)) = pack8(a, b);
                }
            } asm volatile("" ::: "memory"); }
    }
};
struct EpiL3C {
    int layer; const float* w0; const float* a0; const float* v0; const float* k_a;
    float* W; bf16_t* KD; bf16_t* BB; const bf16_t* Kr; const bf16_t* KK; bf16_t* V; const bf16_t* VF; bf16_t* Gg;
    DI void operator()(AccRef acc, const Unit& u, int wr, int wc, int fr, int fq) const {
        asm volatile("" : "+v"(fr), "+v"(fq));
        const int pn = u.pn;
        EPI_ROWS(u) { const int row = EPI_ROW(u);
#pragma unroll
            for (int bj = 0; bj < 2; ++bj) { f32x4 a = acc[ai][bj][m][0], b = acc[ai][bj][m][1]; const int ct = bj * 128 + wc * 32 + fq * 8;
                if (pn < 2) {
                    const f32x4 wa = *(const f32x4*)(w0 + pn * 256 + ct), wb = *(const f32x4*)(w0 + pn * 256 + ct + 4);
                    f32x4 oa, ob;
#pragma unroll
                    for (int j = 0; j < 4; ++j) { oa[j] = fast_exp2(-0.6065306597f * LOG2E * sigmoidf_(wa[j] + a[j])); ob[j] = fast_exp2(-0.6065306597f * LOG2E * sigmoidf_(wb[j] + b[j])); }
                    float* wp = W + (size_t)row * 512 + pn * 256 + ct; *(f32x4*)wp = oa; *(f32x4*)(wp + 4) = ob;
                } else if (pn < 4) {
                    const int d = pn - 2;
                    const f32x4 aa = *(const f32x4*)(a0 + d * 256 + ct), ab = *(const f32x4*)(a0 + d * 256 + ct + 4);
                    const f32x4 ka = *(const f32x4*)(k_a + ct), kb = *(const f32x4*)(k_a + ct + 4);
                    f32x4 k0, k1, q0, q1; unpack8(*(const u32x4*)(Kr + (size_t)row * 256 + ct), k0, k1); unpack8(*(const u32x4*)(KK + (size_t)row * 256 + ct), q0, q1);
                    f32x4 kd0, kd1, bb0, bb1;
#pragma unroll
                    for (int j = 0; j < 4; ++j) { const float s0 = sigmoidf_(aa[j] + a[j]), s1 = sigmoidf_(ab[j] + b[j]);
                        kd0[j] = k0[j] * (1.0f + (s0 - 1.0f) * ka[j]); kd1[j] = k1[j] * (1.0f + (s1 - 1.0f) * kb[j]); bb0[j] = q0[j] * s0; bb1[j] = q1[j] * s1; }
                    *(u32x4*)(KD + (size_t)row * 512 + d * 256 + ct) = pack8(kd0, kd1); *(u32x4*)(BB + (size_t)row * 512 + d * 256 + ct) = pack8(bb0, bb1);
                } else if (pn == 4) {
                    const f32x4 va = *(const f32x4*)(v0 + ct), vb = *(const f32x4*)(v0 + ct + 4);
                    f32x4 r0, r1, f0, f1; unpack8(*(const u32x4*)(V + (size_t)row * 256 + ct), r0, r1); unpack8(*(const u32x4*)(VF + (size_t)row * 256 + ct), f0, f1);
#pragma unroll
                    for (int j = 0; j < 4; ++j) { r0[j] = r0[j] + (f0[j] - r0[j]) * sigmoidf_(va[j] + a[j]); r1[j] = r1[j] + (f1[j] - r1[j]) * sigmoidf_(vb[j] + b[j]); }
                    *(u32x4*)(V + (size_t)row * 256 + ct) = pack8(r0, r1);
                } else {
                    *(u32x4*)(Gg + (size_t)row * 256 + ct) = pack8(a, b);
                }
                asm volatile("" ::: "memory");
            } }
    }
};
struct EpiMerge {
    const bf16_t* P; bf16_t* MB;
    DI void operator()(AccRef acc, const Unit& u, int wr, int wc, int fr, int fq) const {
        asm volatile("" : "+v"(fr), "+v"(fq));
        const int br = u.aux;
        EPI_ROWS(u) { const int row = EPI_ROW(u);
#pragma unroll
            for (int bj = 0; bj < 2; ++bj) { f32x4 a = acc[ai][bj][m][0], b = acc[ai][bj][m][1]; const int col = u.pn * 256 + bj * 128 + wc * 32 + fq * 8;
                f32x4 g0, g1; unpack8(*(const u32x4*)(P + (size_t)row * LDP + PC_GATE + br * 1024 + col), g0, g1);
                a = a * g0; b = b * g1;
                bf16_t* mp = MB + (size_t)row * 1024 + col;
                if (br > 0) { f32x4 p0, p1; unpack8(*(const u32x4*)mp, p0, p1); a = a + p0; b = b + p1; }
                *(u32x4*)mp = pack8(a, b); } asm volatile("" ::: "memory"); }
    }
};
struct EpiResid {
    float* X; const float* mod_l; int which;
    DI void operator()(AccRef acc, const Unit& u, int wr, int wc, int fr, int fq) const {
        asm volatile("" : "+v"(fr), "+v"(fq));
        const int vec = (u.pm % 33 == 0) ? 2 : u.pm / 33;
        const float* gv = mod_l + ((size_t)vec * 6 + which) * 1024 + u.pn * 256 + wc * 32 + fq * 8;
        f32x4 g[2][2];
#pragma unroll
        for (int bj = 0; bj < 2; ++bj) { g[bj][0] = *(const f32x4*)(gv + bj * 128); g[bj][1] = *(const f32x4*)(gv + bj * 128 + 4); }
        EPI_ROWS(u) { float* xp = X + (size_t)EPI_ROW(u) * 1024 + u.pn * 256 + wc * 32 + fq * 8;
#pragma unroll
            for (int bj = 0; bj < 2; ++bj) { f32x4 x0 = *(f32x4*)(xp + bj * 128), x1 = *(f32x4*)(xp + bj * 128 + 4);
                x0 = x0 + g[bj][0] * acc[ai][bj][m][0]; x1 = x1 + g[bj][1] * acc[ai][bj][m][1];
                *(f32x4*)(xp + bj * 128) = x0; *(f32x4*)(xp + bj * 128 + 4) = x1; } asm volatile("" ::: "memory"); }
    }
};
struct EpiSwiGlu {
    bf16_t* U; int moe;
    DI void operator()(AccRef acc, const Unit& u, int wr, int wc, int fr, int fq) const {
        asm volatile("" : "+v"(fr), "+v"(fq));
        const int tile = moe ? u.aux : u.pn;
        EPI_ROWS(u) { bf16_t* up = U + (size_t)EPI_ROW(u) * DFF + tile * 128 + wc * 32 + fq * 8;
            f32x4 a = acc[ai][0][m][0], b = acc[ai][0][m][1]; const f32x4 c = acc[ai][1][m][0], d = acc[ai][1][m][1];
#pragma unroll
            for (int j = 0; j < 4; ++j) { a[j] = siluf_(a[j]) * c[j]; b[j] = siluf_(b[j]) * d[j]; }
            *(u32x4*)up = pack8(a, b); }
    }
};
struct EpiMoeDown {
    bf16_t* Yg; const float* rowgate;
    DI void operator()(AccRef acc, const Unit& u, int wr, int wc, int fr, int fq) const {
        asm volatile("" : "+v"(fr), "+v"(fq));
        EPI_ROWS(u) { const int row = EPI_ROW(u); const float gt = rowgate[row]; bf16_t* yp = Yg + (size_t)row * 1024 + u.aux * 256 + wc * 32 + fq * 8;
#pragma unroll
            for (int bj = 0; bj < 2; ++bj) *(u32x4*)(yp + bj * 128) = pack8(acc[ai][bj][m][0] * gt, acc[ai][bj][m][1] * gt); }
    }
};
struct ConvMat { const float* s0; const float* s1; int ld; int ksrc; bf16_t* dst; int N; int K; int kind; int nvalid; };
DI int perm64(int i) { return (i >> 1) + 32 * (i & 1); }
DI int perm32r(int i) { return (i >> 1) + 16 * (i & 1); }
DI const float* conv_col(const ConvMat& M, int n) {
    if (M.kind == 0) return n < M.nvalid ? M.s0 + n : nullptr;
    if (M.kind == 1) {
        int col;
        if (n < 1024) col = n;
        else if (n < 1280) { const int j = n - 1024; col = 1024 + (j & ~63) + perm64(j & 63); }
        else if (n < 1408) { const int j = n - 1280; col = 1280 + (j & ~63) + perm64(j & 63); }
        else if (n < 1920) col = n;
        else if (n < 1952) col = 1920 + perm32r(n - 1920);
        else if (n < 2048) return nullptr;
        else if (n < 2304) { const int j = n - 2048; col = 1952 + (j & ~63) + perm64(j & 63); }
        else if (n < 2432) { const int j = n - 2304; col = 2208 + (j & ~63) + perm64(j & 63); }
        else if (n < 2560) col = 2336 + (n - 2432);
        else col = 2464 + (n - 2560);
        return M.s0 + col;
    }
    if (M.kind == 2) {
        if (n >= 384) return nullptr;
        const int h = n / 96, w = n % 96;
        return M.s0 + (w < 64 ? n : h * 96 + 64 + perm32r(w - 64));
    }
    {
        const int t = n >> 8, half = (n >> 7) & 1, j = n & 127;
        return (const float*)((uintptr_t)M.s0 + (uintptr_t)half * ((uintptr_t)M.s1 - (uintptr_t)M.s0)) + t * 128 + j;
    }
}
DI void conv_item(const ConvMat& M, int item, LAS float* scr, int lane) {
    const int nkb = M.K / 64, nb = item / nkb, kb = item % nkb, n0 = nb * 32, k0 = kb * 64;
    const float* cp = conv_col(M, n0 + (lane & 31));
#pragma unroll 8
    for (int i = 0; i < 32; ++i) { const int kk = 2 * i + (lane >> 5); const int k = k0 + kk;
        float v = 0.f; if (cp != nullptr && k < M.ksrc) v = cp[(size_t)k * M.ld];
        scr[kk * 33 + (lane & 31)] = v; }
    LDS_WAIT(); asm volatile("" ::: "memory");
    const int c = lane & 7;
#pragma unroll
    for (int j = 0; j < 4; ++j) { const int n = (lane >> 3) + 8 * j; const LAS float* s = scr + (8 * c) * 33 + n;
        u32x4 o; o.x = pk2(s[0 * 33], s[1 * 33]); o.y = pk2(s[2 * 33], s[3 * 33]); o.z = pk2(s[4 * 33], s[5 * 33]); o.w = pk2(s[6 * 33], s[7 * 33]);
        *(u32x4*)(M.dst + (size_t)(n0 + n) * M.K + k0 + 8 * c) = o; }
    LDS_WAIT(); asm volatile("" ::: "memory");
}
DI ConvMat mkmat(const float* s0, const float* s1, int ld, int ksrc, bf16_t* dst, int N, int K, int kind, int nvalid) { ConvMat M; M.s0 = s0; M.s1 = s1; M.ld = ld; M.ksrc = ksrc; M.dst = dst; M.N = N; M.K = K; M.kind = kind; M.nvalid = nvalid; return M; }
DI void conv_run(Frame& F, const ConvMat M, int& start) {
    LAS float* scr = (LAS float*)(F.lds + F.wave * 16384);
    const int gw = F.vcu * 8 + F.wave, NGW = F.G * 8;
    const int nitems = (M.N / 32) * (M.K / 64);
    int it = (gw - start) % NGW; if (it < 0) it += NGW;
    for (; it < nitems; it += NGW) conv_item(M, it, scr, F.lane);
    start = (start + nitems) % NGW;
}
DI void convert_layer_weights(Frame& F, int l) {
    unsigned char* wl = F.ws + WS_WL;
    int start = 0;
    conv_run(F, mkmat(inp(I_WIN) + (size_t)l * 1024 * IN_W, nullptr, IN_W, 1024, (bf16_t*)(wl + WL_WIN), NP_GEMM, 1024, 1, NP_GEMM), start);
    for (int i = 0; i < 4; ++i) conv_run(F, mkmat(inp(I_WBR) + (size_t)(l * 4 + i) * 256 * 1024, nullptr, 1024, 256, (bf16_t*)(wl + WL_WBR) + (size_t)i * 1024 * 256, 1024, 256, 0, 1024), start);
    conv_run(F, mkmat(inp(I_WOUT) + (size_t)l * 1024 * 1024, nullptr, 1024, 1024, (bf16_t*)(wl + WL_WOUT), 1024, 1024, 0, 1024), start);
    for (int d = 0; d < 2; ++d) conv_run(F, mkmat(inp(I_W1) + (size_t)(l * 2 + d) * 256 * 64, nullptr, 64, 256, (bf16_t*)(wl + WL_L1) + (size_t)d * 256 * 256, 256, 256, 0, 64), start);
    for (int d = 0; d < 2; ++d) conv_run(F, mkmat(inp(I_A1) + (size_t)(l * 2 + d) * 256 * 64, nullptr, 64, 256, (bf16_t*)(wl + WL_L1) + (size_t)(2 + d) * 256 * 256, 256, 256, 0, 64), start);
    conv_run(F, mkmat(inp(I_V1) + (size_t)(l > 0 ? l - 1 : 0) * 256 * 32, nullptr, 32, 256, (bf16_t*)(wl + WL_L1) + (size_t)4 * 256 * 256, 256, 256, 0, l > 0 ? 32 : 0), start);
    conv_run(F, mkmat(inp(I_G1) + (size_t)l * 256 * 128, nullptr, 128, 256, (bf16_t*)(wl + WL_L1) + (size_t)5 * 256 * 256, 256, 256, 0, 128), start);
    for (int d = 0; d < 2; ++d) conv_run(F, mkmat(inp(I_W2) + (size_t)(l * 2 + d) * 64 * 256, nullptr, 256, 64, (bf16_t*)(wl + WL_L2) + (size_t)d * 256 * 256, 256, 256, 0, 256), start);
    for (int d = 0; d < 2; ++d) conv_run(F, mkmat(inp(I_A2) + (size_t)(l * 2 + d) * 64 * 256, nullptr, 256, 64, (bf16_t*)(wl + WL_L2) + (size_t)(2 + d) * 256 * 256, 256, 256, 0, 256), start);
    conv_run(F, mkmat(inp(I_V2) + (size_t)(l > 0 ? l - 1 : 0) * 32 * 256, nullptr, 256, l > 0 ? 32 : 0, (bf16_t*)(wl + WL_L2) + (size_t)4 * 256 * 256, 256, 256, 0, 256), start);
    conv_run(F, mkmat(inp(I_G2) + (size_t)l * 128 * 256, nullptr, 256, 128, (bf16_t*)(wl + WL_L2) + (size_t)5 * 256 * 256, 256, 256, 0, 256), start);
    conv_run(F, mkmat(inp(I_WUQ) + (size_t)l * 256 * 384, nullptr, 384, 256, (bf16_t*)(wl + WL_UQ), 512, 256, 2, 384), start);
    conv_run(F, mkmat(inp(I_WUKV) + (size_t)l * 128 * 512, nullptr, 512, 128, (bf16_t*)(wl + WL_UKV), 512, 256, 0, 512), start);
    if ((l & 1) == 0) {
        conv_run(F, mkmat(inp(I_FW1) + (size_t)(l >> 1) * 1024 * DFF, inp(I_FW3) + (size_t)(l >> 1) * 1024 * DFF, DFF, 1024, (bf16_t*)(wl + WL_W13), 7168, 1024, 3, 7168), start);
        conv_run(F, mkmat(inp(I_FW2) + (size_t)(l >> 1) * DFF * 1024, nullptr, 1024, DFF, (bf16_t*)(wl + WL_W2), 1024, DFF, 0, 1024), start);
    } else {
        for (int e = 0; e < NEXP; ++e) { const size_t eo = (size_t)((l >> 1) * NEXP + e) * 1024 * DFF;
            conv_run(F, mkmat(inp(I_MW1) + eo, inp(I_MW3) + eo, DFF, 1024, (bf16_t*)(wl + WL_W13) + (size_t)e * 7168 * 1024, 7168, 1024, 3, 7168), start); }
        for (int e = 0; e < NEXP; ++e)
            conv_run(F, mkmat(inp(I_MW2) + (size_t)((l >> 1) * NEXP + e) * DFF * 1024, nullptr, 1024, DFF, (bf16_t*)(wl + WL_W2) + (size_t)e * 1024 * DFF, 1024, DFF, 0, 1024), start);
    }
}

DI void p0_prologue(Frame& F) {
    const int gw = F.vcu * 8 + F.wave, NGW = F.G * 8;
    for (int r = gw; r < NROW; r += NGW) {
        const int b = r / TPB, pos = r % TPB;
        const float* src = pos < CTXL ? inp(I_CTX) + ((size_t)b * CTXL + pos) * 1024 : inp(I_X) + ((size_t)b * SEQ + (pos - CTXL)) * 1024;
        const f32x4* s4 = (const f32x4*)src + F.lane; f32x4* d4 = (f32x4*)(FX(F) + (size_t)r * 1024) + F.lane;
#pragma unroll
        for (int j = 0; j < 4; ++j) d4[64 * j] = s4[64 * j];
    }
    {
        float* r64 = (float*)(F.ws + WS_ROPE64); float* r32 = (float*)(F.ws + WS_ROPE32);
        const int gt = (F.vcu * 512 + F.tid), NT = F.G * 512;
        for (int i = gt; i < SEQ * 48; i += NT) {
            const int t = i / 48, q = i % 48; const float row = (float)(t / GRIDW), col = (float)(t % GRIDW);
            float ang;
            if (q < 32) { const int f = q & 15; ang = (q < 16 ? row : col) * powf(10000.0f, -(float)f / 16.0f); }
            else { const int p = q - 32, f = p & 7; ang = (p < 8 ? row : col) * powf(10000.0f, -(float)f / 8.0f); }
            float sn, cs; sincosf(ang, &sn, &cs);
            if (q < 32) { r64[((size_t)t * 32 + q) * 2] = cs; r64[((size_t)t * 32 + q) * 2 + 1] = sn; }
            else { r32[((size_t)t * 16 + (q - 32)) * 2] = cs; r32[((size_t)t * 16 + (q - 32)) * 2 + 1] = sn; }
        }
    }
    {
        LAS float* sl = (LAS float*)F.lds;
        LAS float* red = sl + 3072;
        for (int i = F.tid; i < 3072; i += 512) { const int v = i >> 10, k = i & 1023; const float cvv = v < 2 ? inp(I_C)[v * 1024 + k] : inp(I_CCTX)[k]; sl[i] = siluf_(cvv); }
        __syncthreads();
        const int j = F.tid & 63, ks = F.tid >> 6;
        for (int ch = F.vcu; ch < 4 * 96; ch += F.G) {
            const int l = ch / 96, jb = (ch % 96) * 64 + j;
            const float* wp = inp(I_WMOD) + (size_t)l * 1024 * 6144 + jb;
            float a0 = 0.f, a1 = 0.f, a2 = 0.f;
            for (int k = ks * 128; k < ks * 128 + 128; ++k) { const float w = wp[(size_t)k * 6144]; a0 += sl[k] * w; a1 += sl[1024 + k] * w; a2 += sl[2048 + k] * w; }
            red[(ks * 3 + 0) * 64 + j] = a0; red[(ks * 3 + 1) * 64 + j] = a1; red[(ks * 3 + 2) * 64 + j] = a2;
            __syncthreads();
            if (F.tid < 192) { const int v = F.tid >> 6; float s = 0.f;
#pragma unroll
                for (int q = 0; q < 8; ++q) s += red[(q * 3 + v) * 64 + j];
                FMOD(F)[(size_t)(l * 3 + v) * 6144 + jb] = s + inp(I_BMOD)[l * 6144 + jb]; }
            __syncthreads();
        }
    }
}

template <int MODE>
DI void norm_phase(Frame& F, int l) {
    const int rpw = (NROW + F.G - 1) / F.G;
    const int bid = blockIdx.x;
    const int r0 = bid * rpw, r1 = (r0 + rpw) < NROW ? (r0 + rpw) : NROW;
    const bool combine = (MODE == 0 && l > 0 && ((l - 1) & 1)) || MODE == 2;
    const int lprev = MODE == 2 ? DEPTH - 1 : l - 1;
    const bool moe = (MODE == 1) && (l & 1);
    const float* nw = MODE == 0 ? inp(I_NORM1) + l * 1024 : MODE == 1 ? inp(I_NORM2) + l * 1024 : inp(I_FNORM);
    const bf16_t* Yg = (const bf16_t*)(F.ws + WS_YG);
    const int* dstp = (const int*)(F.ws + WS_ASG_DST);
    volatile LAS int* hist = (volatile LAS int*)(F.lds + MISC_OFF + 64);
    if (moe) { if (F.tid < 8) hist[F.tid] = 0; __syncthreads(); }
    for (int r = r0 + F.wave; r < r1; r += 8) {
        const int vec = row_vec(r);
        float* xr = FX(F) + (size_t)r * 1024;
        f32x4 x[4];
#pragma unroll
        for (int j = 0; j < 4; ++j) x[j] = *((const f32x4*)xr + F.lane + 64 * j);
        if (combine) {
            const int d0 = dstp[r * 2], d1 = dstp[r * 2 + 1];
            const float* g2 = modp(F, lprev, vec, 5);
#pragma unroll
            for (int j = 0; j < 4; ++j) { const int c = 4 * F.lane + 256 * j;
                const u32x2 y0 = *(const u32x2*)(Yg + (size_t)d0 * 1024 + c), y1 = *(const u32x2*)(Yg + (size_t)d1 * 1024 + c); const f32x4 g = *(const f32x4*)(g2 + c);
                x[j][0] += g[0] * (bflo(y0.x) + bflo(y1.x)); x[j][1] += g[1] * (bfhi(y0.x) + bfhi(y1.x)); x[j][2] += g[2] * (bflo(y0.y) + bflo(y1.y)); x[j][3] += g[3] * (bfhi(y0.y) + bfhi(y1.y));
                if (MODE == 0) *((f32x4*)xr + F.lane + 64 * j) = x[j]; }
        }
        float ss = 0.f;
#pragma unroll
        for (int j = 0; j < 4; ++j) ss += (x[j][0] * x[j][0] + x[j][1] * x[j][1]) + (x[j][2] * x[j][2] + x[j][3] * x[j][3]);
        const float rstd = 1.0f / sqrtf(wave_sum(ss) * (1.0f / 1024.0f) + 1e-6f);
        if (MODE == 2) {
            const int pos = r % TPB;
            if (pos >= CTXL) { float* op = F.out + ((size_t)(r / TPB) * SEQ + (pos - CTXL)) * 1024;
#pragma unroll
                for (int j = 0; j < 4; ++j) { const f32x4 w = *(const f32x4*)(nw + 4 * F.lane + 256 * j); *((f32x4*)op + F.lane + 64 * j) = x[j] * rstd * w; } }
            continue;
        }
        const float* sc = modp(F, l, vec, MODE == 0 ? 1 : 4); const float* sh = modp(F, l, vec, MODE == 0 ? 0 : 3);
        f32x4 h[4];
#pragma unroll
        for (int j = 0; j < 4; ++j) { const int c = 4 * F.lane + 256 * j; const f32x4 w = *(const f32x4*)(nw + c), s1 = *(const f32x4*)(sc + c), s0 = *(const f32x4*)(sh + c);
            h[j] = (x[j] * rstd * w) * (1.0f + s1) + s0;
            u32x2 o; o.x = pk2(h[j][0], h[j][1]); o.y = pk2(h[j][2], h[j][3]); *(u32x2*)(FHB(F) + (size_t)r * 1024 + c) = o; }
        if (moe) {
            const float* wr = inp(I_ROUTER) + (size_t)(l >> 1) * 1024 * NEXP;
            float lg[8];
#pragma unroll
            for (int e = 0; e < 8; ++e) lg[e] = 0.f;
#pragma unroll
            for (int j = 0; j < 4; ++j)
#pragma unroll
                for (int q = 0; q < 4; ++q) { const int c = 4 * F.lane + 256 * j + q; const f32x4 w0 = *(const f32x4*)(wr + (size_t)c * 8), w1 = *(const f32x4*)(wr + (size_t)c * 8 + 4); const float hv = h[j][q];
                    lg[0] += hv * w0[0]; lg[1] += hv * w0[1]; lg[2] += hv * w0[2]; lg[3] += hv * w0[3]; lg[4] += hv * w1[0]; lg[5] += hv * w1[1]; lg[6] += hv * w1[2]; lg[7] += hv * w1[3]; }
#pragma unroll
            for (int e = 0; e < 8; ++e) lg[e] = wave_sum(lg[e]);
            int e1 = 0; float l1 = lg[0];
#pragma unroll
            for (int e = 1; e < 8; ++e) if (lg[e] > l1) { l1 = lg[e]; e1 = e; }
            int e2 = -1; float l2 = -3.0e38f;
#pragma unroll
            for (int e = 0; e < 8; ++e) if (e != e1 && lg[e] > l2) { l2 = lg[e]; e2 = e; }
            if (e2 < 0) e2 = (e1 + 1) & 7;
            if (F.lane == 0) {
                const float ex = __expf(l2 - l1); const float g1v = 1.0f / (1.0f + ex), g2v = ex / (1.0f + ex);
                const int lp1 = __hip_atomic_fetch_add((LAS int*)&hist[e1], 1, __ATOMIC_RELAXED, __HIP_MEMORY_SCOPE_WORKGROUP);
                const int lp2 = __hip_atomic_fetch_add((LAS int*)&hist[e2], 1, __ATOMIC_RELAXED, __HIP_MEMORY_SCOPE_WORKGROUP);
                int* asg = (int*)(F.ws + WS_ASG) + (size_t)r * 4; asg[0] = e1 | (e2 << 8); asg[1] = lp1; asg[2] = lp2;
                float* ag = (float*)(F.ws + WS_ASG_GATE) + (size_t)r * 2; ag[0] = g1v; ag[1] = g2v;
            }
        }
    }
    if (moe) {
        __syncthreads();
        if (F.tid < 8) { const int cnt = hist[F.tid]; const int bank = l >> 1;
            const unsigned base = cnt > 0 ? __hip_atomic_fetch_add(F.ctl + CW_MOECNT + bank * 64 + F.tid, (unsigned)cnt, __ATOMIC_RELAXED, __HIP_MEMORY_SCOPE_AGENT) : 0u;
            F.ctl[CW_WGBASE + (bank * 256 + bid) * 8 + F.tid] = base; }
    }
}
DI void moe_panels(const Frame& F, int l, int (&cp)[9]) {
    int acc = 0;
#pragma unroll
    for (int e = 0; e < 8; ++e) { cp[e] = acc; const unsigned c = __hip_atomic_load(F.ctl + CW_MOECNT + (l >> 1) * 64 + e, __ATOMIC_RELAXED, __HIP_MEMORY_SCOPE_AGENT); acc += (int)((c + 255u) >> 8); }
    cp[8] = acc;
#pragma unroll
    for (int e = 0; e < 9; ++e) cp[e] = __builtin_amdgcn_readfirstlane(cp[e]);
}
DI void moe_gather(Frame& F, int l) {
    int cp[9]; moe_panels(F, l, cp);
    const int rpw = (NROW + F.G - 1) / F.G; const int bid = blockIdx.x;
    const int r0 = bid * rpw, r1 = (r0 + rpw) < NROW ? (r0 + rpw) : NROW;
    bf16_t* Xg = (bf16_t*)(F.ws + WS_XG); float* rowgate = (float*)(F.ws + WS_ROWGATE); int* dstp = (int*)(F.ws + WS_ASG_DST);
    const unsigned* wgb = F.ctl + CW_WGBASE + ((l >> 1) * 256 + bid) * 8;
    for (int r = r0 + F.wave; r < r1; r += 8) {
        const int* asg = (const int*)(F.ws + WS_ASG) + (size_t)r * 4; const float* ag = (const float*)(F.ws + WS_ASG_GATE) + (size_t)r * 2;
        const int ee = asg[0], e1 = ee & 255, e2 = ee >> 8;
        int cpa = 0, cpb = 0;
#pragma unroll
        for (int e = 0; e < 8; ++e) { cpa = (e == e1) ? cp[e] : cpa; cpb = (e == e2) ? cp[e] : cpb; }
        const int d0 = cpa * 256 + (int)wgb[e1] + asg[1], d1 = cpb * 256 + (int)wgb[e2] + asg[2];
        const u32x4* src = (const u32x4*)(FHB(F) + (size_t)r * 1024) + F.lane;
        const u32x4 v0 = src[0], v1 = src[64];
        u32x4* p0 = (u32x4*)(Xg + (size_t)d0 * 1024) + F.lane; u32x4* p1 = (u32x4*)(Xg + (size_t)d1 * 1024) + F.lane;
        p0[0] = v0; p0[64] = v1; p1[0] = v0; p1[64] = v1;
        if (F.lane == 0) { rowgate[d0] = ag[0]; rowgate[d1] = ag[1]; dstp[r * 2] = d0; dstp[r * 2 + 1] = d1; }
    }
}

DI f32x4 ld4bf(const bf16_t* p) { const u32x2 w = *(const u32x2*)p; return (f32x4){bflo(w.x), bfhi(w.x), bflo(w.y), bfhi(w.y)}; }
DI void st4bf(bf16_t* p, const f32x4 v) { u32x2 o; o.x = pk2(v[0], v[1]); o.y = pk2(v[2], v[3]); *(u32x2*)p = o; }
DI f32x4 rope2(const f32x4 v, const float* cs) {
    const f32x4 t = *(const f32x4*)cs;
    return (f32x4){v[0] * t[0] - v[1] * t[1], v[0] * t[1] + v[1] * t[0], v[2] * t[2] - v[3] * t[3], v[2] * t[3] + v[3] * t[2]};
}
DI void prep_phase(Frame& F, int l) {
    const int gw = F.vcu * 8 + F.wave, NGW = F.G * 8, lane = F.lane;
    bf16_t* RR = (bf16_t*)(F.ws + WS_RR); bf16_t* KK = (bf16_t*)(F.ws + WS_KK); bf16_t* KR = (bf16_t*)(F.ws + WS_KR); bf16_t* V = (bf16_t*)(F.ws + WS_V); bf16_t* VF = (bf16_t*)(F.ws + WS_VF);
    bf16_t* Km = (bf16_t*)(F.ws + WS_KMLA);
    const float* r64 = (const float*)(F.ws + WS_ROPE64); const float* r32 = (const float*)(F.ws + WS_ROPE32);
    const float* mu = inp(I_MU) + (size_t)l * 2048;
    const int c4 = 4 * lane;
    for (int r = gw; r < NROW; r += NGW) {
        const int pos = r % TPB; const bool isctx = pos < CTXL; const int t = pos - CTXL;
        const bool hasp = isctx ? (pos > 0) : (t > 0), hasn = isctx ? (pos < CTXL - 1) : (t < SEQ - 1);
        bf16_t* pr = FP(F) + (size_t)r * LDP;
#pragma unroll
        for (int s = 0; s < 4; ++s) {
            const f32x4 f = ld4bf(pr + s * 256 + c4);
            const f32x4 fp = hasp ? ld4bf(pr - LDP + s * 256 + c4) : (f32x4){0.f, 0.f, 0.f, 0.f};
            const f32x4 fn = hasn ? ld4bf(pr + LDP + s * 256 + c4) : (f32x4){0.f, 0.f, 0.f, 0.f};
            const f32x4 m0 = *(const f32x4*)(mu + s * 256 + c4), m1 = *(const f32x4*)(mu + 1024 + s * 256 + c4);
            const f32x4 o = f + m0 * (fp - f) + m1 * (fn - f);
            if (s == 0) st4bf(RR + (size_t)r * 256 + c4, o);
            else if (s == 1) {
                st4bf(KR + (size_t)r * 256 + c4, o);
                const f32x4 kx = o * *(const f32x4*)(inp(I_KK) + l * 256 + c4);
                const float ss = sum16((kx[0] * kx[0] + kx[1] * kx[1]) + (kx[2] * kx[2] + kx[3] * kx[3]));
                st4bf(KK + (size_t)r * 256 + c4, kx * (1.0f / sqrtf(ss + 1e-12f)));
            } else if (s == 2) { st4bf(V + (size_t)r * 256 + c4, o); if (l == 0) st4bf(VF + (size_t)r * 256 + c4, o); }
            else st4bf(pr + PC_Z + c4, o);
        }
        {
            f32x4 q = ld4bf(pr + PC_SWQ + c4);
            const int pi = (c4 & 63) >> 1;
            if (!isctx) q = rope2(q, r64 + ((size_t)t * 32 + pi) * 2);
            st4bf(pr + PC_SWQ + c4, q * QS64);
            if (lane < 32) { f32x4 k = ld4bf(pr + PC_SWK + c4); if (!isctx) { k = rope2(k, r64 + ((size_t)t * 32 + pi) * 2); st4bf(pr + PC_SWK + c4, k); } }
        }
        {
            f32x4 q = ld4bf(pr + PC_CQ + c4);
            const float ss = wave_sum((q[0] * q[0] + q[1] * q[1]) + (q[2] * q[2] + q[3] * q[3]));
            q = q * (1.0f / sqrtf(ss * (1.0f / 256.0f) + 1e-6f)) * *(const f32x4*)(inp(I_MQN) + l * 256 + c4);
            st4bf(pr + PC_CQ + c4, q);
            f32x4 kv = lane < 32 ? ld4bf(pr + PC_CKV + c4) : (f32x4){0.f, 0.f, 0.f, 0.f};
            const float s2 = wave_sum((kv[0] * kv[0] + kv[1] * kv[1]) + (kv[2] * kv[2] + kv[3] * kv[3]));
            if (lane < 32) { kv = kv * (1.0f / sqrtf(s2 * (1.0f / 128.0f) + 1e-6f)) * *(const f32x4*)(inp(I_MKVN) + l * 128 + c4); st4bf(pr + PC_CKV + c4, kv); }
            if (lane < 8) { f32x4 kr = ld4bf(pr + PC_KR + c4); if (!isctx) kr = rope2(kr, r32 + ((size_t)t * 16 + 2 * lane) * 2);
#pragma unroll
                for (int h = 0; h < 4; ++h) st4bf(Km + (size_t)r * 384 + h * 96 + 64 + c4, kr); }
        }
        {
            const int i0 = c4 & 63; const int pi = i0 >> 1;
            f32x4 gq, gk;
#pragma unroll
            for (int j = 0; j < 4; ++j) { gq[j] = inp(I_GQN)[l * 64 + perm64(i0 + j)]; gk[j] = inp(I_GKN)[l * 64 + perm64(i0 + j)]; }
            f32x4 q = ld4bf(pr + PC_GAQ + c4);
            const float ss = sum16((q[0] * q[0] + q[1] * q[1]) + (q[2] * q[2] + q[3] * q[3]));
            q = q * (1.0f / sqrtf(ss * (1.0f / 64.0f) + 1e-6f)) * gq;
            if (!isctx) q = rope2(q, r64 + ((size_t)t * 32 + pi) * 2);
            st4bf(pr + PC_GAQ + c4, q * QS64);
            f32x4 k = lane < 32 ? ld4bf(pr + PC_GAK + c4) : (f32x4){0.f, 0.f, 0.f, 0.f};
            const float s2 = sum16((k[0] * k[0] + k[1] * k[1]) + (k[2] * k[2] + k[3] * k[3]));
            if (lane < 32) { k = k * (1.0f / sqrtf(s2 * (1.0f / 64.0f) + 1e-6f)) * gk; if (!isctx) k = rope2(k, r64 + ((size_t)t * 32 + pi) * 2); st4bf(pr + PC_GAK + c4, k); }
        }
    }
}

DI void finish_phase(Frame& F, int l) {
    const int gw = F.vcu * 8 + F.wave, NGW = F.G * 8, lane = F.lane, c4 = 4 * lane, hd = lane >> 4;
    const bf16_t* RR = (const bf16_t*)(F.ws + WS_RR); const bf16_t* KD = (const bf16_t*)(F.ws + WS_KD); const bf16_t* V = (const bf16_t*)(F.ws + WS_V); const bf16_t* Gg = (const bf16_t*)(F.ws + WS_G);
    const float* Y0 = (const float*)(F.ws + WS_YDIR); const float* Y1 = Y0 + (size_t)NROW * 256;
    const float* OP = (const float*)(F.ws + WS_OPART); const float* ML = (const float*)(F.ws + WS_ML);
    bf16_t* YA = (bf16_t*)(F.ws + WS_YALL);
    const f32x4 rk = *(const f32x4*)(inp(I_RK) + l * 256 + c4), lw = *(const f32x4*)(inp(I_LNW) + l * 256 + c4), lb = *(const f32x4*)(inp(I_LNB) + l * 256 + c4);
    for (int r = gw; r < NROW; r += NGW) {
        {
            const f32x4 y = *(const f32x4*)(Y0 + (size_t)r * 256 + c4) + *(const f32x4*)(Y1 + (size_t)r * 256 + c4);
            const float mean = sum16((y[0] + y[1]) + (y[2] + y[3])) * (1.0f / 64.0f);
            const f32x4 d = y - mean;
            const float var = sum16((d[0] * d[0] + d[1] * d[1]) + (d[2] * d[2] + d[3] * d[3])) * (1.0f / 64.0f);
            const f32x4 yn = d * (1.0f / sqrtf(var + 64e-5f)) * lw + lb;
            const f32x4 rr = ld4bf(RR + (size_t)r * 256 + c4), k0 = ld4bf(KD + (size_t)r * 512 + c4), k1 = ld4bf(KD + (size_t)r * 512 + 256 + c4), v = ld4bf(V + (size_t)r * 256 + c4), g = ld4bf(Gg + (size_t)r * 256 + c4);
            const f32x4 pr = rr * (k0 + k1) * rk;
            const float bon = sum16((pr[0] + pr[1]) + (pr[2] + pr[3]));
            st4bf(YA + (size_t)r * 1024 + c4, (yn + bon * v) * g);
        }
#pragma unroll
        for (int kind = 0; kind < 2; ++kind) {
            const float* m0p = ML + (((size_t)(kind * NSPLIT + 0) * NROW + r) * 4 + hd) * 2; const float* m1p = ML + (((size_t)(kind * NSPLIT + 1) * NROW + r) * 4 + hd) * 2;
            const float m0 = m0p[0], l0 = m0p[1], m1 = m1p[0], l1 = m1p[1];
            const float mm = m0 > m1 ? m0 : m1; const float w0 = fast_exp2(m0 - mm), w1 = fast_exp2(m1 - mm);
            const f32x4 o0 = *(const f32x4*)(OP + ((size_t)(kind * NSPLIT + 0) * NROW + r) * 256 + c4), o1 = *(const f32x4*)(OP + ((size_t)(kind * NSPLIT + 1) * NROW + r) * 256 + c4);
            const float inv = 1.0f / (w0 * l0 + w1 * l1);
            st4bf(YA + (size_t)r * 1024 + 512 + kind * 256 + c4, (o0 * w0 + o1 * w1) * inv);
        }
    }
}
typedef short v4i16_t __attribute__((ext_vector_type(4)));
DI s16x4 vtr(const LAS unsigned char* p) { return __builtin_bit_cast(s16x4, __builtin_amdgcn_ds_read_tr16_b64_v4i16((LAS v4i16_t*)p)); }
DI int crow(int r, int hi) { return (r & 3) + 8 * (r >> 2) + 4 * hi; }

struct AttnArgs {
    const bf16_t* Q; int qpitch;
    const bf16_t* K; int kpitch;
    const bf16_t* V; int vpitch;
    int ka0, ka1, kb0, kb1;
    int window;
    int qlat0;
    int use_sink; float sink_l2;
    int out_mode;
    bf16_t* obf; float* opf; float* mlp;
    int empty_part; float* opf2; float* mlp2;
};

template <int DQK>
DI void attn_unit(Frame& F, const AttnArgs& A) {
    constexpr int NCH = DQK / 8, KB = NCH * 1024, BUF = KB + 8192, ND = DQK / 16;
    const int tid = F.tid, lane = F.lane, wid = F.wave, r32 = lane & 31, hi = lane >> 5;
    LAS unsigned char* lds = F.lds;
    bf16x8 qr[ND];
    { const bf16_t* qp = A.Q + (size_t)(wid * 32 + r32) * A.qpitch + 8 * hi;
#pragma unroll
      for (int d0 = 0; d0 < ND; ++d0) qr[d0] = *(const bf16x8*)(qp + 16 * d0); }
    const int na = (A.ka1 - A.ka0) >> 6, nb = (A.kb1 - A.kb0) >> 6, nt = na + nb;
    const bf16_t* ksrc = A.K + (size_t)lane * A.kpitch + wid * 8;
    const bf16_t* ksrc2 = A.K + (size_t)lane * A.kpitch + (8 + wid) * 8;
    const bf16_t* vsrc = A.V + (size_t)(16 * (wid & 3) + (lane >> 2)) * A.vpitch + (wid >> 2) * 32 + (lane & 3) * 8;
#define ATT_DMA(t) do { const int kr_ = (t) < na ? A.ka0 + 64 * (t) : A.kb0 + 64 * ((t) - na); LAS unsigned char* bb_ = lds + ((t) & 1) * BUF; \
        __builtin_amdgcn_global_load_lds((const unsigned*)(ksrc + (size_t)kr_ * A.kpitch), (LAS unsigned*)(bb_ + wid * 1024), 16, 0, 0); \
        if (DQK == 96 && wid < 4) __builtin_amdgcn_global_load_lds((const unsigned*)(ksrc2 + (size_t)kr_ * A.kpitch), (LAS unsigned*)(bb_ + (8 + wid) * 1024), 16, 0, 0); \
        __builtin_amdgcn_global_load_lds((const unsigned*)(vsrc + (size_t)kr_ * A.vpitch), (LAS unsigned*)(bb_ + KB + wid * 1024), 16, 0, 0); } while (0)
    float m_run = -INFINITY, l_run = 0.f;
    f32x16 o0, o1;
#pragma unroll
    for (int i = 0; i < 16; ++i) { o0[i] = 0.f; o1[i] = 0.f; }
    const int qw0 = A.qlat0 + wid * 32;
    if (nt > 0) ATT_DMA(0);
    for (int t = 0; t < nt; ++t) {
        asm volatile("s_waitcnt vmcnt(0)" ::: "memory");
        __syncthreads();
        if (t + 1 < nt) ATT_DMA(t + 1);
        const int keyrow = t < na ? A.ka0 + 64 * t : A.kb0 + 64 * (t - na);
        const bool banded = A.window && t >= na;
        const int kj0 = keyrow - CTXL;
        if (banded && (kj0 + 63 < qw0 - 128 || kj0 > qw0 + 31 + 128)) continue;
        const LAS unsigned char* kb = lds + (t & 1) * BUF;
        const LAS unsigned char* vb = kb + KB;
        f32x16 p0, p1;
#pragma unroll
        for (int i = 0; i < 16; ++i) { p0[i] = 0.f; p1[i] = 0.f; }
        const LAS unsigned char* kf = kb + hi * 1024 + r32 * 16;
#pragma unroll
        for (int d0 = 0; d0 < ND; ++d0) {
            const bf16x8 a0 = *(const LAS bf16x8*)(kf + d0 * 2048), a1 = *(const LAS bf16x8*)(kf + d0 * 2048 + 512);
            p0 = __builtin_amdgcn_mfma_f32_32x32x16_bf16(a0, qr[d0], p0, 0, 0, 0);
            p1 = __builtin_amdgcn_mfma_f32_32x32x16_bf16(a1, qr[d0], p1, 0, 0, 0);
        }
        if (banded) {
            const int qi = qw0 + r32;
#pragma unroll
            for (int i = 0; i < 16; ++i) { const int kj = kj0 + crow(i, hi); const int d0_ = qi - kj, d1_ = qi - (kj + 32);
                if (d0_ > 128 || d0_ < -128) p0[i] = -INFINITY; if (d1_ > 128 || d1_ < -128) p1[i] = -INFINITY; }
        }
        float mx = p0[0];
#pragma unroll
        for (int i = 1; i < 16; ++i) mx = __builtin_fmaxf(mx, p0[i]);
#pragma unroll
        for (int i = 0; i < 16; ++i) mx = __builtin_fmaxf(mx, p1[i]);
        mx = __builtin_fmaxf(mx, __shfl_xor(mx, 32));
        const float m_new = __builtin_fmaxf(m_run, mx);
        const float alpha = fast_exp2(m_run - m_new);
        m_run = m_new;
        float ps = 0.f;
#pragma unroll
        for (int i = 0; i < 16; ++i) { p0[i] = fast_exp2(p0[i] - m_new); p1[i] = fast_exp2(p1[i] - m_new); ps += p0[i] + p1[i]; }
        l_run = l_run * alpha + ps;
#pragma unroll
        for (int i = 0; i < 16; ++i) { o0[i] *= alpha; o1[i] *= alpha; }
        bf16x8 pb[4];
#pragma unroll
        for (int s = 0; s < 2; ++s) {
            u32x4 w0, w1;
            w0.x = cvt_pk_bf16(p0[8 * s + 0], p0[8 * s + 1]); w0.y = cvt_pk_bf16(p0[8 * s + 2], p0[8 * s + 3]); w0.z = cvt_pk_bf16(p0[8 * s + 4], p0[8 * s + 5]); w0.w = cvt_pk_bf16(p0[8 * s + 6], p0[8 * s + 7]);
            w1.x = cvt_pk_bf16(p1[8 * s + 0], p1[8 * s + 1]); w1.y = cvt_pk_bf16(p1[8 * s + 2], p1[8 * s + 3]); w1.z = cvt_pk_bf16(p1[8 * s + 4], p1[8 * s + 5]); w1.w = cvt_pk_bf16(p1[8 * s + 6], p1[8 * s + 7]);
            pb[s] = __builtin_bit_cast(bf16x8, w0); pb[2 + s] = __builtin_bit_cast(bf16x8, w1);
        }
        const LAS unsigned char* vp = vb + ((lane >> 4) & 1) * 32 + (lane & 3) * 8 + (4 * hi + ((lane & 15) >> 2)) * 64;
#pragma unroll
        for (int ks = 0; ks < 4; ++ks) {
            const s16x4 l0 = vtr(vp + ks * 1024), h0 = vtr(vp + ks * 1024 + 512), l1 = vtr(vp + 4096 + ks * 1024), h1 = vtr(vp + 4096 + ks * 1024 + 512);
            const bf16x8 va = (bf16x8){l0[0], l0[1], l0[2], l0[3], h0[0], h0[1], h0[2], h0[3]}, vb2 = (bf16x8){l1[0], l1[1], l1[2], l1[3], h1[0], h1[1], h1[2], h1[3]};
            o0 = __builtin_amdgcn_mfma_f32_32x32x16_bf16(va, pb[ks], o0, 0, 0, 0);
            o1 = __builtin_amdgcn_mfma_f32_32x32x16_bf16(vb2, pb[ks], o1, 0, 0, 0);
        }
    }
#undef ATT_DMA
    float l_tot = l_run + __shfl_xor(l_run, 32);
    if (A.use_sink) l_tot += fast_exp2(A.sink_l2 - m_run);
    const int qrow = wid * 32 + r32;
    if (A.out_mode == 0) {
        const float inv = 1.0f / l_tot;
        bf16_t* op = A.obf + (size_t)qrow * 1024 + 4 * hi;
#pragma unroll
        for (int g = 0; g < 4; ++g) {
            u32x2 w; w.x = cvt_pk_bf16(o0[4 * g] * inv, o0[4 * g + 1] * inv); w.y = cvt_pk_bf16(o0[4 * g + 2] * inv, o0[4 * g + 3] * inv); *(u32x2*)(op + 8 * g) = w;
            u32x2 w2; w2.x = cvt_pk_bf16(o1[4 * g] * inv, o1[4 * g + 1] * inv); w2.y = cvt_pk_bf16(o1[4 * g + 2] * inv, o1[4 * g + 3] * inv); *(u32x2*)(op + 32 + 8 * g) = w2;
        }
    } else {
        float* op = A.opf + (size_t)qrow * 256 + 4 * hi;
#pragma unroll
        for (int g = 0; g < 4; ++g) {
            *(f32x4*)(op + 8 * g) = (f32x4){o0[4 * g], o0[4 * g + 1], o0[4 * g + 2], o0[4 * g + 3]};
            *(f32x4*)(op + 32 + 8 * g) = (f32x4){o1[4 * g], o1[4 * g + 1], o1[4 * g + 2], o1[4 * g + 3]};
        }
        if (hi == 0) { float* mp = A.mlp + (size_t)qrow * 8; mp[0] = m_run; mp[1] = l_tot; }
        if (A.empty_part) {
            float* op2 = A.opf2 + (size_t)qrow * 256 + 4 * hi;
#pragma unroll
            for (int g = 0; g < 4; ++g) { *(f32x4*)(op2 + 8 * g) = (f32x4){0.f, 0.f, 0.f, 0.f}; *(f32x4*)(op2 + 32 + 8 * g) = (f32x4){0.f, 0.f, 0.f, 0.f}; }
            if (hi == 0) { float* mp = A.mlp2 + (size_t)qrow * 8; mp[0] = -1.0e30f; mp[1] = 0.f; }
        }
    }
    __syncthreads();
}

constexpr int ATT_NUNITS = 1304;
DI void attn_run_unit(Frame& F, int l, int idx) {
    AttnArgs A;
    const bf16_t* P = FP(F); bf16_t* YA = (bf16_t*)(F.ws + WS_YALL);
    float* OP = (float*)(F.ws + WS_OPART); float* ML = (float*)(F.ws + WS_ML);
    A.window = 0; A.qlat0 = 0; A.use_sink = 0; A.sink_l2 = 0.f; A.empty_part = 0; A.opf2 = nullptr; A.mlp2 = nullptr; A.obf = nullptr; A.opf = nullptr; A.mlp = nullptr;
    A.kb0 = 0; A.kb1 = 0;
    if (idx < 1024) {
        const int kind = idx >> 9, i = idx & 511, split = i & 1, qb = (i >> 1) & 31, h = (i >> 6) & 3, b = i >> 8;
        const size_t row0 = (size_t)b * TPB + CTXL + qb * 256, brow = (size_t)b * TPB;
        A.ka0 = split * (TPB / 2); A.ka1 = A.ka0 + TPB / 2;
        A.out_mode = 1; A.opf = OP + ((size_t)(kind * NSPLIT + split) * NROW + row0) * 256 + h * 64; A.mlp = ML + (((size_t)(kind * NSPLIT + split) * NROW + row0) * 4 + h) * 2;
        if (kind == 0) {
            const bf16_t* Qm = (const bf16_t*)(F.ws + WS_QMLA); const bf16_t* Km = (const bf16_t*)(F.ws + WS_KMLA); const bf16_t* Vm = (const bf16_t*)(F.ws + WS_VMLA);
            A.Q = Qm + row0 * 384 + h * 96; A.qpitch = 384; A.K = Km + brow * 384 + h * 96; A.kpitch = 384; A.V = Vm + brow * 256 + h * 64; A.vpitch = 256;
            attn_unit<96>(F, A);
        } else {
            A.Q = P + row0 * LDP + PC_GAQ + h * 64; A.qpitch = LDP; A.K = P + brow * LDP + PC_GAK + (h >> 1) * 64; A.kpitch = LDP; A.V = P + brow * LDP + PC_GAV + (h >> 1) * 64; A.vpitch = LDP;
            attn_unit<64>(F, A);
        }
    } else if (idx < 1280) {
        const int i = idx - 1024, qb = i & 31, h = (i >> 5) & 3, b = i >> 7;
        const size_t row0 = (size_t)b * TPB + CTXL + qb * 256, brow = (size_t)b * TPB;
        const int q0 = qb * 256; int lo = q0 - 128; if (lo < 0) lo = 0; int hi_ = q0 + 256 + 128; if (hi_ > SEQ) hi_ = SEQ;
        A.ka0 = 0; A.ka1 = CTXL; A.kb0 = CTXL + lo; A.kb1 = CTXL + hi_; A.window = 1; A.qlat0 = q0;
        A.use_sink = 1; A.sink_l2 = inp(I_SINK)[l * 4 + h] * LOG2E;
        A.Q = P + row0 * LDP + PC_SWQ + h * 64; A.qpitch = LDP; A.K = P + brow * LDP + PC_SWK + (h >> 1) * 64; A.kpitch = LDP; A.V = P + brow * LDP + PC_SWV + (h >> 1) * 64; A.vpitch = LDP;
        A.out_mode = 0; A.obf = YA + row0 * 1024 + 256 + h * 64;
        attn_unit<64>(F, A);
    } else {
        const int i = idx - 1280, ck = i >> 3, b = (i >> 2) & 1, h = i & 3;
        const size_t row0 = (size_t)b * TPB, brow = row0;
        A.ka0 = 0; A.ka1 = CTXL;
        if (ck == 0) {
            const bf16_t* Qm = (const bf16_t*)(F.ws + WS_QMLA); const bf16_t* Km = (const bf16_t*)(F.ws + WS_KMLA); const bf16_t* Vm = (const bf16_t*)(F.ws + WS_VMLA);
            A.Q = Qm + row0 * 384 + h * 96; A.qpitch = 384; A.K = Km + brow * 384 + h * 96; A.kpitch = 384; A.V = Vm + brow * 256 + h * 64; A.vpitch = 256;
            A.out_mode = 1; A.opf = OP + ((size_t)(0 * NSPLIT + 0) * NROW + row0) * 256 + h * 64; A.mlp = ML + (((size_t)(0 * NSPLIT + 0) * NROW + row0) * 4 + h) * 2;
            A.empty_part = 1; A.opf2 = OP + ((size_t)(0 * NSPLIT + 1) * NROW + row0) * 256 + h * 64; A.mlp2 = ML + (((size_t)(0 * NSPLIT + 1) * NROW + row0) * 4 + h) * 2;
            attn_unit<96>(F, A);
        } else if (ck == 1) {
            A.Q = P + row0 * LDP + PC_GAQ + h * 64; A.qpitch = LDP; A.K = P + brow * LDP + PC_GAK + (h >> 1) * 64; A.kpitch = LDP; A.V = P + brow * LDP + PC_GAV + (h >> 1) * 64; A.vpitch = LDP;
            A.out_mode = 1; A.opf = OP + ((size_t)(1 * NSPLIT + 0) * NROW + row0) * 256 + h * 64; A.mlp = ML + (((size_t)(1 * NSPLIT + 0) * NROW + row0) * 4 + h) * 2;
            A.empty_part = 1; A.opf2 = OP + ((size_t)(1 * NSPLIT + 1) * NROW + row0) * 256 + h * 64; A.mlp2 = ML + (((size_t)(1 * NSPLIT + 1) * NROW + row0) * 4 + h) * 2;
            attn_unit<64>(F, A);
        } else {
            A.use_sink = 1; A.sink_l2 = inp(I_SINK)[l * 4 + h] * LOG2E;
            A.Q = P + row0 * LDP + PC_SWQ + h * 64; A.qpitch = LDP; A.K = P + brow * LDP + PC_SWK + (h >> 1) * 64; A.kpitch = LDP; A.V = P + brow * LDP + PC_SWV + (h >> 1) * 64; A.vpitch = LDP;
            A.out_mode = 0; A.obf = YA + row0 * 1024 + 256 + h * 64;
            attn_unit<64>(F, A);
        }
    }
}

constexpr int SC_CH = 32, SC_STEP = 1536, SC_BUF = SC_CH * SC_STEP;
DI int scan_row(int b, int d, int n) { return b * TPB + (d == 0 ? n : (n < CTXL ? CTXL - 1 - n : TPB + CTXL - 1 - n)); }
#define DPP_ADD(x, ctrl) ((x) + __builtin_bit_cast(float, __builtin_amdgcn_update_dpp(0, __builtin_bit_cast(int, (x)), (ctrl), 0xf, 0xf, false)))
DI float rsum16(float x) { x = DPP_ADD(x, 0x128); x = DPP_ADD(x, 0x124); x = DPP_ADD(x, 0x122); x = DPP_ADD(x, 0x121); return x; }

DI void scan_fill(Frame& F, int b, int d, int h, int chunk, int lt, int nlt) {
    const float* W = (const float*)(F.ws + WS_W); const bf16_t* KD = (const bf16_t*)(F.ws + WS_KD); const bf16_t* BB = (const bf16_t*)(F.ws + WS_BB);
    const bf16_t* KK = (const bf16_t*)(F.ws + WS_KK); const bf16_t* RR = (const bf16_t*)(F.ws + WS_RR); const bf16_t* V = (const bf16_t*)(F.ws + WS_V);
    LAS unsigned char* buf = F.lds + (chunk & 1) * SC_BUF;
    for (int item = lt; item < SC_CH * 96; item += nlt) {
        const int piece = item & 15, vs = item >> 4, vec = vs % 6, s = vs / 6;
        const int row = scan_row(b, d, chunk * SC_CH + s);
        f32x4 val;
        if (vec == 0) val = *(const f32x4*)(W + (size_t)row * 512 + d * 256 + h * 64 + 4 * piece);
        else if (vec == 1) val = ld4bf(KD + (size_t)row * 512 + d * 256 + h * 64 + 4 * piece);
        else if (vec == 2) val = ld4bf(BB + (size_t)row * 512 + d * 256 + h * 64 + 4 * piece);
        else if (vec == 3) val = ld4bf(KK + (size_t)row * 256 + h * 64 + 4 * piece);
        else if (vec == 4) val = ld4bf(RR + (size_t)row * 256 + h * 64 + 4 * piece);
        else val = ld4bf(V + (size_t)row * 256 + h * 64 + 4 * piece);
        *(LAS f32x4*)(buf + s * SC_STEP + vec * 256 + piece * 16) = val;
    }
}
DI void scan_phase(Frame& F, int sw) {
    const int chain = sw >> 2, quarter = sw & 3, b = chain >> 3, d = (chain >> 2) & 1, h = chain & 3;
    const int lane = F.lane, wid = F.wave, g = lane >> 4, kq = lane & 15;
    const int vrow = quarter * 16 + (wid & 3) * 4 + g;
    float* Y = (float*)(F.ws + WS_YDIR) + (size_t)d * NROW * 256;
    constexpr int NCHUNK = TPB / SC_CH;
    f32x4 S = (f32x4){0.f, 0.f, 0.f, 0.f};
    scan_fill(F, b, d, h, 0, F.tid, 512);
    __syncthreads();
    for (int c = 0; c < NCHUNK; ++c) {
        if (wid >= 4) { if (c + 1 < NCHUNK) scan_fill(F, b, d, h, c + 1, F.tid - 256, 256); }
        else {
            const LAS unsigned char* buf = F.lds + (c & 1) * SC_BUF;
#pragma unroll
            for (int half = 0; half < 2; ++half) {
                float ykeep = 0.f;
#pragma unroll
                for (int s16 = 0; s16 < 16; ++s16) {
                    const LAS unsigned char* sp = buf + (half * 16 + s16) * SC_STEP;
                    const f32x4 w4 = *(const LAS f32x4*)(sp + kq * 16), kd4 = *(const LAS f32x4*)(sp + 256 + kq * 16), bb4 = *(const LAS f32x4*)(sp + 512 + kq * 16),
                                kk4 = *(const LAS f32x4*)(sp + 768 + kq * 16), r4 = *(const LAS f32x4*)(sp + 1024 + kq * 16);
                    const float vv = *(const LAS float*)(sp + 1280 + vrow * 4);
                    const f32x4 t = S * kk4;
                    const float sa = -rsum16((t[0] + t[1]) + (t[2] + t[3]));
                    S = S * w4 + sa * bb4 + vv * kd4;
                    const f32x4 u = S * r4;
                    const float y = rsum16((u[0] + u[1]) + (u[2] + u[3]));
                    ykeep = (s16 == kq) ? y : ykeep;
                }
                const int n = c * SC_CH + half * 16 + kq;
                Y[(size_t)scan_row(b, d, n) * 256 + h * 64 + vrow] = ykeep;
            }
        }
        __syncthreads();
    }
}
constexpr int NPH_LAYER = 13, NPHASE = 1 + NPH_LAYER * DEPTH + 1;
struct Args { const float* in[43]; float* out; unsigned char* ws; int ph_lo, ph_hi; };
__global__ void __launch_bounds__(512, 2) hfb_fwd(Args args) {
    extern __shared__ __attribute__((aligned(16))) unsigned char lds_raw[];
    Frame F;
    F.lds = (LAS unsigned char*)lds_raw;
    F.MISC = (volatile LAS unsigned*)(F.lds + MISC_OFF);
    F.tid = threadIdx.x; F.lane = F.tid & 63; F.wave = __builtin_amdgcn_readfirstlane(F.tid >> 6);
    F.G = gridDim.x; { const int bx = blockIdx.x; F.vcu = (F.G % 8 == 0) ? (bx % 8) * (F.G / 8) + bx / 8 : bx; }
    F.ws = args.ws; F.ctl = (unsigned*)(args.ws + WS_CTL); F.out = args.out;
    for (int u = F.tid; u < (LDS_BYTES - MISC_OFF) / 4; u += 512) ((LAS unsigned*)(F.lds + MISC_OFF))[u] = 0u;
    __syncthreads();
    const int lo = args.ph_lo, hi = args.ph_hi;
    XcdBarrier bar; bar.bar = F.ctl + CW_BAR; bar.x = 0; bar.st = nullptr;
    if (hi - lo > 1) bar = xcd_barrier_post(F.ctl + CW_BAR, F.MISC + 8);
#ifndef PH_MASK
#define PH_MASK 0xFFFFF
#endif
#define IN(k) (lo <= (k) && (k) < hi)
#define INL(j) ((((PH_MASK) >> (j)) & 1) && IN(pb + (j)))
#define SEAM(k) do { if (IN(k) && IN((k) + 1)) xcd_barrier_t<false>(bar); } while (0)
    const int bx = blockIdx.x;

    if (((PH_MASK >> 16) & 1) && IN(0)) { Frame Q = relane(F); p0_prologue(Q); }
    if (hi - lo > 1) xcd_barrier_t<true>(bar);

    for (int l = 0; l < DEPTH; ++l) {
        const int pb = 1 + NPH_LAYER * l;
        if (INL(0)) { Frame Q = relane(F); convert_layer_weights(Q, l); norm_phase<0>(Q, l); } SEAM(pb + 0);
        if (INL(1)) {
            Frame Q = relane(F); unsigned char* wl = Q.ws + WS_WL;
            pg8::Gemm g{(const char*)FHB(Q), (const char*)(wl + WL_WIN), 1024, 1024, 1024};
            SchedGrid S; S.T.init(NPANEL, NP_GEMM / 256, Q.G, bx); S.lda = 1024; S.ldb = 1024; S.acol = 0;
            EpiWin E{FP(Q)};
            pg8::gemm_phase(Q.lds, g, S, E, Q.wave);
        } SEAM(pb + 1);
        if (INL(2)) { Frame Q = relane(F); prep_phase(Q, l); } SEAM(pb + 2);
        if (INL(3)) {
            Frame Q = relane(F); unsigned char* wl = Q.ws + WS_WL;
            pg8::Gemm g{(const char*)FP(Q), (const char*)(wl + WL_L1), LDP, 256, 256};
            SchedL3B S{Q.G, bx};
            EpiL3B E{(bf16_t*)(Q.ws + WS_T), (bf16_t*)(Q.ws + WS_QMLA), (bf16_t*)(Q.ws + WS_KMLA), (bf16_t*)(Q.ws + WS_VMLA), (const float*)(Q.ws + WS_ROPE32)};
            pg8::gemm_phase(Q.lds, g, S, E, Q.wave);
        } SEAM(pb + 3);
        if (INL(4)) {
            Frame Q = relane(F); unsigned char* wl = Q.ws + WS_WL;
            pg8::Gemm g{(const char*)(Q.ws + WS_T), (const char*)(wl + WL_L2), 1536, 256, 256};
            SchedL3C S{Q.G, bx, l};
            EpiL3C E{l, inp(I_W0) + l * 512, inp(I_A0) + l * 512, inp(I_V0) + (l > 0 ? l - 1 : 0) * 256, inp(I_KA) + l * 256,
                     (float*)(Q.ws + WS_W), (bf16_t*)(Q.ws + WS_KD), (bf16_t*)(Q.ws + WS_BB), (const bf16_t*)(Q.ws + WS_KR), (const bf16_t*)(Q.ws + WS_KK),
                     (bf16_t*)(Q.ws + WS_V), (const bf16_t*)(Q.ws + WS_VF), (bf16_t*)(Q.ws + WS_G)};
            pg8::gemm_phase(Q.lds, g, S, E, Q.wave);
        } SEAM(pb + 4);
        if (INL(5)) {
            Frame Q = relane(F); unsigned char* wl = Q.ws + WS_WL;

            if (bx < 64) scan_phase(Q, bx);
            for (;;) {
                if (Q.tid == 0) Q.MISC[16] = __hip_atomic_fetch_add(Q.ctl + CW_ATTQ + l * 64, 1u, __ATOMIC_RELAXED, __HIP_MEMORY_SCOPE_AGENT);
                __syncthreads();
                const int idx = (int)Q.MISC[16];
                __syncthreads();
                if (idx >= ATT_NUNITS) break;
                attn_run_unit(Q, l, idx);
            }
        } SEAM(pb + 5);
        if (INL(6)) { Frame Q = relane(F); finish_phase(Q, l); } SEAM(pb + 6);
        if (INL(7)) {
            Frame Q = relane(F); unsigned char* wl = Q.ws + WS_WL;
            pg8::Gemm g{(const char*)(Q.ws + WS_YALL), (const char*)(wl + WL_WBR), 1024, 256, 256};
            SchedMerge S{Q.G, bx};
            EpiMerge E{FP(Q), FHB(Q)};
            pg8::gemm_phase(Q.lds, g, S, E, Q.wave);
        } SEAM(pb + 7);
        if (INL(8)) {
            Frame Q = relane(F); unsigned char* wl = Q.ws + WS_WL;
            pg8::Gemm g{(const char*)FHB(Q), (const char*)(wl + WL_WOUT), 1024, 1024, 1024};
            SchedGrid S; S.T.init(NPANEL, 4, Q.G, bx); S.lda = 1024; S.ldb = 1024; S.acol = 0;
            EpiResid E{FX(Q), FMOD(Q) + (size_t)l * 3 * 6144, 2};
            pg8::gemm_phase(Q.lds, g, S, E, Q.wave);
        } SEAM(pb + 8);
        if (INL(9)) { Frame Q = relane(F); norm_phase<1>(Q, l); } SEAM(pb + 9);
#ifndef DIAG_DENSE_ONLY
#define DIAG_DENSE_ONLY 0
#endif
#ifndef DIAG_MOE_ONLY
#define DIAG_MOE_ONLY 0
#endif
        if (!DIAG_DENSE_ONLY && ((l & 1) || DIAG_MOE_ONLY)) {
            if (INL(10)) { Frame Q = relane(F); moe_gather(Q, l); } SEAM(pb + 10);
            if (INL(11)) {
                Frame Q = relane(F); unsigned char* wl = Q.ws + WS_WL;
                pg8::Gemm g{(const char*)(Q.ws + WS_XG), (const char*)(wl + WL_W13), 1024, 1024, 1024};
                SchedMoe S; S.G = Q.G; S.c = bx; S.ncol = 28; S.lda = 1024; S.ldb = 1024; S.nrowB = 7168; moe_panels(Q, l, S.cp);
                EpiSwiGlu E{(bf16_t*)(Q.ws + WS_UG), 1};
                pg8::gemm_phase(Q.lds, g, S, E, Q.wave);
            } SEAM(pb + 11);
            if (INL(12)) {
                Frame Q = relane(F); unsigned char* wl = Q.ws + WS_WL;
                pg8::Gemm g{(const char*)(Q.ws + WS_UG), (const char*)(wl + WL_W2), DFF, DFF, DFF};
                SchedMoe S; S.G = Q.G; S.c = bx; S.ncol = 4; S.lda = DFF; S.ldb = DFF; S.nrowB = 1024; moe_panels(Q, l, S.cp);
                EpiMoeDown E{(bf16_t*)(Q.ws + WS_YG), (const float*)(Q.ws + WS_ROWGATE)};
                pg8::gemm_phase(Q.lds, g, S, E, Q.wave);
            } SEAM(pb + 12);
        } else {
            SEAM(pb + 10);
            if (INL(11)) {
                Frame Q = relane(F); unsigned char* wl = Q.ws + WS_WL;
                pg8::Gemm g{(const char*)FHB(Q), (const char*)(wl + WL_W13), 1024, 1024, 1024};
                SchedGrid S; S.T.init(NPANEL, 28, Q.G, bx); S.lda = 1024; S.ldb = 1024; S.acol = 0;
                EpiSwiGlu E{(bf16_t*)(Q.ws + WS_U), 0};
                pg8::gemm_phase(Q.lds, g, S, E, Q.wave);
            } SEAM(pb + 11);
            if (INL(12)) {
                Frame Q = relane(F); unsigned char* wl = Q.ws + WS_WL;
                pg8::Gemm g{(const char*)(Q.ws + WS_U), (const char*)(wl + WL_W2), DFF, DFF, DFF};
                SchedGrid S; S.T.init(NPANEL, 4, Q.G, bx); S.lda = DFF; S.ldb = DFF; S.acol = 0;
                EpiResid E{FX(Q), FMOD(Q) + (size_t)l * 3 * 6144, 5};
                pg8::gemm_phase(Q.lds, g, S, E, Q.wave);
            } SEAM(pb + 12);
        }
    }
    if (((PH_MASK >> 17) & 1) && IN(NPHASE - 1)) { Frame Q = relane(F); norm_phase<2>(Q, DEPTH - 1); }
#undef IN
#undef SEAM
}

extern "C" void kernel_launch(void* const* d_in, const int* in_sizes, int n_in, void* d_out, int out_size, void* d_ws, size_t ws_size, hipStream_t stream) {
    static int grid = 0;
    if (grid == 0) {
        if (n_in != 43 || out_size != NB * SEQ * DM || ws_size < WS_END) { fprintf(stderr, "kernel_launch: unexpected problem (n_in %d, out %d, ws %zu < %zu)\n", n_in, out_size, ws_size, (size_t)WS_END); grid = -1; return; }
        int dev = 0, cus = 0, per_cu = 0;
        if (hipGetDevice(&dev) != hipSuccess || hipDeviceGetAttribute(&cus, hipDeviceAttributeMultiprocessorCount, dev) != hipSuccess) { grid = -1; return; }
        if (hipFuncSetAttribute((const void*)hfb_fwd, hipFuncAttributeMaxDynamicSharedMemorySize, LDS_BYTES) != hipSuccess) { fprintf(stderr, "kernel_launch: hipFuncSetAttribute failed\n"); grid = -1; return; }
        if (hipOccupancyMaxActiveBlocksPerMultiprocessor(&per_cu, (const void*)hfb_fwd, 512, LDS_BYTES) != hipSuccess || per_cu < 1) { fprintf(stderr, "kernel_launch: occupancy query says %d\n", per_cu); }
        (void)hipGetLastError();
        grid = cus < 256 ? cus : 256;
        if (grid < 64) { grid = -1; return; }
    }
    if (grid < 0) return;
    (void)in_sizes;
    hipMemsetAsync((char*)d_ws + WS_CTL, 0, CTL_BYTES, stream);
    Args a{};
    for (int i = 0; i < 43; ++i) a.in[i] = (const float*)d_in[i];
    a.out = (float*)d_out; a.ws = (unsigned char*)d_ws;
#if MK_N_LAUNCHES == 1
    a.ph_lo = 0; a.ph_hi = NPHASE;
    hipLaunchKernelGGL(hfb_fwd, dim3(grid), dim3(512), LDS_BYTES, stream, a);
#else
    for (int p = 0; p < NPHASE; ++p) {
        const int l = (p - 1) / NPH_LAYER, k = (p - 1) % NPH_LAYER;
        if (p >= 1 && p < NPHASE - 1 && k == 10 && !(l & 1)) continue;
        a.ph_lo = p; a.ph_hi = p + 1;
        hipLaunchKernelGGL(hfb_fwd, dim3(grid), dim3(512), LDS_BYTES, stream, a);
    }
#endif
}
```

```cpp
#include <hip/hip_runtime.h>
#include <cstdio>
#include <cstdint>

#ifndef MK_N_LAUNCHES
#define MK_N_LAUNCHES 1
#endif

#define GAS __attribute__((address_space(1)))
#define LAS __attribute__((address_space(3)))
#define DI __device__ __forceinline__
typedef unsigned short bf16_t;
typedef short bf16x8 __attribute__((ext_vector_type(8)));
typedef short s16x4 __attribute__((ext_vector_type(4)));
typedef float f32x2 __attribute__((ext_vector_type(2)));
typedef float f32x4 __attribute__((ext_vector_type(4)));
typedef float f32x16 __attribute__((ext_vector_type(16)));
typedef unsigned u32x2 __attribute__((ext_vector_type(2)));
typedef unsigned u32x4 __attribute__((ext_vector_type(4)));

constexpr int DM = 1024, NB = 2, SEQ = 8192, DEPTH = 4, CTXL = 256, GRIDW = 64;
constexpr int TPB = CTXL + SEQ;
constexpr int NROW = NB * TPB;
constexpr int NPANEL = NROW / 256;
constexpr int DFF = 3584, NEXP = 8;
constexpr int IN_W = 6560;
constexpr int PC_F = 0, PC_SWQ = 1024, PC_SWK = 1280, PC_SWV = 1408, PC_CQ = 1536, PC_CKV = 1792, PC_KR = 1920,
              PC_GAQ = 2048, PC_GAK = 2304, PC_GAV = 2432, PC_GATE = 2560, PC_Z = 6656, NP_GEMM = 6656, LDP = 6912;
constexpr float LOG2E = 1.4426950408889634f;
constexpr float QS64 = 0.125f * LOG2E;
constexpr float QS96 = 0.10206207261596577f * LOG2E;
constexpr int NSPLIT = 2;
constexpr int MOE_MAXROWS = 35840;

constexpr size_t MiB = 1u << 20;
constexpr size_t WS_CTL = 0, CTL_BYTES = 1 * MiB;
constexpr size_t WS_MOD = 1 * MiB;
constexpr size_t WS_ROPE64 = 2 * MiB;
constexpr size_t WS_ROPE32 = 4 * MiB;
constexpr size_t WS_ASG = 5 * MiB;
constexpr size_t WS_ASG_GATE = 5 * MiB + 512 * 1024;
constexpr size_t WS_ASG_DST = 6 * MiB;
constexpr size_t WS_ROWGATE = 6 * MiB + 512 * 1024;
constexpr size_t WS_WL = 8 * MiB;
constexpr size_t WL_WIN = 0;
constexpr size_t WL_WBR = WL_WIN + (size_t)NP_GEMM * 1024 * 2;
constexpr size_t WL_WOUT = WL_WBR + (size_t)4 * 1024 * 256 * 2;
constexpr size_t WL_L1 = WL_WOUT + (size_t)1024 * 1024 * 2;
constexpr size_t WL_L2 = WL_L1 + (size_t)1536 * 256 * 2;
constexpr size_t WL_UQ = WL_L2 + (size_t)1536 * 256 * 2;
constexpr size_t WL_UKV = WL_UQ + (size_t)512 * 256 * 2;
constexpr size_t WL_W13 = WL_UKV + (size_t)512 * 256 * 2;
constexpr size_t WL_W2 = WL_W13 + (size_t)NEXP * 7168 * 1024 * 2;
constexpr size_t WL_END = WL_W2 + (size_t)NEXP * 1024 * 3584 * 2;
static_assert(WL_END <= 200 * MiB, "weights region");
constexpr size_t WS_X = 208 * MiB;
constexpr size_t WS_HB = 274 * MiB;
constexpr size_t WS_VF = 307 * MiB;
constexpr size_t WS_REG = 316 * MiB;
constexpr size_t WS_P = WS_REG;
constexpr size_t WS_RR = WS_REG + 223 * MiB;
constexpr size_t WS_KK = WS_RR + 9 * MiB;
constexpr size_t WS_KR = WS_KK + 9 * MiB;
constexpr size_t WS_V = WS_KR + 9 * MiB;
constexpr size_t WS_KD = WS_V + 9 * MiB;
constexpr size_t WS_BB = WS_KD + 17 * MiB;
constexpr size_t WS_W = WS_BB + 17 * MiB;
constexpr size_t WS_G = WS_W + 33 * MiB;
constexpr size_t WS_T = WS_G + 9 * MiB;
constexpr size_t WS_OPART = WS_T;
constexpr size_t WS_ML = WS_OPART + 66 * MiB;
constexpr size_t WS_YDIR = WS_ML + 3 * MiB;
constexpr size_t WS_QMLA = WS_YDIR + 33 * MiB;
constexpr size_t WS_KMLA = WS_QMLA + 13 * MiB;
constexpr size_t WS_VMLA = WS_KMLA + 13 * MiB;
constexpr size_t WS_YALL = WS_VMLA + 9 * MiB;
constexpr size_t WS_MIX_END = WS_YALL + 33 * MiB;
constexpr size_t WS_U = WS_REG;
constexpr size_t WS_XG = WS_REG;
constexpr size_t WS_UG = WS_REG + 70 * MiB;
constexpr size_t WS_YG = WS_UG + 245 * MiB;
constexpr size_t WS_FFN_END = WS_YG + 70 * MiB;
constexpr size_t WS_SLAB = WS_REG + 440 * MiB;
static_assert(WS_SLAB >= WS_FFN_END && WS_SLAB + 16 * MiB <= WS_MIX_END, "slabs");
constexpr size_t WS_WLB = 824 * MiB;
constexpr size_t WL_W2D = WL_W13 + (size_t)7168 * 1024 * 2;
static_assert(WS_WLB >= WS_MIX_END && WS_WLB >= WS_FFN_END && WL_W2D + (size_t)1024 * 3584 * 2 <= 44 * MiB, "dense weight buffer");
constexpr size_t WS_END = WS_WLB + 44 * MiB;
static_assert(WS_KR + (size_t)NROW * 256 * 2 <= WS_V && WS_T + (size_t)NROW * 1536 * 2 <= WS_ML && WS_OPART + (size_t)2 * NSPLIT * NROW * 256 * 4 <= WS_ML, "map");
static_assert((size_t)2 * NSPLIT * NROW * 8 * 4 <= 3 * MiB && (size_t)NROW * 384 * 2 <= 13 * MiB && (size_t)NROW * LDP * 2 <= 223 * MiB, "map");
static_assert((size_t)MOE_MAXROWS * 1024 * 2 <= 70 * MiB && (size_t)MOE_MAXROWS * 3584 * 2 <= 245 * MiB, "map");

constexpr int CW_BAR = 4096;
constexpr int CW_MOECNT = 16384;
constexpr int CW_ATTQ = 20480;
constexpr int CW_CONVQ = 24576;
constexpr int CW_SYNC = 28672;
constexpr int CW_SLABCNT = 30720;
constexpr int CW_WGBASE = 32768;

constexpr int RING_BYTES = 131072;
constexpr int MISC_OFF = RING_BYTES;
constexpr int LDS_BYTES = 147456;

#define LDS_WAIT() asm volatile("s_waitcnt lgkmcnt(0)" ::: "memory")
#define VM_WAIT() asm volatile("s_waitcnt vmcnt(0)" ::: "memory")
DI unsigned f2bf(float f) { unsigned u = __builtin_bit_cast(unsigned, f); return (u + 0x7fffu + ((u >> 16) & 1u)) >> 16; }
DI unsigned pk2(float lo, float hi) { return f2bf(lo) | (f2bf(hi) << 16); }
DI float bflo(unsigned w) { return __builtin_bit_cast(float, w << 16); }
DI float bfhi(unsigned w) { return __builtin_bit_cast(float, w & 0xffff0000u); }
DI float bf2f(bf16_t b) { return __builtin_bit_cast(float, ((unsigned)b) << 16); }
typedef __bf16 bf16x2_t __attribute__((ext_vector_type(2)));
DI unsigned cvt_pk_bf16(float lo, float hi) { const f32x2 v = (f32x2){lo, hi}; const bf16x2_t b = __builtin_convertvector(v, bf16x2_t); return __builtin_bit_cast(unsigned, b); }
DI float fast_exp2(float x) { return __builtin_amdgcn_exp2f(x); }
DI float fast_rcp(float x) { return __builtin_amdgcn_rcpf(x); }
DI float sigmoidf_(float x) { return fast_rcp(1.0f + fast_exp2(-x * LOG2E)); }
DI float siluf_(float x) { return x * sigmoidf_(x); }
DI float tanhf_(float x) { const float e = fast_exp2(-2.0f * LOG2E * __builtin_fabsf(x)); const float t = (1.0f - e) * fast_rcp(1.0f + e); return x < 0.f ? -t : t; }
#define DPP_ADD(x, ctrl) ((x) + __builtin_bit_cast(float, __builtin_amdgcn_update_dpp(0, __builtin_bit_cast(int, (x)), (ctrl), 0xf, 0xf, false)))
DI float rsum16(float x) { x = DPP_ADD(x, 0x128); x = DPP_ADD(x, 0x124); x = DPP_ADD(x, 0x122); x = DPP_ADD(x, 0x121); return x; }
DI float sum16(float v) { return rsum16(v); }
DI float wave_sum(float v) {
    v = rsum16(v);
    { auto rr = __builtin_amdgcn_permlane16_swap(__float_as_uint(v), __float_as_uint(v), false, false); v = __uint_as_float(rr[0]) + __uint_as_float(rr[1]); }
    { auto rr = __builtin_amdgcn_permlane32_swap(__float_as_uint(v), __float_as_uint(v), false, false); v = __uint_as_float(rr[0]) + __uint_as_float(rr[1]); }
    return v;
}
DI int row_vec(int row) { return (row % TPB) < CTXL ? 2 : row / TPB; }
#define MIX_MERGE 1
#define XB_TMO      128
#define XB_XCNT(j)  (256  + 64 * (j))
#define XB_XSUB(j)  (1280 + 64 * (j))
#define XB_XGEN(j)  (2304 + 64 * (j))
#define XB_TOP      3328
#define XB_TOPGEN   3392
#define XCD_BAR_WORDS 3456
#define XB_SPIN_CAP (1u << 25)
DI unsigned xb_ld(unsigned* p)              { return __hip_atomic_load(p, __ATOMIC_RELAXED, __HIP_MEMORY_SCOPE_AGENT); }
DI unsigned xb_add(unsigned* p, unsigned v) { return __hip_atomic_fetch_add(p, v, __ATOMIC_RELAXED, __HIP_MEMORY_SCOPE_AGENT); }
DI unsigned xb_xcc_id() { return (unsigned)__builtin_amdgcn_s_getreg((3 << 11) | 20) & 0xFu; }
#define XB_SPIN(cond, bar) do { unsigned _sp = 0; while (cond) { __builtin_amdgcn_s_sleep(1); \
    if ((++_sp & 255u) == 0u) { if (xb_ld(&(bar)[XB_TMO])) break; if (_sp > XB_SPIN_CAP) { atomicAdd(&(bar)[XB_TMO], 1u); break; } } } } while (0)
struct XcdBarrier { unsigned* bar; unsigned x; volatile LAS unsigned* st; };
DI XcdBarrier xcd_barrier_post(unsigned* bar, volatile LAS unsigned* st) {
    XcdBarrier b; b.bar = bar; b.x = xb_xcc_id(); b.st = st;
    if (threadIdx.x == 0) (void)xb_add(&bar[XB_XCNT(b.x)], 1u);
    return b;
}
DI void xcd_barrier_complete(unsigned* bar, unsigned x, unsigned& nloc, unsigned& nx) {
    const unsigned G = gridDim.x * gridDim.y * gridDim.z;
    unsigned sum, cnt, mine, sp = 0u;
    for (;;) {
        sum = 0u; cnt = 0u; mine = 0u;
#pragma unroll
        for (unsigned j = 0; j < 16; ++j) { const unsigned c = xb_ld(&bar[XB_XCNT(j)]); sum += c; cnt += (c > 0u) ? 1u : 0u; mine = (j == x) ? c : mine; }
        if (sum == G) break;
        __builtin_amdgcn_s_sleep(1);
        if ((++sp & 255u) == 0u) { if (xb_ld(&bar[XB_TMO])) break; if (sp > XB_SPIN_CAP) { atomicAdd(&bar[XB_TMO], 1u); break; } }
    }
    nloc = mine > 0u ? mine : 1u; nx = cnt > 0u ? cnt : 1u;
}
template <bool FIRST>
DI void xcd_barrier_t(const XcdBarrier& b) {
    asm volatile("s_waitcnt vmcnt(0)" ::: "memory");
    __syncthreads();
    if (threadIdx.x == 0) {
        unsigned* bar = b.bar; asm volatile("" : "+s"(bar));
        __builtin_amdgcn_s_waitcnt(0);
        unsigned nloc = b.st[0], nx = b.st[1];
        if (FIRST) { if (nloc == 0u) { xcd_barrier_complete(bar, b.x, nloc, nx); b.st[0] = nloc; b.st[1] = nx; } }
        else if (nloc == 0u) { atomicAdd(&bar[XB_TMO], 1u); nloc = 1u; nx = 1u; }
        const unsigned old = xb_add(&bar[XB_XSUB(b.x)], 1u);
        const unsigned gen = old / nloc;
        if (old + 1u == (gen + 1u) * nloc) {
            __builtin_amdgcn_fence(__ATOMIC_RELEASE, "agent");
            asm volatile("s_waitcnt vmcnt(0)" ::: "memory");
            const unsigned og = xb_add(&bar[XB_TOP], 1u);
            const unsigned tg = og / nx;
            if (og + 1u == (tg + 1u) * nx) xb_add(&bar[XB_TOPGEN], 1u);
            else XB_SPIN(xb_ld(&bar[XB_TOPGEN]) == tg, bar);
            __builtin_amdgcn_fence(__ATOMIC_ACQUIRE, "agent");
            xb_add(&bar[XB_XGEN(b.x)], 1u);
            asm volatile("s_waitcnt vmcnt(0)" ::: "memory");
        } else {
            XB_SPIN(xb_ld(&bar[XB_XGEN(b.x)]) == gen, bar);
            __builtin_amdgcn_fence(__ATOMIC_ACQUIRE, "agent");
            asm volatile("s_waitcnt vmcnt(0)" ::: "memory");
        }
    }
    __syncthreads();
}

namespace pg8 {
constexpr int BM = 256, BK = 64, HALF = 128, HTB = HALF * BK * 2, STAGE_BYTES = 8 * HTB, NXCD = 8, WGM = 8;
__host__ __device__ __forceinline__ int lds_byte(int r, int c) { const int st = (r >> 4) * 2 + (c >> 5), rr = r & 15, cc = c & 31, ob = rr * 64 + cc * 2; return st * 1024 + (ob ^ (((ob >> 9) & 1) << 5)); }
__host__ __device__ __forceinline__ void stage_rc(int b, int& R, int& C) { const int st = b / 1024, sb = b % 1024, swz = sb ^ (((sb >> 9) & 1) << 5); R = (st >> 1) * 16 + swz / 64; C = (st & 1) * 32 + (swz % 64) / 2; }
__host__ __device__ __forceinline__ int perm32(int rho) { const int n = rho >> 4, i = rho & 15; return 8 * (i >> 2) + 4 * n + (i & 3); }

struct Unit { int pm, pn, aux; size_t aoff, boff; };
struct Gemm { const char* A; const char* Bt; int lda, ldb, K; };

struct TileOrder {
    int nM, nN, nwg, G, c;
    DI void init(int nM_, int nN_, int G_, int c_) { nM = nM_; nN = nN_; nwg = nM * nN; G = G_; c = c_; }
    DI bool tile(int i, int& pm, int& pn) const {
        const long L = (long)i * G + c; if (L >= nwg) return false;
        int wgid = (int)L; { const int q = nwg / NXCD, r = nwg % NXCD, xcd = wgid % NXCD, off = wgid / NXCD; wgid = (xcd < r ? xcd * (q + 1) : r * (q + 1) + (xcd - r) * q) + off; }
        const int nig = WGM * nN, gid = wgid / nig, fm = gid * WGM, gsz = (nM - fm) < WGM ? (nM - fm) : WGM;
        pm = fm + ((wgid % nig) % gsz); pn = (wgid % nig) / gsz; return true;
    }
};

template <class Epi, class Sched>
DI void gemm_phase(LAS unsigned char* lds, const Gemm g, const Sched& S, const Epi& E, const int wave_id, const int skew = 0) {
    int lane = (int)__builtin_amdgcn_mbcnt_hi(~0u, __builtin_amdgcn_mbcnt_lo(~0u, 0u)); asm volatile("" : "+v"(lane));
    const int wid = wave_id, tid = wid * 64 + lane, wr = wid >> 2, wc = wid & 3, fr = lane & 15, fq = lane >> 4;
    const int K = g.K, nt = K / BK;
    unsigned voffA[2], voffB[2];
#pragma unroll
    for (int i = 0; i < 2; ++i) { int R, C; stage_rc(tid * 16 + i * 8192, R, C); const int Rb = (R & ~31) + perm32(R & 31);
        voffA[i] = (unsigned)(R * g.lda + C) * 2u; voffB[i] = (unsigned)(Rb * g.ldb + C) * 2u; }
    const size_t kstep = (size_t)(BK * 2);
    const size_t hstepA = (size_t)HALF * g.lda * 2, hstepB = (size_t)HALF * g.ldb * 2;
    const unsigned ldsw = (unsigned)wid * 1024u;
    const int aoff = lds_byte(wr * 64 + fr, fq * 8), boff = lds_byte(wc * 32 + fr, fq * 8);
#define PG8_SA(b, h) (((b) * 2 + (h)) * HTB)
#define PG8_SB(b, h) ((4 + (b) * 2 + (h)) * HTB)
#define PG8_STAGE(bufoff, gbase, voff) do { _Pragma("unroll") for (int _i = 0; _i < 2; ++_i) \
        __builtin_amdgcn_global_load_lds((const unsigned*)((const char*)(gbase) + (voff)[_i]), (LAS unsigned*)(lds + (bufoff) + ldsw + _i * 8192), 16, 0, 0); } while (0)
#define PG8_LDA(dst, b, h) do { _Pragma("unroll") for (int m = 0; m < 4; ++m) _Pragma("unroll") for (int k = 0; k < 2; ++k) dst[m][k] = *(const LAS bf16x8*)(lds + PG8_SA(b, h) + aoff + m * 2048 + k * 1024); } while (0)
#define PG8_LDB(dst, b, h) do { _Pragma("unroll") for (int n = 0; n < 2; ++n) _Pragma("unroll") for (int k = 0; k < 2; ++k) dst[n][k] = *(const LAS bf16x8*)(lds + PG8_SB(b, h) + boff + n * 2048 + k * 1024); } while (0)
#define PG8_MMA(ai, bj, At, Bt) do { __builtin_amdgcn_s_setprio(1); _Pragma("unroll") for (int m = 0; m < 4; ++m) _Pragma("unroll") for (int n = 0; n < 2; ++n) _Pragma("unroll") for (int k = 0; k < 2; ++k) \
        acc[ai][bj][m][n] = __builtin_amdgcn_mfma_f32_16x16x32_bf16(Bt[n][k], At[m][k], acc[ai][bj][m][n], 0, 0, 0); __builtin_amdgcn_s_setprio(0); } while (0)
#define PG8_WAIT_V(n) asm volatile("s_waitcnt vmcnt(" #n ")" ::: "memory")
#define PG8_WAIT_L(n) asm volatile("s_waitcnt lgkmcnt(" #n ")" ::: "memory")
#define PG8_BAR __builtin_amdgcn_s_barrier()
#define PG8_SCHED __builtin_amdgcn_sched_barrier(0)
    Unit cur, nxt; int ui = 0;
    if (!S.next(0, cur)) return;
    for (int sk = (int)((blockIdx.x >> 3) & 7u) * skew; sk > 0; sk -= 100) __builtin_amdgcn_s_sleep(100);
    f32x4 acc[2][2][4][2];
#pragma unroll
    for (int a = 0; a < 2; ++a)
#pragma unroll
        for (int b = 0; b < 2; ++b)
#pragma unroll
            for (int m = 0; m < 4; ++m)
#pragma unroll
                for (int n = 0; n < 2; ++n) acc[a][b][m][n] = (f32x4){0.f, 0.f, 0.f, 0.f};
    bf16x8 At[4][2], B0[2][2], B1[2][2];
    const char* cA = g.A + cur.aoff; const char* cB = g.Bt + cur.boff;
    {
        PG8_STAGE(PG8_SB(0, 0), cB, voffB); PG8_STAGE(PG8_SB(0, 1), cB + hstepB, voffB); PG8_STAGE(PG8_SA(0, 0), cA, voffA); PG8_STAGE(PG8_SA(0, 1), cA + hstepA, voffA);
        if (wr == 1) PG8_BAR;
        PG8_WAIT_V(2); PG8_BAR;
        PG8_STAGE(PG8_SB(1, 0), cB + kstep, voffB); PG8_STAGE(PG8_SA(1, 0), cA + kstep, voffA); PG8_STAGE(PG8_SB(1, 1), cB + hstepB + kstep, voffB);
        PG8_WAIT_V(6); PG8_BAR;
    }
    for (;;) {
        const bool has_next = S.next(ui + 1, nxt);
        const char* nA = has_next ? g.A + nxt.aoff : cA; const char* nB = has_next ? g.Bt + nxt.boff : cB;
#pragma nounroll
        for (int t = 0; t < nt; t += 2) {
            const bool last = (t == nt - 2);
            const char* a1 = cA + (size_t)(t + 1) * kstep;
            const char* a2 = last ? nA : cA + (size_t)(t + 2) * kstep; const char* b2 = last ? nB : cB + (size_t)(t + 2) * kstep;
            const char* a3 = a2 + kstep; const char* b3 = b2 + kstep;
            PG8_LDB(B0, 0, 0); PG8_LDB(B1, 0, 1); PG8_SCHED; PG8_LDA(At, 0, 0); PG8_STAGE(PG8_SA(1, 1), a1 + hstepA, voffA);
            PG8_WAIT_V(8); PG8_WAIT_L(0); PG8_BAR; PG8_MMA(0, 0, At, B0); PG8_MMA(0, 1, At, B1); PG8_BAR; PG8_SCHED;
            PG8_LDA(At, 0, 1); PG8_STAGE(PG8_SB(0, 0), b2, voffB); PG8_STAGE(PG8_SB(0, 1), b2 + hstepB, voffB); PG8_STAGE(PG8_SA(0, 0), a2, voffA);
            PG8_WAIT_V(8); PG8_WAIT_L(0); PG8_BAR; PG8_MMA(1, 0, At, B0); PG8_MMA(1, 1, At, B1); PG8_BAR; PG8_SCHED;
            PG8_LDB(B0, 1, 0); PG8_LDB(B1, 1, 1); PG8_SCHED; PG8_LDA(At, 1, 0); PG8_STAGE(PG8_SA(0, 1), a2 + hstepA, voffA);
            PG8_WAIT_V(8); PG8_WAIT_L(0); PG8_BAR; PG8_MMA(0, 0, At, B0); PG8_MMA(0, 1, At, B1); PG8_BAR; PG8_SCHED;
            PG8_LDA(At, 1, 1); PG8_STAGE(PG8_SB(1, 0), b3, voffB); PG8_STAGE(PG8_SB(1, 1), b3 + hstepB, voffB); PG8_STAGE(PG8_SA(1, 0), a3, voffA);
            PG8_WAIT_V(8); PG8_WAIT_L(0); PG8_BAR; PG8_MMA(1, 0, At, B0); PG8_MMA(1, 1, At, B1); PG8_BAR; PG8_SCHED;
        }
        if (wr == 0) PG8_BAR;
        E(acc, cur, wr, wc, fr, fq);
        if (!has_next) break;
#pragma unroll
        for (int a = 0; a < 2; ++a)
#pragma unroll
            for (int b = 0; b < 2; ++b)
#pragma unroll
                for (int m = 0; m < 4; ++m)
#pragma unroll
                    for (int n = 0; n < 2; ++n) acc[a][b][m][n] = (f32x4){0.f, 0.f, 0.f, 0.f};
        cur = nxt; cA = nA; cB = nB; ++ui;
        if (wr == 1) PG8_BAR;
    }
    PG8_WAIT_V(0);
    PG8_BAR;
#undef PG8_SA
#undef PG8_SB
#undef PG8_STAGE
#undef PG8_LDA
#undef PG8_LDB
#undef PG8_MMA
#undef PG8_WAIT_V
#undef PG8_WAIT_L
#undef PG8_BAR
#undef PG8_SCHED
}
}
struct Frame {
    LAS unsigned char* lds;
    volatile LAS unsigned* MISC;
    unsigned* ctl;
    unsigned char* ws;
    int tid, lane, wave, vcu, G, bx;
    float* out;
};
DI Frame relane(const Frame& F) { Frame Q = F; int ln; unsigned char* w = F.ws; int wv = F.wave;
    asm volatile("v_mbcnt_lo_u32_b32 %0, -1, 0\n\tv_mbcnt_hi_u32_b32 %0, -1, %0" : "=v"(ln));
    asm volatile("" : "+s"(w), "+s"(wv)); Q.ws = w; Q.ctl = (unsigned*)w; Q.lane = ln; Q.wave = wv; Q.tid = wv * 64 + ln; return Q; }
typedef const float* cfp_t;
DI cfp_t inp(int i) { unsigned long long kp = (unsigned long long)__builtin_amdgcn_kernarg_segment_ptr(); asm volatile("" : "+s"(kp)); return ((const __attribute__((address_space(4))) cfp_t*)kp)[i]; }
#define FX(F) ((float*)((F).ws + WS_X))
#define FHB(F) ((bf16_t*)((F).ws + WS_HB))
#define FP(F) ((bf16_t*)((F).ws + WS_P))
#define FMOD(F) ((float*)((F).ws + WS_MOD))
enum { I_X = 0, I_C, I_CTX, I_CCTX, I_WMOD, I_BMOD, I_NORM1, I_NORM2, I_WIN, I_WBR, I_WOUT, I_MU, I_W0, I_W1, I_W2, I_A0, I_A1, I_A2, I_V0, I_V1, I_V2,
       I_G1, I_G2, I_KK, I_KA, I_RK, I_LNW, I_LNB, I_SINK, I_MQN, I_WUQ, I_MKVN, I_WUKV, I_GQN, I_GKN, I_FW1, I_FW3, I_FW2, I_ROUTER, I_MW1, I_MW3, I_MW2, I_FNORM };

DI const float* modp(const Frame& F, int l, int vec, int which) { return FMOD(F) + ((size_t)(l * 3 + vec) * 6 + which) * 1024; }

using pg8::Unit;
struct SchedGrid {
    pg8::TileOrder T; int lda, ldb, acol, lat;
    DI bool next(int i, Unit& u) const { int pm, pn; if (!T.tile(i, pm, pn)) return false; if (lat) pm = pm < 32 ? pm + 1 : pm + 2; u.pm = pm; u.pn = pn; u.aux = 0;
        u.aoff = ((size_t)pm * 256 * lda + acol) * 2; u.boff = (size_t)pn * 256 * ldb * 2; return true; }
};
struct SchedLat {
    pg8::TileOrder T; int lda, ldb;
    DI bool next(int i, Unit& u) const { int lp, pn; if (!T.tile(i, lp, pn)) return false; const int pm = lp < 32 ? lp + 1 : lp + 2; u.pm = pm; u.pn = pn; u.aux = 0;
        u.aoff = (size_t)pm * 256 * lda * 2; u.boff = (size_t)pn * 256 * ldb * 2; return true; }
};
struct SchedCtxK {
    int G, c, ns, kc, lda, ldb;
    DI bool next(int i, Unit& u) const { const int L = i * G + c; if (L >= 8 * ns) return false;
        const int sl = L % ns, t = L / ns, pn = t & 3, pm = (t >> 2) ? 33 : 0; u.pm = pm; u.pn = pn; u.aux = sl;
        u.aoff = ((size_t)pm * 256 * lda + (size_t)sl * kc) * 2; u.boff = ((size_t)pn * 256 * ldb + (size_t)sl * kc) * 2; return true; }
};
struct SchedL3B {
    int G, c;
    DI bool next(int i, Unit& u) const {
        int L = i * G + c; if (L >= 660) return false;
        int grp, pm, pn; size_t bb; int acol;
        if (L < 396) { grp = 0; pm = L % 66; pn = L / 66; bb = 0; acol = PC_Z; }
        else if (L < 528) { L -= 396; grp = 1; pm = L % 66; pn = L / 66; bb = WL_UQ - WL_L1; acol = PC_CQ; }
        else { L -= 528; grp = 2; pm = L % 66; pn = L / 66; bb = WL_UKV - WL_L1; acol = PC_CKV; }
        u.pm = pm; u.pn = pn; u.aux = grp; u.aoff = ((size_t)pm * 256 * LDP + acol) * 2; u.boff = bb + (size_t)pn * 256 * 256 * 2; return true;
    }
};
struct SchedL3C {
    int G, c, layer;
    DI bool next(int i, Unit& u) const {
        const int L = i * G + c; const int ntile = layer == 0 ? 5 : 6; if (L >= 66 * ntile) return false;
        const int pm = L % 66; int pn = L / 66; if (layer == 0 && pn >= 4) pn = 5;
        u.pm = pm; u.pn = pn; u.aux = 0; u.aoff = ((size_t)pm * 256 * 1536 + pn * 256) * 2; u.boff = (size_t)pn * 256 * 256 * 2; return true;
    }
};
struct SchedMerge {
    int G, c, lat, b0, nb, one;
    DI bool next(int i, Unit& u) const {
        const int ti = one ? c : (i / nb) * G + c; if (ti >= (lat ? 256 : 264) || (one && i >= nb)) return false; const int br = b0 + i % nb;
        int pm, pn; if (lat) { const int lp = ti & 63; pm = lp < 32 ? lp + 1 : lp + 2; pn = ti >> 6; } else { pm = ti % 66; pn = ti / 66; }
        u.pm = pm; u.pn = pn; u.aux = br; u.aoff = ((size_t)pm * 256 * 1024 + br * 256) * 2; u.boff = ((size_t)(br * 1024 + pn * 256) * 256) * 2; return true;
    }
};
struct SchedMoe {
    int G, c, ncol, lda, ldb, nrowB; int cp[9];
    DI bool next(int i, Unit& u) const {
        const int L = i * G + c; if (L >= cp[8] * ncol) return false;
        const int p = L / ncol, j = L % ncol; int e = 0;
#pragma unroll
        for (int q = 1; q < 8; ++q) e += (p >= cp[q]) ? 1 : 0;
        u.pm = p; u.pn = e; u.aux = j; u.aoff = (size_t)p * 256 * lda * 2; u.boff = ((size_t)e * nrowB + (size_t)j * 256) * ldb * 2; return true;
    }
};

typedef const f32x4 (&AccRef)[2][2][4][2];
#define EPI_ROWS(u) _Pragma("unroll") for (int ai = 0; ai < 2; ++ai) _Pragma("unroll") for (int m = 0; m < 4; ++m)
#define EPI_ROW(u) ((u).pm * 256 + ai * 128 + wr * 64 + m * 16 + fr)
DI u32x4 pack8(const f32x4 a, const f32x4 b) { u32x4 w; w.x = cvt_pk_bf16(a[0], a[1]); w.y = cvt_pk_bf16(a[2], a[3]); w.z = cvt_pk_bf16(b[0], b[1]); w.w = cvt_pk_bf16(b[2], b[3]); return w; }
DI void unpack8(const u32x4 w, f32x4& a, f32x4& b) { a = (f32x4){bflo(w.x), bfhi(w.x), bflo(w.y), bfhi(w.y)}; b = (f32x4){bflo(w.z), bfhi(w.z), bflo(w.w), bfhi(w.w)}; }

struct EpiWin {
    bf16_t* P; int sigfrom; int tm;
    DI void operator()(AccRef acc, const Unit& u, int wr, int wc, int fr, int fq) const {
        asm volatile("" : "+v"(fr), "+v"(fq));
        const bool sig = u.pn >= sigfrom;
        EPI_ROWS(u) { bf16_t* rp = tm ? P + (size_t)u.pn * NROW * 256 + (size_t)EPI_ROW(u) * 256 + wc * 32 + fq * 8 : P + (size_t)EPI_ROW(u) * LDP + u.pn * 256 + wc * 32 + fq * 8;
#pragma unroll
            for (int bj = 0; bj < 2; ++bj) { f32x4 a = acc[ai][bj][m][0], b = acc[ai][bj][m][1];
                if (sig) {
#pragma unroll
                    for (int j = 0; j < 4; ++j) { a[j] = sigmoidf_(a[j]); b[j] = sigmoidf_(b[j]); } }
                *(GAS u32x4*)(rp + bj * 128) = pack8(a, b); } asm volatile("" ::: "memory"); }
    }
};
struct EpiNull {
    bf16_t* P;
    DI void operator()(AccRef acc, const Unit& u, int wr, int wc, int fr, int fq) const {
        asm volatile("" : "+v"(fr), "+v"(fq));
        if (u.pm < 0) {
        EPI_ROWS(u) { bf16_t* rp = P + (size_t)EPI_ROW(u) * LDP + u.pn * 256 + wc * 32 + fq * 8;
#pragma unroll
            for (int bj = 0; bj < 2; ++bj) *(GAS u32x4*)(rp + bj * 128) = pack8(acc[ai][bj][m][0], acc[ai][bj][m][1]); } }
    }
};
struct EpiL3B {
    bf16_t* T; bf16_t* Qm; bf16_t* Km; bf16_t* Vm; const float* rope32;
    DI void operator()(AccRef acc, const Unit& u, int wr, int wc, int fr, int fq) const {
        asm volatile("" : "+v"(fr), "+v"(fq));
        const int grp = u.aux, pn = u.pn;
        EPI_ROWS(u) { const int row = EPI_ROW(u);
#pragma unroll
            for (int bj = 0; bj < 2; ++bj) { f32x4 a = acc[ai][bj][m][0], b = acc[ai][bj][m][1]; const int ct = bj * 128 + wc * 32 + fq * 8;
                if (grp == 0) {
                    if (pn < 2) {
#pragma unroll
                        for (int j = 0; j < 4; ++j) { a[j] = tanhf_(a[j]); b[j] = tanhf_(b[j]); } }
                    else if (pn == 5) {
#pragma unroll
                        for (int j = 0; j < 4; ++j) { a[j] = sigmoidf_(a[j]); b[j] = sigmoidf_(b[j]); } }
                    *(GAS u32x4*)(T + (size_t)row * 1536 + pn * 256 + ct) = pack8(a, b);
                } else if (grp == 1) {
                    const int col = pn * 256 + ct;
                    if (col < 384) {
                        const int within = col % 96; const int pos = row % TPB;
                        if (within >= 64 && pos >= CTXL) {
                            const float* rt = rope32 + ((size_t)(pos - CTXL) * 16 + ((within - 64) >> 1)) * 2;
                            const f32x4 cs0 = *(const f32x4*)rt, cs1 = *(const GAS f32x4*)(rt + 4);
                            const f32x4 a2 = (f32x4){a[0] * cs0[0] - a[1] * cs0[1], a[0] * cs0[1] + a[1] * cs0[0], a[2] * cs0[2] - a[3] * cs0[3], a[2] * cs0[3] + a[3] * cs0[2]};
                            const f32x4 b2 = (f32x4){b[0] * cs1[0] - b[1] * cs1[1], b[0] * cs1[1] + b[1] * cs1[0], b[2] * cs1[2] - b[3] * cs1[3], b[2] * cs1[3] + b[3] * cs1[2]};
                            a = a2; b = b2;
                        }
                        a = a * QS96; b = b * QS96;
                        *(GAS u32x4*)(Qm + (size_t)row * 384 + col) = pack8(a, b);
                    }
                } else {
                    const int col = pn * 256 + ct, head = col >> 7, within = col & 127;
                    if (within < 64) *(GAS u32x4*)(Km + (size_t)row * 384 + head * 96 + within) = pack8(a, b);
                    else *(GAS u32x4*)(Vm + (size_t)row * 256 + head * 64 + (within - 64)) = pack8(a, b);
                }
            } asm volatile("" ::: "memory"); }
    }
};
struct EpiL3C {
    int layer; const float* w0; const float* a0; const float* v0; const float* k_a;
    float* W; bf16_t* KD; bf16_t* BB; const bf16_t* Kr; const bf16_t* KK; bf16_t* V; const bf16_t* VF; bf16_t* Gg;
    DI void operator()(AccRef acc, const Unit& u, int wr, int wc, int fr, int fq) const {
        asm volatile("" : "+v"(fr), "+v"(fq));
        const int pn = u.pn;
        EPI_ROWS(u) { const int row = EPI_ROW(u);
#pragma unroll
            for (int bj = 0; bj < 2; ++bj) { f32x4 a = acc[ai][bj][m][0], b = acc[ai][bj][m][1]; const int ct = bj * 128 + wc * 32 + fq * 8;
                if (pn < 2) {
                    const f32x4 wa = *(const GAS f32x4*)(w0 + pn * 256 + ct), wb = *(const GAS f32x4*)(w0 + pn * 256 + ct + 4);
                    f32x4 oa, ob;
#pragma unroll
                    for (int j = 0; j < 4; ++j) { oa[j] = fast_exp2(-0.6065306597f * LOG2E * sigmoidf_(wa[j] + a[j])); ob[j] = fast_exp2(-0.6065306597f * LOG2E * sigmoidf_(wb[j] + b[j])); }
                    float* wp = W + (size_t)row * 512 + pn * 256 + ct; *(f32x4*)wp = oa; *(GAS f32x4*)(wp + 4) = ob;
                } else if (pn < 4) {
                    const int d = pn - 2;
                    const f32x4 aa = *(const GAS f32x4*)(a0 + d * 256 + ct), ab = *(const GAS f32x4*)(a0 + d * 256 + ct + 4);
                    const f32x4 ka = *(const GAS f32x4*)(k_a + ct), kb = *(const GAS f32x4*)(k_a + ct + 4);
                    f32x4 k0, k1, q0, q1; unpack8(*(const GAS u32x4*)(Kr + (size_t)row * 256 + ct), k0, k1); unpack8(*(const GAS u32x4*)(KK + (size_t)row * 256 + ct), q0, q1);
                    f32x4 kd0, kd1, bb0, bb1;
#pragma unroll
                    for (int j = 0; j < 4; ++j) { const float s0 = sigmoidf_(aa[j] + a[j]), s1 = sigmoidf_(ab[j] + b[j]);
                        kd0[j] = k0[j] * (1.0f + (s0 - 1.0f) * ka[j]); kd1[j] = k1[j] * (1.0f + (s1 - 1.0f) * kb[j]); bb0[j] = q0[j] * s0; bb1[j] = q1[j] * s1; }
                    *(GAS u32x4*)(KD + (size_t)row * 512 + d * 256 + ct) = pack8(kd0, kd1); *(GAS u32x4*)(BB + (size_t)row * 512 + d * 256 + ct) = pack8(bb0, bb1);
                } else if (pn == 4) {
                    const f32x4 va = *(const GAS f32x4*)(v0 + ct), vb = *(const GAS f32x4*)(v0 + ct + 4);
                    f32x4 r0, r1, f0, f1; unpack8(*(const GAS u32x4*)(V + (size_t)row * 256 + ct), r0, r1); unpack8(*(const GAS u32x4*)(VF + (size_t)row * 256 + ct), f0, f1);
#pragma unroll
                    for (int j = 0; j < 4; ++j) { r0[j] = r0[j] + (f0[j] - r0[j]) * sigmoidf_(va[j] + a[j]); r1[j] = r1[j] + (f1[j] - r1[j]) * sigmoidf_(vb[j] + b[j]); }
                    *(GAS u32x4*)(V + (size_t)row * 256 + ct) = pack8(r0, r1);
                } else {
                    *(GAS u32x4*)(Gg + (size_t)row * 256 + ct) = pack8(a, b);
                }
                asm volatile("" ::: "memory");
            } }
    }
};
struct EpiMerge {
    const bf16_t* P; bf16_t* MB; int init_br;
    DI void operator()(AccRef acc, const Unit& u, int wr, int wc, int fr, int fq) const {
        asm volatile("" : "+v"(fr), "+v"(fq));
        const int br = u.aux;
        const int col = u.pn * 256 + wc * 32 + fq * 8;
#pragma unroll
        for (int ai = 0; ai < 2; ++ai) {
            u32x4 gt[4][2], pm[4][2];
#pragma unroll
            for (int m = 0; m < 4; ++m) { const int row = EPI_ROW(u);
#pragma unroll
                for (int bj = 0; bj < 2; ++bj) { gt[m][bj] = *(const GAS u32x4*)(P + (size_t)row * LDP + PC_GATE + br * 1024 + col + bj * 128);
                    pm[m][bj] = br != init_br ? *(const GAS u32x4*)(MB + (size_t)row * 1024 + col + bj * 128) : (u32x4){0u, 0u, 0u, 0u}; } }
#pragma unroll
            for (int m = 0; m < 4; ++m) { const int row = EPI_ROW(u);
#pragma unroll
                for (int bj = 0; bj < 2; ++bj) { f32x4 g0, g1, p0, p1; unpack8(gt[m][bj], g0, g1); unpack8(pm[m][bj], p0, p1);
                    *(GAS u32x4*)(MB + (size_t)row * 1024 + col + bj * 128) = pack8(acc[ai][bj][m][0] * g0 + p0, acc[ai][bj][m][1] * g1 + p1); } }
            asm volatile("" ::: "memory");
        }
    }
};
struct EpiMergeP {
    const bf16_t* P; bf16_t* D;
    DI void operator()(AccRef acc, const Unit& u, int wr, int wc, int fr, int fq) const {
        asm volatile("" : "+v"(fr), "+v"(fq));
        const int br = u.aux;
        const int col = u.pn * 256 + wc * 32 + fq * 8;
#pragma unroll
        for (int ai = 0; ai < 2; ++ai) {
            u32x4 gt[4][2];
#pragma unroll
            for (int m = 0; m < 4; ++m) { const int row = EPI_ROW(u);
#pragma unroll
                for (int bj = 0; bj < 2; ++bj) gt[m][bj] = *(const GAS u32x4*)(P + (size_t)row * LDP + PC_GATE + br * 1024 + col + bj * 128); }
#pragma unroll
            for (int m = 0; m < 4; ++m) { const int row = EPI_ROW(u);
#pragma unroll
                for (int bj = 0; bj < 2; ++bj) { f32x4 g0, g1; unpack8(gt[m][bj], g0, g1);
                    *(GAS u32x4*)(D + (size_t)row * 1024 + col + bj * 128) = pack8(acc[ai][bj][m][0] * g0, acc[ai][bj][m][1] * g1); } }
            asm volatile("" ::: "memory");
        }
    }
};
struct EpiMergeA {
    const bf16_t* P; bf16_t* MB; const bf16_t* X1; const bf16_t* X2;
    DI void operator()(AccRef acc, const Unit& u, int wr, int wc, int fr, int fq) const {
        asm volatile("" : "+v"(fr), "+v"(fq));
        const int col = u.pn * 256 + wc * 32 + fq * 8;
#pragma unroll
        for (int ai = 0; ai < 2; ++ai) {
#pragma unroll
            for (int m = 0; m < 4; ++m) { const int row = EPI_ROW(u);
                u32x4 gt[2], pm[2], x1[2], x2[2];
#pragma unroll
                for (int bj = 0; bj < 2; ++bj) { const size_t o = (size_t)row * 1024 + col + bj * 128;
                    gt[bj] = *(const GAS u32x4*)(P + (size_t)row * LDP + PC_GATE + col + bj * 128); pm[bj] = *(const GAS u32x4*)(MB + o); x1[bj] = *(const GAS u32x4*)(X1 + o); x2[bj] = *(const GAS u32x4*)(X2 + o); }
#pragma unroll
                for (int bj = 0; bj < 2; ++bj) { f32x4 g0, g1, p0, p1, a0, a1, b0, b1; unpack8(gt[bj], g0, g1); unpack8(pm[bj], p0, p1); unpack8(x1[bj], a0, a1); unpack8(x2[bj], b0, b1);
                    *(GAS u32x4*)(MB + (size_t)row * 1024 + col + bj * 128) = pack8(acc[ai][bj][m][0] * g0 + ((p0 + a0) + b0), acc[ai][bj][m][1] * g1 + ((p1 + a1) + b1)); }
            }
            asm volatile("" ::: "memory");
        }
    }
};
struct EpiResid {
    float* X; const float* mod_l; int which;
    DI void operator()(AccRef acc, const Unit& u, int wr, int wc, int fr, int fq) const {
        asm volatile("" : "+v"(fr), "+v"(fq));
        const int vec = (u.pm % 33 == 0) ? 2 : u.pm / 33;
        const float* gv = mod_l + ((size_t)vec * 6 + which) * 1024 + u.pn * 256 + wc * 32 + fq * 8;
        f32x4 g[2][2];
#pragma unroll
        for (int bj = 0; bj < 2; ++bj) { g[bj][0] = *(const GAS f32x4*)(gv + bj * 128); g[bj][1] = *(const GAS f32x4*)(gv + bj * 128 + 4); }
#pragma unroll
        for (int ai = 0; ai < 2; ++ai)
#pragma unroll
            for (int mh = 0; mh < 2; ++mh) {
                f32x4 xv[2][2][2];
#pragma unroll
                for (int mm = 0; mm < 2; ++mm) { const int m = 2 * mh + mm; const float* xp = X + (size_t)EPI_ROW(u) * 1024 + u.pn * 256 + wc * 32 + fq * 8;
#pragma unroll
                    for (int bj = 0; bj < 2; ++bj) { xv[mm][bj][0] = *(const GAS f32x4*)(xp + bj * 128); xv[mm][bj][1] = *(const GAS f32x4*)(xp + bj * 128 + 4); } }
#pragma unroll
                for (int mm = 0; mm < 2; ++mm) { const int m = 2 * mh + mm; float* xp = X + (size_t)EPI_ROW(u) * 1024 + u.pn * 256 + wc * 32 + fq * 8;
#pragma unroll
                    for (int bj = 0; bj < 2; ++bj) { *(GAS f32x4*)(xp + bj * 128) = xv[mm][bj][0] + g[bj][0] * acc[ai][bj][m][0]; *(GAS f32x4*)(xp + bj * 128 + 4) = xv[mm][bj][1] + g[bj][1] * acc[ai][bj][m][1]; } }
                asm volatile("" ::: "memory");
            }
    }
};
struct EpiSlab {
    float* slab;
    DI void operator()(AccRef acc, const Unit& u, int wr, int wc, int fr, int fq) const {
        asm volatile("" : "+v"(fr), "+v"(fq));
        const int crow0 = (u.pm == 33 ? 256 : 0) - u.pm * 256;
        EPI_ROWS(u) { float* xp = slab + ((size_t)u.aux * 512 + (size_t)(EPI_ROW(u) + crow0)) * 1024 + u.pn * 256 + wc * 32 + fq * 8;
#pragma unroll
            for (int bj = 0; bj < 2; ++bj) { *(GAS f32x4*)(xp + bj * 128) = acc[ai][bj][m][0]; *(GAS f32x4*)(xp + bj * 128 + 4) = acc[ai][bj][m][1]; }
            asm volatile("" ::: "memory"); }
    }
};
struct EpiSwiGlu {
    bf16_t* U; int moe;
    DI void operator()(AccRef acc, const Unit& u, int wr, int wc, int fr, int fq) const {
        asm volatile("" : "+v"(fr), "+v"(fq));
        const int tile = moe ? u.aux : u.pn;
        EPI_ROWS(u) { bf16_t* up = U + (size_t)EPI_ROW(u) * DFF + tile * 128 + wc * 32 + fq * 8;
            f32x4 a = acc[ai][0][m][0], b = acc[ai][0][m][1]; const f32x4 c = acc[ai][1][m][0], d = acc[ai][1][m][1];
#pragma unroll
            for (int j = 0; j < 4; ++j) { a[j] = siluf_(a[j]) * c[j]; b[j] = siluf_(b[j]) * d[j]; }
            *(u32x4*)up = pack8(a, b); asm volatile("" ::: "memory"); }
    }
};
struct EpiMoeDown {
    bf16_t* Yg; const float* rowgate;
    DI void operator()(AccRef acc, const Unit& u, int wr, int wc, int fr, int fq) const {
        asm volatile("" : "+v"(fr), "+v"(fq));
        EPI_ROWS(u) { const int row = EPI_ROW(u); const float gt = *(const GAS float*)(rowgate + row); bf16_t* yp = Yg + (size_t)row * 1024 + u.aux * 256 + wc * 32 + fq * 8;
#pragma unroll
            for (int bj = 0; bj < 2; ++bj) *(GAS u32x4*)(yp + bj * 128) = pack8(acc[ai][bj][m][0] * gt, acc[ai][bj][m][1] * gt);
            asm volatile("" ::: "memory"); }
    }
};
struct ConvMat { const float* s0; const float* s1; int ld; int ksrc; bf16_t* dst; int N; int K; int kind; int nvalid; };
DI int perm64(int i) { return (i >> 1) + 32 * (i & 1); }
DI int perm32r(int i) { return (i >> 1) + 16 * (i & 1); }
DI const float* conv_col(const ConvMat& M, int n) {
    if (M.kind == 0) return n < M.nvalid ? M.s0 + n : nullptr;
    if (M.kind == 1) {
        int col;
        if (n < 1024) col = n;
        else if (n < 1280) { const int j = n - 1024; col = 1024 + (j & ~63) + perm64(j & 63); }
        else if (n < 1408) { const int j = n - 1280; col = 1280 + (j & ~63) + perm64(j & 63); }
        else if (n < 1920) col = n;
        else if (n < 1952) col = 1920 + perm32r(n - 1920);
        else if (n < 2048) return nullptr;
        else if (n < 2304) { const int j = n - 2048; col = 1952 + (j & ~63) + perm64(j & 63); }
        else if (n < 2432) { const int j = n - 2304; col = 2208 + (j & ~63) + perm64(j & 63); }
        else if (n < 2560) col = 2336 + (n - 2432);
        else col = 2464 + (n - 2560);
        return M.s0 + col;
    }
    if (M.kind == 2) {
        if (n >= 384) return nullptr;
        const int h = n / 96, w = n % 96;
        return M.s0 + (w < 64 ? n : h * 96 + 64 + perm32r(w - 64));
    }
    {
        const int t = n >> 8, half = (n >> 7) & 1, j = n & 127;
        return (const float*)((uintptr_t)M.s0 + (uintptr_t)half * ((uintptr_t)M.s1 - (uintptr_t)M.s0)) + t * 128 + j;
    }
}
DI void conv_item(const ConvMat& M, int item, LAS float* scr, int lane) {
    const int nkb = M.K / 64, nb = item / nkb, kb = item % nkb, n0 = nb * 32, k0 = kb * 64;
    const float* cp = conv_col(M, n0 + (lane & 31));
#pragma unroll 8
    for (int i = 0; i < 32; ++i) { const int kk = 2 * i + (lane >> 5); const int k = k0 + kk;
        float v = 0.f; if (cp != nullptr && k < M.ksrc) v = *(const GAS float*)(cp + (size_t)k * M.ld);
        scr[kk * 33 + (lane & 31)] = v; }
    LDS_WAIT(); asm volatile("" ::: "memory");
    const int c = lane & 7;
#pragma unroll
    for (int j = 0; j < 4; ++j) { const int n = (lane >> 3) + 8 * j; const LAS float* s = scr + (8 * c) * 33 + n;
        u32x4 o; o.x = pk2(s[0 * 33], s[1 * 33]); o.y = pk2(s[2 * 33], s[3 * 33]); o.z = pk2(s[4 * 33], s[5 * 33]); o.w = pk2(s[6 * 33], s[7 * 33]);
        *(GAS u32x4*)(M.dst + (size_t)(n0 + n) * M.K + k0 + 8 * c) = o; }
    LDS_WAIT(); asm volatile("" ::: "memory");
}
DI ConvMat mkmat(const float* s0, const float* s1, int ld, int ksrc, bf16_t* dst, int N, int K, int kind, int nvalid) { ConvMat M; M.s0 = s0; M.s1 = s1; M.ld = ld; M.ksrc = ksrc; M.dst = dst; M.N = N; M.K = K; M.kind = kind; M.nvalid = nvalid; return M; }
DI bool conv_slow_block(const ConvMat& M, int b128) { return M.kind == 2 || (M.kind == 1 && ((b128 >= 8 && b128 <= 10) || (b128 >= 15 && b128 <= 18))); }
DI void conv_item_fast(const ConvMat& M, int item, LAS bf16_t* scr, int lane) {
    const int nkb = M.K / 32, nb = item / nkb, kb = item % nkb, n0 = nb * 128, k0 = kb * 32;
    if (conv_slow_block(M, nb)) return;
    const float* cp = conv_col(M, n0);
    int nv = 128; if (M.kind == 0) { nv = M.nvalid - n0; nv = nv < 0 ? 0 : (nv > 128 ? 128 : nv); }
    const int q = lane & 31, kr = lane >> 5;
    const bool cok = cp != nullptr && 4 * q < nv;
    f32x4 v[16];
#pragma unroll
    for (int i = 0; i < 16; ++i) { const int k = k0 + 2 * i + kr; v[i] = (cok && k < M.ksrc) ? *(const GAS f32x4*)(cp + (size_t)k * M.ld + 4 * q) : (f32x4){0.f, 0.f, 0.f, 0.f}; }
#pragma unroll
    for (int i = 0; i < 16; ++i) { u32x2 o; o.x = pk2(v[i][0], v[i][1]); o.y = pk2(v[i][2], v[i][3]); *(LAS u32x2*)(scr + (2 * i + kr) * 132 + 4 * q) = o; }
    LDS_WAIT(); asm volatile("" ::: "memory");
#pragma unroll
    for (int p = 0; p < 2; ++p)
#pragma unroll
        for (int c = 0; c < 4; ++c) { const int n = lane + 64 * p; const LAS bf16_t* sp = scr + (8 * c) * 132 + n;
            u32x4 o; o.x = (unsigned)sp[0] | ((unsigned)sp[132] << 16); o.y = (unsigned)sp[2 * 132] | ((unsigned)sp[3 * 132] << 16); o.z = (unsigned)sp[4 * 132] | ((unsigned)sp[5 * 132] << 16); o.w = (unsigned)sp[6 * 132] | ((unsigned)sp[7 * 132] << 16);
            *(GAS u32x4*)(M.dst + (size_t)(n0 + n) * M.K + k0 + 8 * c) = o; }
    LDS_WAIT(); asm volatile("" ::: "memory");
}
struct ConvSel { int mode, lo, hi; };
DI void conv_run(Frame& F, const ConvMat M, int& gbase, const ConvSel sel) {
    LAS float* scr = (LAS float*)(F.lds + F.wave * 16384);
    const int gw = F.vcu * 8 + F.wave, NGW = F.G * 8;
    {
        const int nitems = (M.N / 128) * (M.K / 32);
        int it, step;
        if (sel.mode == 0) { it = (gw - gbase % NGW) % NGW; if (it < 0) it += NGW; step = NGW; }
        else { int f = sel.lo - gbase; if (f < 0) f = 0; const int ph = (gbase + f - sel.lo) & 7; it = f + ((F.wave - ph) & 7); step = 8; }
        const int end = sel.mode == 0 ? nitems : ((sel.hi - gbase) < nitems ? (sel.hi - gbase) : nitems);
        for (; it < end; it += step) conv_item_fast(M, it, (LAS bf16_t*)scr, F.lane);
        gbase += nitems;
    }
    if (M.kind == 1 || M.kind == 2) {
        const int nkb = M.K / 64;
        const int nrow32 = M.kind == 2 ? M.N / 32 : 28;
        const int nitems = nrow32 * nkb;
        int it, step;
        if (sel.mode == 0) { it = (gw - gbase % NGW) % NGW; if (it < 0) it += NGW; step = NGW; }
        else { int f = sel.lo - gbase; if (f < 0) f = 0; const int ph = (gbase + f - sel.lo) & 7; it = f + ((F.wave - ph) & 7); step = 8; }
        const int end = sel.mode == 0 ? nitems : ((sel.hi - gbase) < nitems ? (sel.hi - gbase) : nitems);
        for (; it < end; it += step) { int rb = it / nkb; const int kb = it % nkb;
            if (M.kind == 1) rb = rb < 12 ? 32 + rb : 60 + (rb - 12);
            conv_item(M, rb * nkb + kb, scr, F.lane); }
        gbase += nitems;
    }
}
DI int convert_layer_weights(Frame& F, int l, const ConvSel sel) {
    unsigned char* wl = F.ws + ((l & 1) ? WS_WL : WS_WLB);
    int start = 0;
    conv_run(F, mkmat(inp(I_WIN) + (size_t)l * 1024 * IN_W, nullptr, IN_W, 1024, (bf16_t*)(wl + WL_WIN), NP_GEMM, 1024, 1, NP_GEMM), start, sel);
    for (int i = 0; i < 4; ++i) conv_run(F, mkmat(inp(I_WBR) + (size_t)(l * 4 + i) * 256 * 1024, nullptr, 1024, 256, (bf16_t*)(wl + WL_WBR) + (size_t)i * 1024 * 256, 1024, 256, 0, 1024), start, sel);
    conv_run(F, mkmat(inp(I_WOUT) + (size_t)l * 1024 * 1024, nullptr, 1024, 1024, (bf16_t*)(wl + WL_WOUT), 1024, 1024, 0, 1024), start, sel);
    for (int d = 0; d < 2; ++d) conv_run(F, mkmat(inp(I_W1) + (size_t)(l * 2 + d) * 256 * 64, nullptr, 64, 256, (bf16_t*)(wl + WL_L1) + (size_t)d * 256 * 256, 256, 256, 0, 64), start, sel);
    for (int d = 0; d < 2; ++d) conv_run(F, mkmat(inp(I_A1) + (size_t)(l * 2 + d) * 256 * 64, nullptr, 64, 256, (bf16_t*)(wl + WL_L1) + (size_t)(2 + d) * 256 * 256, 256, 256, 0, 64), start, sel);
    conv_run(F, mkmat(inp(I_V1) + (size_t)(l > 0 ? l - 1 : 0) * 256 * 32, nullptr, 32, 256, (bf16_t*)(wl + WL_L1) + (size_t)4 * 256 * 256, 256, 256, 0, l > 0 ? 32 : 0), start, sel);
    conv_run(F, mkmat(inp(I_G1) + (size_t)l * 256 * 128, nullptr, 128, 256, (bf16_t*)(wl + WL_L1) + (size_t)5 * 256 * 256, 256, 256, 0, 128), start, sel);
    for (int d = 0; d < 2; ++d) conv_run(F, mkmat(inp(I_W2) + (size_t)(l * 2 + d) * 64 * 256, nullptr, 256, 64, (bf16_t*)(wl + WL_L2) + (size_t)d * 256 * 256, 256, 256, 0, 256), start, sel);
    for (int d = 0; d < 2; ++d) conv_run(F, mkmat(inp(I_A2) + (size_t)(l * 2 + d) * 64 * 256, nullptr, 256, 64, (bf16_t*)(wl + WL_L2) + (size_t)(2 + d) * 256 * 256, 256, 256, 0, 256), start, sel);
    conv_run(F, mkmat(inp(I_V2) + (size_t)(l > 0 ? l - 1 : 0) * 32 * 256, nullptr, 256, l > 0 ? 32 : 0, (bf16_t*)(wl + WL_L2) + (size_t)4 * 256 * 256, 256, 256, 0, 256), start, sel);
    conv_run(F, mkmat(inp(I_G2) + (size_t)l * 128 * 256, nullptr, 256, 128, (bf16_t*)(wl + WL_L2) + (size_t)5 * 256 * 256, 256, 256, 0, 256), start, sel);
    conv_run(F, mkmat(inp(I_WUQ) + (size_t)l * 256 * 384, nullptr, 384, 256, (bf16_t*)(wl + WL_UQ), 512, 256, 2, 384), start, sel);
    conv_run(F, mkmat(inp(I_WUKV) + (size_t)l * 128 * 512, nullptr, 512, 128, (bf16_t*)(wl + WL_UKV), 512, 256, 0, 512), start, sel);
    if ((l & 1) == 0) {
        conv_run(F, mkmat(inp(I_FW1) + (size_t)(l >> 1) * 1024 * DFF, inp(I_FW3) + (size_t)(l >> 1) * 1024 * DFF, DFF, 1024, (bf16_t*)(wl + WL_W13), 7168, 1024, 3, 7168), start, sel);
        conv_run(F, mkmat(inp(I_FW2) + (size_t)(l >> 1) * DFF * 1024, nullptr, 1024, DFF, (bf16_t*)(wl + WL_W2D), 1024, DFF, 0, 1024), start, sel);
    } else {
        for (int e = 0; e < NEXP; ++e) { const size_t eo = (size_t)((l >> 1) * NEXP + e) * 1024 * DFF;
            conv_run(F, mkmat(inp(I_MW1) + eo, inp(I_MW3) + eo, DFF, 1024, (bf16_t*)(wl + WL_W13) + (size_t)e * 7168 * 1024, 7168, 1024, 3, 7168), start, sel); }
        for (int e = 0; e < NEXP; ++e)
            conv_run(F, mkmat(inp(I_MW2) + (size_t)((l >> 1) * NEXP + e) * DFF * 1024, nullptr, 1024, DFF, (bf16_t*)(wl + WL_W2) + (size_t)e * 1024 * DFF, 1024, DFF, 0, 1024), start, sel);
    }
    return start;
}

DI void p0_prologue(Frame& F) {
    convert_layer_weights(F, 0, ConvSel{0, 0, 0});
    const int gw = F.vcu * 8 + F.wave, NGW = F.G * 8;
    for (int r = gw; r < NROW; r += NGW) {
        const int b = r / TPB, pos = r % TPB;
        const float* src = pos < CTXL ? inp(I_CTX) + ((size_t)b * CTXL + pos) * 1024 : inp(I_X) + ((size_t)b * SEQ + (pos - CTXL)) * 1024;
        const GAS f32x4* s4 = (const GAS f32x4*)src + F.lane; GAS f32x4* d4 = (GAS f32x4*)(FX(F) + (size_t)r * 1024) + F.lane;
#pragma unroll
        for (int j = 0; j < 4; ++j) d4[64 * j] = s4[64 * j];
    }
    {
        float* r64 = (float*)(F.ws + WS_ROPE64); float* r32 = (float*)(F.ws + WS_ROPE32);
        const int gt = (F.vcu * 512 + F.tid), NT = F.G * 512;
        for (int i = gt; i < SEQ * 48; i += NT) {
            const int t = i / 48, q = i % 48; const float row = (float)(t / GRIDW), col = (float)(t % GRIDW);
            float ang;
            if (q < 32) { const int f = q & 15; ang = (q < 16 ? row : col) * powf(10000.0f, -(float)f / 16.0f); }
            else { const int p = q - 32, f = p & 7; ang = (p < 8 ? row : col) * powf(10000.0f, -(float)f / 8.0f); }
            float sn, cs; sincosf(ang, &sn, &cs);
            if (q < 32) { r64[((size_t)t * 32 + q) * 2] = cs; r64[((size_t)t * 32 + q) * 2 + 1] = sn; }
            else { r32[((size_t)t * 16 + (q - 32)) * 2] = cs; r32[((size_t)t * 16 + (q - 32)) * 2 + 1] = sn; }
        }
    }
    __syncthreads();
    {
        LAS float* sl = (LAS float*)F.lds;
        LAS float* red = sl + 3072;
        for (int i = F.tid; i < 3072; i += 512) { const int v = i >> 10, k = i & 1023; const float cvv = v < 2 ? *(const GAS float*)(inp(I_C) + v * 1024 + k) : *(const GAS float*)(inp(I_CCTX) + k); sl[i] = siluf_(cvv); }
        __syncthreads();
        const int q = F.lane, ks = F.wave;
        for (int ch = F.vcu; ch < 4 * 24; ch += F.G) {
            const int l = ch / 24, jb = (ch % 24) * 256 + 4 * q;
            const float* wp = inp(I_WMOD) + (size_t)l * 1024 * 6144 + jb;
            f32x4 a0 = (f32x4){0.f, 0.f, 0.f, 0.f}, a1 = a0, a2 = a0;
#pragma unroll 8
            for (int k = ks * 128; k < ks * 128 + 128; ++k) { const f32x4 w = *(const GAS f32x4*)(wp + (size_t)k * 6144); a0 = a0 + w * sl[k]; a1 = a1 + w * sl[1024 + k]; a2 = a2 + w * sl[2048 + k]; }
            *(LAS f32x4*)(red + (ks * 3 + 0) * 256 + 4 * q) = a0; *(LAS f32x4*)(red + (ks * 3 + 1) * 256 + 4 * q) = a1; *(LAS f32x4*)(red + (ks * 3 + 2) * 256 + 4 * q) = a2;
            __syncthreads();
            if (F.tid < 192) { const int v = F.tid >> 6; f32x4 s4 = *(const GAS f32x4*)(inp(I_BMOD) + l * 6144 + jb);
#pragma unroll
                for (int w8 = 0; w8 < 8; ++w8) s4 = s4 + *(const LAS f32x4*)(red + (w8 * 3 + v) * 256 + 4 * q);
                *(GAS f32x4*)(FMOD(F) + (size_t)(l * 3 + v) * 6144 + jb) = s4; }
            __syncthreads();
        }
    }
}

template <int MODE>
DI void norm_phase(Frame& F, int l, float probe_scale = 1.0f) {
    const int rpw = (NROW + F.G - 1) / F.G;
    const int bid = F.bx;
    const int r0 = bid * rpw, r1 = (r0 + rpw) < NROW ? (r0 + rpw) : NROW;
    const bool combine = (MODE == 0 && l > 0 && ((l - 1) & 1)) || MODE == 2;
    const int lprev = MODE == 2 ? DEPTH - 1 : l - 1;
    const bool moe = (MODE == 1) && (l & 1);
    const bool skipctx = MODE == 2 || (MODE == 1 && l == DEPTH - 1);
    const float* nw = MODE == 0 ? inp(I_NORM1) + l * 1024 : MODE == 1 ? inp(I_NORM2) + l * 1024 : inp(I_FNORM);
    const bf16_t* Yg = (const bf16_t*)(F.ws + WS_YG);
    const int* dstp = (const int*)(F.ws + WS_ASG_DST);
    volatile LAS int* hist = (volatile LAS int*)(F.lds + MISC_OFF + 64);
    if (moe) { if (F.tid < 8) hist[F.tid] = 0; __syncthreads(); }
    f32x4 nx[2][4]; u32x2 ny0[2][4], ny1[2][4];
#define NORM_LOAD(set, rr) do { const GAS f32x4* xp_ = (const GAS f32x4*)(FX(F) + (size_t)(rr) * 1024) + F.lane; \
        _Pragma("unroll") for (int j = 0; j < 4; ++j) nx[set][j] = xp_[64 * j]; \
        if (combine && !(skipctx && ((rr) % TPB) < CTXL)) { const int d0_ = *(const GAS int*)(dstp + (rr) * 2), d1_ = *(const GAS int*)(dstp + (rr) * 2 + 1); \
            _Pragma("unroll") for (int j = 0; j < 4; ++j) { const int c_ = 4 * F.lane + 256 * j; ny0[set][j] = *(const GAS u32x2*)(Yg + (size_t)d0_ * 1024 + c_); ny1[set][j] = *(const GAS u32x2*)(Yg + (size_t)d1_ * 1024 + c_); } } } while (0)
    f32x4 nwv[4];
#pragma unroll
    for (int j = 0; j < 4; ++j) nwv[j] = *(const GAS f32x4*)(nw + 4 * F.lane + 256 * j);
    int cur_vec = -1; f32x4 scv[4], shv[4];
    float one_ = 1.f, zero_ = 0.f; asm volatile("" : "+v"(one_), "+v"(zero_));
#pragma unroll
    for (int j = 0; j < 4; ++j) { scv[j] = (f32x4){one_, one_, one_, one_}; shv[j] = (f32x4){zero_, zero_, zero_, zero_}; }
    if (r0 + F.wave < r1) NORM_LOAD(0, r0 + F.wave);
    if (r0 + F.wave + 8 < r1) NORM_LOAD(1, r0 + F.wave + 8);
    for (int rr = r0 + F.wave; rr < r1; rr += 16)
#pragma unroll
    for (int half = 0; half < 2; ++half) {
        const int r = rr + 8 * half; if (r >= r1) break;
        const int vec = row_vec(r);
        float* xr = FX(F) + (size_t)r * 1024;
        f32x4 x[4]; u32x2 y0[4], y1[4];
#pragma unroll
        for (int j = 0; j < 4; ++j) { x[j] = nx[half][j]; y0[j] = ny0[half][j]; y1[j] = ny1[half][j]; }
        if (r + 16 < r1) NORM_LOAD(half, r + 16);
        if (skipctx && (r % TPB) < CTXL) continue;
        if (combine) {
            const float* g2 = modp(F, lprev, vec, 5);
#pragma unroll
            for (int j = 0; j < 4; ++j) { const int c = 4 * F.lane + 256 * j; const f32x4 g = *(const GAS f32x4*)(g2 + c);
                x[j][0] += g[0] * (bflo(y0[j].x) + bflo(y1[j].x)); x[j][1] += g[1] * (bfhi(y0[j].x) + bfhi(y1[j].x)); x[j][2] += g[2] * (bflo(y0[j].y) + bflo(y1[j].y)); x[j][3] += g[3] * (bfhi(y0[j].y) + bfhi(y1[j].y));
                if (MODE == 0) *((GAS f32x4*)xr + F.lane + 64 * j) = x[j]; }
        }
        {
            const int nsl = 0;
            const int pos = r % TPB;
            if (nsl > 0 && pos < CTXL) {
                const int crow = (r / TPB) * 256 + pos;
                const float* gsl = (MODE == 1) ? modp(F, l, 2, 2) : modp(F, l - 1, 2, 5);
                const float* sl = (const float*)(F.ws + WS_SLAB) + (size_t)crow * 1024;
#pragma unroll
                for (int j = 0; j < 4; ++j) { const int c = 4 * F.lane + 256 * j; f32x4 a = *(const GAS f32x4*)(sl + c);
                    for (int q = 1; q < nsl; ++q) a = a + *(const GAS f32x4*)(sl + (size_t)q * 512 * 1024 + c);
                    x[j] = x[j] + *(const GAS f32x4*)(gsl + c) * a; *((GAS f32x4*)xr + F.lane + 64 * j) = x[j]; }
            }
        }
        float ss = 0.f;
#pragma unroll
        for (int j = 0; j < 4; ++j) ss += (x[j][0] * x[j][0] + x[j][1] * x[j][1]) + (x[j][2] * x[j][2] + x[j][3] * x[j][3]);
        const float rstd = 1.0f / sqrtf(wave_sum(ss) * (1.0f / 1024.0f) + 1e-6f);
        if (MODE == 2) {
            const int pos = r % TPB;
            if (pos >= CTXL) { float* op = F.out + ((size_t)(r / TPB) * SEQ + (pos - CTXL)) * 1024;
#pragma unroll
                for (int j = 0; j < 4; ++j) *((GAS f32x4*)op + F.lane + 64 * j) = x[j] * rstd * nwv[j] * probe_scale; }
            continue;
        }
        if (vec != cur_vec) {
            cur_vec = vec; const float* sc = modp(F, l, vec, MODE == 0 ? 1 : 4); const float* sh = modp(F, l, vec, MODE == 0 ? 0 : 3);
#pragma unroll
            for (int j = 0; j < 4; ++j) { const int c = 4 * F.lane + 256 * j; scv[j] = 1.0f + *(const GAS f32x4*)(sc + c); shv[j] = *(const GAS f32x4*)(sh + c); }
        }
        f32x4 h[4];
#pragma unroll
        for (int j = 0; j < 4; ++j) { const int c = 4 * F.lane + 256 * j;
            h[j] = (x[j] * rstd * nwv[j]) * scv[j] + shv[j];
            u32x2 o; o.x = pk2(h[j][0], h[j][1]); o.y = pk2(h[j][2], h[j][3]); *(GAS u32x2*)(FHB(F) + (size_t)r * 1024 + c) = o; }
        if (moe) {
            const float* wr = inp(I_ROUTER) + (size_t)(l >> 1) * 1024 * NEXP;
            float lg[8];
#pragma unroll
            for (int e = 0; e < 8; ++e) lg[e] = 0.f;
#pragma unroll
            for (int j = 0; j < 4; ++j)
#pragma unroll
                for (int q = 0; q < 4; ++q) { const int c = 4 * F.lane + 256 * j + q; const f32x4 w0 = *(const GAS f32x4*)(wr + (size_t)c * 8), w1 = *(const GAS f32x4*)(wr + (size_t)c * 8 + 4); const float hv = h[j][q];
                    lg[0] += hv * w0[0]; lg[1] += hv * w0[1]; lg[2] += hv * w0[2]; lg[3] += hv * w0[3]; lg[4] += hv * w1[0]; lg[5] += hv * w1[1]; lg[6] += hv * w1[2]; lg[7] += hv * w1[3]; }
#pragma unroll
            for (int e = 0; e < 8; ++e) lg[e] = wave_sum(lg[e]);
            int e1 = 0; float l1 = lg[0];
#pragma unroll
            for (int e = 1; e < 8; ++e) if (lg[e] > l1) { l1 = lg[e]; e1 = e; }
            int e2 = -1; float l2 = -3.0e38f;
#pragma unroll
            for (int e = 0; e < 8; ++e) if (e != e1 && lg[e] > l2) { l2 = lg[e]; e2 = e; }
            if (e2 < 0) e2 = (e1 + 1) & 7;
            if (F.lane == 0) {
                const float ex = __expf(l2 - l1); const float g1v = 1.0f / (1.0f + ex), g2v = ex / (1.0f + ex);
                const int lp1 = __hip_atomic_fetch_add((LAS int*)&hist[e1], 1, __ATOMIC_RELAXED, __HIP_MEMORY_SCOPE_WORKGROUP);
                const int lp2 = __hip_atomic_fetch_add((LAS int*)&hist[e2], 1, __ATOMIC_RELAXED, __HIP_MEMORY_SCOPE_WORKGROUP);
                int* asg = (int*)(F.ws + WS_ASG) + (size_t)r * 4; asg[0] = e1 | (e2 << 8); asg[1] = lp1; asg[2] = lp2;
                float* ag = (float*)(F.ws + WS_ASG_GATE) + (size_t)r * 2; ag[0] = g1v; ag[1] = g2v;
            }
        }
    }
#undef NORM_LOAD
    if (moe) {
        __syncthreads();
        if (F.tid < 8) { const int cnt = hist[F.tid]; const int bank = l >> 1;
            const unsigned base = cnt > 0 ? __hip_atomic_fetch_add(F.ctl + CW_MOECNT + bank * 64 + F.tid, (unsigned)cnt, __ATOMIC_RELAXED, __HIP_MEMORY_SCOPE_AGENT) : 0u;
            F.ctl[CW_WGBASE + (bank * 256 + bid) * 8 + F.tid] = base; }
    }
}
DI void moe_panels(const Frame& F, int l, int (&cp)[9]) {
    int acc = 0;
#pragma unroll
    for (int e = 0; e < 8; ++e) { cp[e] = acc; const unsigned c = __hip_atomic_load(F.ctl + CW_MOECNT + (l >> 1) * 64 + e, __ATOMIC_RELAXED, __HIP_MEMORY_SCOPE_AGENT); acc += (int)((c + 255u) >> 8); }
    cp[8] = acc;
#pragma unroll
    for (int e = 0; e < 9; ++e) cp[e] = __builtin_amdgcn_readfirstlane(cp[e]);
}
DI void moe_gather(Frame& F, int l) {
    int cp[9]; moe_panels(F, l, cp);
    const int rpw = (NROW + F.G - 1) / F.G; const int bid = F.bx;
    const int r0 = bid * rpw, r1 = (r0 + rpw) < NROW ? (r0 + rpw) : NROW;
    bf16_t* Xg = (bf16_t*)(F.ws + WS_XG); float* rowgate = (float*)(F.ws + WS_ROWGATE); int* dstp = (int*)(F.ws + WS_ASG_DST);
    const unsigned* wgb = F.ctl + CW_WGBASE + ((l >> 1) * 256 + bid) * 8;
    for (int r = r0 + F.wave; r < r1; r += 8) {
        if (l == DEPTH - 1 && (r % TPB) < CTXL) continue;
        const int* asg = (const int*)(F.ws + WS_ASG) + (size_t)r * 4; const float* ag = (const float*)(F.ws + WS_ASG_GATE) + (size_t)r * 2;
        const int ee = asg[0], e1 = ee & 255, e2 = ee >> 8;
        int cpa = 0, cpb = 0;
#pragma unroll
        for (int e = 0; e < 8; ++e) { cpa = (e == e1) ? cp[e] : cpa; cpb = (e == e2) ? cp[e] : cpb; }
        const int d0 = cpa * 256 + (int)wgb[e1] + asg[1], d1 = cpb * 256 + (int)wgb[e2] + asg[2];
        const GAS u32x4* src = (const GAS u32x4*)(FHB(F) + (size_t)r * 1024) + F.lane;
        const u32x4 v0 = src[0], v1 = src[64];
        GAS u32x4* p0 = (GAS u32x4*)(Xg + (size_t)d0 * 1024) + F.lane; GAS u32x4* p1 = (GAS u32x4*)(Xg + (size_t)d1 * 1024) + F.lane;
        p0[0] = v0; p0[64] = v1; p1[0] = v0; p1[64] = v1;
        if (F.lane == 0) { rowgate[d0] = ag[0]; rowgate[d1] = ag[1]; dstp[r * 2] = d0; dstp[r * 2 + 1] = d1; }
    }
}

DI f32x4 ld4bf(const bf16_t* p) { const u32x2 w = *(const u32x2*)p; return (f32x4){bflo(w.x), bfhi(w.x), bflo(w.y), bfhi(w.y)}; }
DI void st4bf(bf16_t* p, const f32x4 v) { u32x2 o; o.x = pk2(v[0], v[1]); o.y = pk2(v[2], v[3]); *(u32x2*)p = o; }
DI f32x4 rope2(const f32x4 v, const float* cs) {
    const f32x4 t = *(const GAS f32x4*)cs;
    return (f32x4){v[0] * t[0] - v[1] * t[1], v[0] * t[1] + v[1] * t[0], v[2] * t[2] - v[3] * t[3], v[2] * t[3] + v[3] * t[2]};
}
DI u32x2 ld8(const bf16_t* p) { return *(const GAS u32x2*)p; }
DI f32x4 bf4(const u32x2 w) { return (f32x4){bflo(w.x), bfhi(w.x), bflo(w.y), bfhi(w.y)}; }
DI f32x4 rope2v(const f32x4 v, const f32x4 t) { return (f32x4){v[0] * t[0] - v[1] * t[1], v[0] * t[1] + v[1] * t[0], v[2] * t[2] - v[3] * t[3], v[2] * t[3] + v[3] * t[2]}; }
DI void prep_phase(Frame& F, int l) {
    const int gw = F.vcu * 8 + F.wave, NGW = F.G * 8, lane = F.lane;
    bf16_t* RR = (bf16_t*)(F.ws + WS_RR); bf16_t* KK = (bf16_t*)(F.ws + WS_KK); bf16_t* KR = (bf16_t*)(F.ws + WS_KR); bf16_t* V = (bf16_t*)(F.ws + WS_V); bf16_t* VF = (bf16_t*)(F.ws + WS_VF);
    bf16_t* Km = (bf16_t*)(F.ws + WS_KMLA);
    const float* r64 = (const float*)(F.ws + WS_ROPE64); const float* r32 = (const float*)(F.ws + WS_ROPE32);
    const float* mu = inp(I_MU) + (size_t)l * 2048;
    const int c4 = 4 * lane;
    f32x4 m0[4], m1[4];
#pragma unroll
    for (int s = 0; s < 4; ++s) { m0[s] = *(const GAS f32x4*)(mu + s * 256 + c4); m1[s] = *(const GAS f32x4*)(mu + 1024 + s * 256 + c4); }
    const f32x4 kkv = *(const GAS f32x4*)(inp(I_KK) + l * 256 + c4), mqn = *(const GAS f32x4*)(inp(I_MQN) + l * 256 + c4);
    const f32x4 mkvn = lane < 32 ? *(const GAS f32x4*)(inp(I_MKVN) + l * 128 + c4) : (f32x4){0.f, 0.f, 0.f, 0.f};
    const int i0 = c4 & 63, pi = i0 >> 1;
    f32x4 gq, gk;
    { const float* gqp = inp(I_GQN) + l * 64; const float* gkp = inp(I_GKN) + l * 64;
#pragma unroll
      for (int j = 0; j < 4; ++j) { gq[j] = *(const GAS float*)(gqp + perm64(i0 + j)); gk[j] = *(const GAS float*)(gkp + perm64(i0 + j)); } }
    struct PrepRaw { u32x2 rf[4], rp[4], rn[4], rswq, rcq, rgaq, rswk, rckv, rgak, rkr; f32x4 cs64, cs32; };
    const u32x2 zz = (u32x2){0u, 0u};
#define PREP_LOAD(R, rr) do { const int pos_ = (rr) % TPB; const bool isctx_ = pos_ < CTXL; const int t_ = isctx_ ? 0 : pos_ - CTXL; \
        const bool hasp_ = isctx_ ? (pos_ > 0) : (pos_ > CTXL), hasn_ = isctx_ ? (pos_ < CTXL - 1) : (pos_ < TPB - 1); \
        const bf16_t* pr_ = FP(F) + (size_t)(rr) * LDP; \
        _Pragma("unroll") for (int s = 0; s < 4; ++s) { R.rf[s] = ld8(pr_ + s * 256 + c4); R.rp[s] = hasp_ ? ld8(pr_ - LDP + s * 256 + c4) : zz; R.rn[s] = hasn_ ? ld8(pr_ + LDP + s * 256 + c4) : zz; } \
        R.rswq = ld8(pr_ + PC_SWQ + c4); R.rcq = ld8(pr_ + PC_CQ + c4); R.rgaq = ld8(pr_ + PC_GAQ + c4); \
        R.rswk = lane < 32 ? ld8(pr_ + PC_SWK + c4) : zz; R.rckv = lane < 32 ? ld8(pr_ + PC_CKV + c4) : zz; R.rgak = lane < 32 ? ld8(pr_ + PC_GAK + c4) : zz; \
        R.rkr = lane < 8 ? ld8(pr_ + PC_KR + c4) : zz; \
        R.cs64 = *(const GAS f32x4*)(r64 + ((size_t)t_ * 32 + pi) * 2); R.cs32 = *(const GAS f32x4*)(r32 + ((size_t)t_ * 16 + 2 * (lane & 7)) * 2); } while (0)
    PrepRaw RA, RB;
    if (gw < NROW) PREP_LOAD(RA, gw);
    for (int r = gw; r < NROW; r += NGW) {
        if (r + NGW < NROW) PREP_LOAD(RB, r + NGW);
        const int pos = r % TPB; const bool isctx = pos < CTXL;
        bf16_t* pr = FP(F) + (size_t)r * LDP;
        u32x2 rf[4], rp[4], rn[4];
#pragma unroll
        for (int s = 0; s < 4; ++s) { rf[s] = RA.rf[s]; rp[s] = RA.rp[s]; rn[s] = RA.rn[s]; }
        const u32x2 rswq = RA.rswq, rcq = RA.rcq, rgaq = RA.rgaq, rswk = RA.rswk, rckv = RA.rckv, rgak = RA.rgak, rkr = RA.rkr;
        const f32x4 cs64 = RA.cs64, cs32 = RA.cs32;
        RA = RB;
        f32x4 o[4];
#pragma unroll
        for (int s = 0; s < 4; ++s) { const f32x4 f = bf4(rf[s]), fp = bf4(rp[s]), fn = bf4(rn[s]); o[s] = f + m0[s] * (fp - f) + m1[s] * (fn - f); }
        st4bf(RR + (size_t)r * 256 + c4, o[0]);
        st4bf(KR + (size_t)r * 256 + c4, o[1]);
        { const f32x4 kx = o[1] * kkv; const float ss = sum16((kx[0] * kx[0] + kx[1] * kx[1]) + (kx[2] * kx[2] + kx[3] * kx[3])); st4bf(KK + (size_t)r * 256 + c4, kx * (1.0f / sqrtf(ss + 1e-12f))); }
        st4bf(V + (size_t)r * 256 + c4, o[2]); if (l == 0) st4bf(VF + (size_t)r * 256 + c4, o[2]);
        st4bf(pr + PC_Z + c4, o[3]);
        { f32x4 q = bf4(rswq); if (!isctx) q = rope2v(q, cs64); st4bf(pr + PC_SWQ + c4, q * QS64);
          if (lane < 32 && !isctx) st4bf(pr + PC_SWK + c4, rope2v(bf4(rswk), cs64)); }
        { f32x4 q = bf4(rcq); const float ss = wave_sum((q[0] * q[0] + q[1] * q[1]) + (q[2] * q[2] + q[3] * q[3]));
          st4bf(pr + PC_CQ + c4, q * (1.0f / sqrtf(ss * (1.0f / 256.0f) + 1e-6f)) * mqn);
          f32x4 kv = bf4(rckv); const float s2 = wave_sum((kv[0] * kv[0] + kv[1] * kv[1]) + (kv[2] * kv[2] + kv[3] * kv[3]));
          if (lane < 32) st4bf(pr + PC_CKV + c4, kv * (1.0f / sqrtf(s2 * (1.0f / 128.0f) + 1e-6f)) * mkvn);
          if (lane < 8) { f32x4 kr = bf4(rkr); if (!isctx) kr = rope2v(kr, cs32);
#pragma unroll
              for (int h = 0; h < 4; ++h) st4bf(Km + (size_t)r * 384 + h * 96 + 64 + c4, kr); } }
        { f32x4 q = bf4(rgaq); const float ss = sum16((q[0] * q[0] + q[1] * q[1]) + (q[2] * q[2] + q[3] * q[3]));
          q = q * (1.0f / sqrtf(ss * (1.0f / 64.0f) + 1e-6f)) * gq; if (!isctx) q = rope2v(q, cs64); st4bf(pr + PC_GAQ + c4, q * QS64);
          f32x4 k = bf4(rgak); const float s2 = sum16((k[0] * k[0] + k[1] * k[1]) + (k[2] * k[2] + k[3] * k[3]));
          if (lane < 32) { k = k * (1.0f / sqrtf(s2 * (1.0f / 64.0f) + 1e-6f)) * gk; if (!isctx) k = rope2v(k, cs64); st4bf(pr + PC_GAK + c4, k); } }
    }
}

#undef PREP_LOAD
template <int PARTS>
DI void finish_rows(Frame& F, int l, int r0, int r1, int stride8) {
    const int gw = stride8 ? r0 + F.wave : F.vcu * 8 + F.wave, NGW = stride8 ? 8 : F.G * 8, lane = F.lane, c4 = 4 * lane, hd = lane >> 4;
    const bf16_t* RR = (const bf16_t*)(F.ws + WS_RR); const bf16_t* KD = (const bf16_t*)(F.ws + WS_KD); const bf16_t* V = (const bf16_t*)(F.ws + WS_V); const bf16_t* Gg = (const bf16_t*)(F.ws + WS_G);
    const float* Y0 = (const float*)(F.ws + WS_YDIR); const float* Y1 = Y0 + (size_t)NROW * 256;
    const float* OP = (const float*)(F.ws + WS_OPART); const float* ML = (const float*)(F.ws + WS_ML);
    bf16_t* YA = (bf16_t*)(F.ws + WS_YALL);
    const f32x4 rk = *(const GAS f32x4*)(inp(I_RK) + l * 256 + c4), lw = *(const GAS f32x4*)(inp(I_LNW) + l * 256 + c4), lb = *(const GAS f32x4*)(inp(I_LNB) + l * 256 + c4);
    for (int r = gw; r < r1; r += NGW) {
        if (PARTS & 1) {
            const f32x4 y = *(const GAS f32x4*)(Y0 + (size_t)r * 256 + c4) + *(const GAS f32x4*)(Y1 + (size_t)r * 256 + c4);
            const float mean = sum16((y[0] + y[1]) + (y[2] + y[3])) * (1.0f / 64.0f);
            const f32x4 d = y - mean;
            const float var = sum16((d[0] * d[0] + d[1] * d[1]) + (d[2] * d[2] + d[3] * d[3])) * (1.0f / 64.0f);
            const f32x4 yn = d * (1.0f / sqrtf(var + 64e-5f)) * lw + lb;
            const f32x4 rr = ld4bf(RR + (size_t)r * 256 + c4), k0 = ld4bf(KD + (size_t)r * 512 + c4), k1 = ld4bf(KD + (size_t)r * 512 + 256 + c4), v = ld4bf(V + (size_t)r * 256 + c4), g = ld4bf(Gg + (size_t)r * 256 + c4);
            const f32x4 pr = rr * (k0 + k1) * rk;
            const float bon = sum16((pr[0] + pr[1]) + (pr[2] + pr[3]));
            st4bf(YA + (size_t)r * 1024 + c4, (yn + bon * v) * g);
        }
        if (PARTS & 2)
#pragma unroll
        for (int kind = 0; kind < 2; ++kind) {
            const float* m0p = ML + (((size_t)(kind * NSPLIT + 0) * NROW + r) * 4 + hd) * 2; const float* m1p = ML + (((size_t)(kind * NSPLIT + 1) * NROW + r) * 4 + hd) * 2;
            const float m0 = m0p[0], l0 = m0p[1], m1 = m1p[0], l1 = m1p[1];
            const float mm = m0 > m1 ? m0 : m1; const float w0 = fast_exp2(m0 - mm), w1 = fast_exp2(m1 - mm);
            const f32x4 o0 = *(const GAS f32x4*)(OP + ((size_t)(kind * NSPLIT + 0) * NROW + r) * 256 + c4), o1 = *(const GAS f32x4*)(OP + ((size_t)(kind * NSPLIT + 1) * NROW + r) * 256 + c4);
            const float inv = 1.0f / (w0 * l0 + w1 * l1);
            st4bf(YA + (size_t)r * 1024 + 512 + kind * 256 + c4, (o0 * w0 + o1 * w1) * inv);
        }
    }
}
#ifdef MIX_MERGE
DI void finish_phase(Frame& F, int l) { finish_rows<1>(F, l, 0, NROW, 0); }
#else
DI void finish_phase(Frame& F, int l) { finish_rows<3>(F, l, 0, NROW, 0); }
#endif
typedef short v4i16_t __attribute__((ext_vector_type(4)));
DI s16x4 vtr(const LAS unsigned char* p) { return __builtin_bit_cast(s16x4, __builtin_amdgcn_ds_read_tr16_b64_v4i16((LAS v4i16_t*)p)); }
DI int crow(int r, int hi) { return (r & 3) + 8 * (r >> 2) + 4 * hi; }

struct AttnArgs {
    const bf16_t* Q; int qpitch;
    const bf16_t* K; int kpitch;
    const bf16_t* V; int vpitch;
    int ka0, ka1, kb0, kb1;
    int window;
    int qlat0;
    int use_sink; float sink_l2;
    int out_mode;
    bf16_t* obf; float* opf; float* mlp;
    int empty_part; float* opf2; float* mlp2;
};

template <int DQK>
DI void attn_unit(Frame& F, const AttnArgs& A) {
    constexpr int NCH = DQK / 8, KB = NCH * 1024, BUF = KB + 8192, ND = DQK / 16;
    const int tid = F.tid, lane = F.lane, wid = F.wave, r32 = lane & 31, hi = lane >> 5;
    LAS unsigned char* lds = F.lds;
    bf16x8 qr[ND];
    { const bf16_t* qp = A.Q + (size_t)(wid * 32 + r32) * A.qpitch + 8 * hi;
#pragma unroll
      for (int d0 = 0; d0 < ND; ++d0) qr[d0] = *(const GAS bf16x8*)(qp + 16 * d0); }
    const int na = (A.ka1 - A.ka0) >> 6, nb = (A.kb1 - A.kb0) >> 6, nt = na + nb;
    const bf16_t* ksrc = A.K + (size_t)lane * A.kpitch + wid * 8;
    const bf16_t* ksrc2 = A.K + (size_t)lane * A.kpitch + (8 + wid) * 8;
    const bf16_t* vsrc = A.V + (size_t)(16 * (wid & 3) + (lane >> 2)) * A.vpitch + (wid >> 2) * 32 + (lane & 3) * 8;
#define ATT_DMA(t) do { const int kr_ = (t) < na ? A.ka0 + 64 * (t) : A.kb0 + 64 * ((t) - na); LAS unsigned char* bb_ = lds + ((t) & 1) * BUF; \
        __builtin_amdgcn_global_load_lds((const unsigned*)(ksrc + (size_t)kr_ * A.kpitch), (LAS unsigned*)(bb_ + wid * 1024), 16, 0, 0); \
        if (DQK == 96 && wid < 4) __builtin_amdgcn_global_load_lds((const unsigned*)(ksrc2 + (size_t)kr_ * A.kpitch), (LAS unsigned*)(bb_ + (8 + wid) * 1024), 16, 0, 0); \
        __builtin_amdgcn_global_load_lds((const unsigned*)(vsrc + (size_t)kr_ * A.vpitch), (LAS unsigned*)(bb_ + KB + wid * 1024), 16, 0, 0); } while (0)
    constexpr float THR = 8.0f;
    float m_ref = 0.f, l_run = 0.f;
    f32x16 o0, o1, negm;
#pragma unroll
    for (int i = 0; i < 16; ++i) { o0[i] = 0.f; o1[i] = 0.f; negm[i] = 0.f; }
    const int qw0 = A.qlat0 + wid * 32;
    bool first = true;
    if (nt > 0) ATT_DMA(0);
    for (int t = 0; t < nt; ++t) {
        asm volatile("s_waitcnt vmcnt(0)" ::: "memory");
        __syncthreads();
        if (t + 1 < nt) ATT_DMA(t + 1);
        const int keyrow = t < na ? A.ka0 + 64 * t : A.kb0 + 64 * (t - na);
        const bool banded = A.window && t >= na;
        const int kj0 = keyrow - CTXL;
        if (banded && (kj0 + 63 < qw0 - 128 || kj0 > qw0 + 31 + 128)) continue;
        const LAS unsigned char* kb = lds + (t & 1) * BUF;
        const LAS unsigned char* vb = kb + KB;
        f32x16 p0 = negm, p1 = negm;
        const LAS unsigned char* kf = kb + hi * 1024 + r32 * 16;
        bf16x8 ka[2 * ND];
#pragma unroll
        for (int d0 = 0; d0 < ND; ++d0) { ka[2 * d0] = *(const LAS bf16x8*)(kf + d0 * 2048); ka[2 * d0 + 1] = *(const LAS bf16x8*)(kf + d0 * 2048 + 512); }
        __builtin_amdgcn_sched_barrier(0);
#pragma unroll
        for (int d0 = 0; d0 < ND; ++d0) {
            p0 = __builtin_amdgcn_mfma_f32_32x32x16_bf16(ka[2 * d0], qr[d0], p0, 0, 0, 0);
            p1 = __builtin_amdgcn_mfma_f32_32x32x16_bf16(ka[2 * d0 + 1], qr[d0], p1, 0, 0, 0);
        }
        const LAS unsigned char* vp = vb + ((lane >> 4) & 1) * 32 + (lane & 3) * 8 + (4 * hi + ((lane & 15) >> 2)) * 64;
        s16x4 vl0[4], vh0[4], vl1[4], vh1[4];
        { const unsigned va_ = (unsigned)(unsigned long)vp;
#define VTR_ASM(dst, off) asm volatile("ds_read_b64_tr_b16 %0, %1 offset:%2" : "=v"(dst) : "v"(va_), "n"(off) : "memory")
#pragma unroll
          for (int ks = 0; ks < 4; ++ks) { VTR_ASM(vl0[ks], ks * 1024); VTR_ASM(vh0[ks], ks * 1024 + 512); VTR_ASM(vl1[ks], 4096 + ks * 1024); VTR_ASM(vh1[ks], 4096 + ks * 1024 + 512); }
#undef VTR_ASM
        }
        if (banded) {
            const int qi = qw0 + r32;
#pragma unroll
            for (int i = 0; i < 16; ++i) { const int kj = kj0 + crow(i, hi); const int d0_ = qi - kj, d1_ = qi - (kj + 32);
                if (d0_ > 128 || d0_ < -128) p0[i] = -INFINITY; if (d1_ > 128 || d1_ < -128) p1[i] = -INFINITY; }
        }
        float mx = __builtin_fmaxf(__builtin_fmaxf(p0[0], p0[1]), p1[0]);
#pragma unroll
        for (int i = 2; i < 16; i += 2) mx = __builtin_fmaxf(__builtin_fmaxf(mx, p0[i]), p0[i + 1]);
#pragma unroll
        for (int i = 1; i < 15; i += 2) mx = __builtin_fmaxf(__builtin_fmaxf(mx, p1[i]), p1[i + 1]);
        mx = __builtin_fmaxf(mx, p1[15]);
        { auto rr = __builtin_amdgcn_permlane32_swap(__float_as_uint(mx), __float_as_uint(mx), false, false); mx = __builtin_fmaxf(__uint_as_float(rr[0]), __uint_as_float(rr[1])); }
        if (first || __any(mx > THR)) {
            const float dl = first ? mx : __builtin_fmaxf(mx, 0.f);
            first = false;
            m_ref += dl;
            const float f = fast_exp2(-dl);
            l_run *= f;
#pragma unroll
            for (int i = 0; i < 16; ++i) { p0[i] -= dl; p1[i] -= dl; o0[i] *= f; o1[i] *= f; negm[i] = -m_ref; }
        }
        float ps = 0.f;
#pragma unroll
        for (int i = 0; i < 16; ++i) { p0[i] = fast_exp2(p0[i]); p1[i] = fast_exp2(p1[i]); ps += p0[i] + p1[i]; }
        l_run += ps;
        bf16x8 pb[4];
#pragma unroll
        for (int s = 0; s < 2; ++s) {
            u32x4 w0, w1;
            w0.x = cvt_pk_bf16(p0[8 * s + 0], p0[8 * s + 1]); w0.y = cvt_pk_bf16(p0[8 * s + 2], p0[8 * s + 3]); w0.z = cvt_pk_bf16(p0[8 * s + 4], p0[8 * s + 5]); w0.w = cvt_pk_bf16(p0[8 * s + 6], p0[8 * s + 7]);
            w1.x = cvt_pk_bf16(p1[8 * s + 0], p1[8 * s + 1]); w1.y = cvt_pk_bf16(p1[8 * s + 2], p1[8 * s + 3]); w1.z = cvt_pk_bf16(p1[8 * s + 4], p1[8 * s + 5]); w1.w = cvt_pk_bf16(p1[8 * s + 6], p1[8 * s + 7]);
            pb[s] = __builtin_bit_cast(bf16x8, w0); pb[2 + s] = __builtin_bit_cast(bf16x8, w1);
        }
        asm volatile("s_waitcnt lgkmcnt(0)" : "+v"(vl0[0]), "+v"(vl0[1]), "+v"(vl0[2]), "+v"(vl0[3]), "+v"(vh0[0]), "+v"(vh0[1]), "+v"(vh0[2]), "+v"(vh0[3]),
                                              "+v"(vl1[0]), "+v"(vl1[1]), "+v"(vl1[2]), "+v"(vl1[3]), "+v"(vh1[0]), "+v"(vh1[1]), "+v"(vh1[2]), "+v"(vh1[3]) :: "memory");
#pragma unroll
        for (int ks = 0; ks < 4; ++ks) {
            const s16x4 l0 = vl0[ks], h0 = vh0[ks], l1 = vl1[ks], h1 = vh1[ks];
            const bf16x8 va = (bf16x8){l0[0], l0[1], l0[2], l0[3], h0[0], h0[1], h0[2], h0[3]}, vb2 = (bf16x8){l1[0], l1[1], l1[2], l1[3], h1[0], h1[1], h1[2], h1[3]};
            o0 = __builtin_amdgcn_mfma_f32_32x32x16_bf16(va, pb[ks], o0, 0, 0, 0);
            o1 = __builtin_amdgcn_mfma_f32_32x32x16_bf16(vb2, pb[ks], o1, 0, 0, 0);
        }
    }
    const float m_run = m_ref;
#undef ATT_DMA
    float l_tot; { auto rr = __builtin_amdgcn_permlane32_swap(__float_as_uint(l_run), __float_as_uint(l_run), false, false); l_tot = __uint_as_float(rr[0]) + __uint_as_float(rr[1]); }
    if (A.use_sink) l_tot += fast_exp2(A.sink_l2 - m_run);
    const int qrow = wid * 32 + r32;
    if (A.out_mode == 0) {
        const float inv = 1.0f / l_tot;
        bf16_t* op = A.obf + (size_t)qrow * 1024 + 4 * hi;
#pragma unroll
        for (int g = 0; g < 4; ++g) {
            u32x2 w; w.x = cvt_pk_bf16(o0[4 * g] * inv, o0[4 * g + 1] * inv); w.y = cvt_pk_bf16(o0[4 * g + 2] * inv, o0[4 * g + 3] * inv); *(GAS u32x2*)(op + 8 * g) = w;
            u32x2 w2; w2.x = cvt_pk_bf16(o1[4 * g] * inv, o1[4 * g + 1] * inv); w2.y = cvt_pk_bf16(o1[4 * g + 2] * inv, o1[4 * g + 3] * inv); *(GAS u32x2*)(op + 32 + 8 * g) = w2;
        }
    } else {
        float* op = A.opf + (size_t)qrow * 256 + 4 * hi;
#pragma unroll
        for (int g = 0; g < 4; ++g) {
            *(GAS f32x4*)(op + 8 * g) = (f32x4){o0[4 * g], o0[4 * g + 1], o0[4 * g + 2], o0[4 * g + 3]};
            *(GAS f32x4*)(op + 32 + 8 * g) = (f32x4){o1[4 * g], o1[4 * g + 1], o1[4 * g + 2], o1[4 * g + 3]};
        }
        if (hi == 0) { GAS float* mp = (GAS float*)(A.mlp + (size_t)qrow * 8); mp[0] = m_run; mp[1] = l_tot; }
        if (A.empty_part) {
            float* op2 = A.opf2 + (size_t)qrow * 256 + 4 * hi;
#pragma unroll
            for (int g = 0; g < 4; ++g) { *(GAS f32x4*)(op2 + 8 * g) = (f32x4){0.f, 0.f, 0.f, 0.f}; *(GAS f32x4*)(op2 + 32 + 8 * g) = (f32x4){0.f, 0.f, 0.f, 0.f}; }
            if (hi == 0) { GAS float* mp = (GAS float*)(A.mlp2 + (size_t)qrow * 8); float neg = -1.0e30f, zer = 0.f; asm volatile("" : "+v"(neg), "+v"(zer)); mp[0] = neg; mp[1] = zer; }
        }
    }
    __syncthreads();
}

constexpr int ATT_NUNITS = 1304;
DI void attn_run_unit(Frame& F, int l, int idx) {
    AttnArgs A;
    const bf16_t* P = FP(F); bf16_t* YA = (bf16_t*)(F.ws + WS_YALL);
    float* OP = (float*)(F.ws + WS_OPART); float* ML = (float*)(F.ws + WS_ML);
    A.window = 0; A.qlat0 = 0; A.use_sink = 0; A.sink_l2 = 0.f; A.empty_part = 0; A.opf2 = nullptr; A.mlp2 = nullptr; A.obf = nullptr; A.opf = nullptr; A.mlp = nullptr;
    A.kb0 = 0; A.kb1 = 0;
    if (idx < 1024) {
        const int kind = idx >> 9, i = idx & 511, split = i & 1, qb = (i >> 1) & 31, h = (i >> 6) & 3, b = i >> 8;
        const size_t row0 = (size_t)b * TPB + CTXL + qb * 256, brow = (size_t)b * TPB;
        A.ka0 = split * (TPB / 2); A.ka1 = A.ka0 + TPB / 2;
        A.out_mode = 1; A.opf = OP + ((size_t)(kind * NSPLIT + split) * NROW + row0) * 256 + h * 64; A.mlp = ML + (((size_t)(kind * NSPLIT + split) * NROW + row0) * 4 + h) * 2;
        if (kind == 0) {
            const bf16_t* Qm = (const bf16_t*)(F.ws + WS_QMLA); const bf16_t* Km = (const bf16_t*)(F.ws + WS_KMLA); const bf16_t* Vm = (const bf16_t*)(F.ws + WS_VMLA);
            A.Q = Qm + row0 * 384 + h * 96; A.qpitch = 384; A.K = Km + brow * 384 + h * 96; A.kpitch = 384; A.V = Vm + brow * 256 + h * 64; A.vpitch = 256;
            attn_unit<96>(F, A);
        } else {
            A.Q = P + row0 * LDP + PC_GAQ + h * 64; A.qpitch = LDP; A.K = P + brow * LDP + PC_GAK + (h >> 1) * 64; A.kpitch = LDP; A.V = P + brow * LDP + PC_GAV + (h >> 1) * 64; A.vpitch = LDP;
            attn_unit<64>(F, A);
        }
    } else if (idx < 1280) {
        const int i = idx - 1024, qb = i & 31, h = (i >> 5) & 3, b = i >> 7;
        const size_t row0 = (size_t)b * TPB + CTXL + qb * 256, brow = (size_t)b * TPB;
        const int q0 = qb * 256; int lo = q0 - 128; if (lo < 0) lo = 0; int hi_ = q0 + 256 + 128; if (hi_ > SEQ) hi_ = SEQ;
        A.ka0 = 0; A.ka1 = CTXL; A.kb0 = CTXL + lo; A.kb1 = CTXL + hi_; A.window = 1; A.qlat0 = q0;
        A.use_sink = 1; A.sink_l2 = inp(I_SINK)[l * 4 + h] * LOG2E;
        A.Q = P + row0 * LDP + PC_SWQ + h * 64; A.qpitch = LDP; A.K = P + brow * LDP + PC_SWK + (h >> 1) * 64; A.kpitch = LDP; A.V = P + brow * LDP + PC_SWV + (h >> 1) * 64; A.vpitch = LDP;
        A.out_mode = 0; A.obf = YA + row0 * 1024 + 256 + h * 64;
        attn_unit<64>(F, A);
    } else {
        const int i = idx - 1280, ck = i >> 3, b = (i >> 2) & 1, h = i & 3;
        const size_t row0 = (size_t)b * TPB, brow = row0;
        A.ka0 = 0; A.ka1 = CTXL;
        if (ck == 0) {
            const bf16_t* Qm = (const bf16_t*)(F.ws + WS_QMLA); const bf16_t* Km = (const bf16_t*)(F.ws + WS_KMLA); const bf16_t* Vm = (const bf16_t*)(F.ws + WS_VMLA);
            A.Q = Qm + row0 * 384 + h * 96; A.qpitch = 384; A.K = Km + brow * 384 + h * 96; A.kpitch = 384; A.V = Vm + brow * 256 + h * 64; A.vpitch = 256;
            A.out_mode = 1; A.opf = OP + ((size_t)(0 * NSPLIT + 0) * NROW + row0) * 256 + h * 64; A.mlp = ML + (((size_t)(0 * NSPLIT + 0) * NROW + row0) * 4 + h) * 2;
            A.empty_part = 1; A.opf2 = OP + ((size_t)(0 * NSPLIT + 1) * NROW + row0) * 256 + h * 64; A.mlp2 = ML + (((size_t)(0 * NSPLIT + 1) * NROW + row0) * 4 + h) * 2;
            attn_unit<96>(F, A);
        } else if (ck == 1) {
            A.Q = P + row0 * LDP + PC_GAQ + h * 64; A.qpitch = LDP; A.K = P + brow * LDP + PC_GAK + (h >> 1) * 64; A.kpitch = LDP; A.V = P + brow * LDP + PC_GAV + (h >> 1) * 64; A.vpitch = LDP;
            A.out_mode = 1; A.opf = OP + ((size_t)(1 * NSPLIT + 0) * NROW + row0) * 256 + h * 64; A.mlp = ML + (((size_t)(1 * NSPLIT + 0) * NROW + row0) * 4 + h) * 2;
            A.empty_part = 1; A.opf2 = OP + ((size_t)(1 * NSPLIT + 1) * NROW + row0) * 256 + h * 64; A.mlp2 = ML + (((size_t)(1 * NSPLIT + 1) * NROW + row0) * 4 + h) * 2;
            attn_unit<64>(F, A);
        } else {
            A.use_sink = 1; A.sink_l2 = inp(I_SINK)[l * 4 + h] * LOG2E;
            A.Q = P + row0 * LDP + PC_SWQ + h * 64; A.qpitch = LDP; A.K = P + brow * LDP + PC_SWK + (h >> 1) * 64; A.kpitch = LDP; A.V = P + brow * LDP + PC_SWV + (h >> 1) * 64; A.vpitch = LDP;
            A.out_mode = 0; A.obf = YA + row0 * 1024 + 256 + h * 64;
            attn_unit<64>(F, A);
        }
    }
}

constexpr int SC_CH = 32, SC_STEP = 1536, SC_BUF = SC_CH * SC_STEP;
DI int scan_row(int b, int d, int n) { return b * TPB + (d == 0 ? n : (n < CTXL ? CTXL - 1 - n : TPB + CTXL - 1 - n)); }

struct ScanRegs { f32x4 w[2]; u32x2 b[5][2]; };
DI void scan_load(const Frame& F, int b, int d, int h, int chunk, int lt, ScanRegs& R) {
    const float* W = (const float*)(F.ws + WS_W); const bf16_t* KD = (const bf16_t*)(F.ws + WS_KD); const bf16_t* BB = (const bf16_t*)(F.ws + WS_BB);
    const bf16_t* KK = (const bf16_t*)(F.ws + WS_KK); const bf16_t* RR = (const bf16_t*)(F.ws + WS_RR); const bf16_t* V = (const bf16_t*)(F.ws + WS_V);
    const int piece = lt & 15;
#pragma unroll
    for (int half = 0; half < 2; ++half) {
        const int row = scan_row(b, d, chunk * SC_CH + half * 16 + (lt >> 4));
        const size_t o512 = (size_t)row * 512 + d * 256 + h * 64 + 4 * piece, o256 = (size_t)row * 256 + h * 64 + 4 * piece;
        R.w[half] = *(const GAS f32x4*)(W + o512);
        R.b[0][half] = *(const GAS u32x2*)(KD + o512); R.b[1][half] = *(const GAS u32x2*)(BB + o512);
        R.b[2][half] = *(const GAS u32x2*)(KK + o256); R.b[3][half] = *(const GAS u32x2*)(RR + o256); R.b[4][half] = *(const GAS u32x2*)(V + o256);
    }
}
DI void scan_store(const Frame& F, int chunk, int lt, const ScanRegs& R) {
    LAS unsigned char* buf = F.lds + (chunk & 1) * SC_BUF;
    const int piece = lt & 15;
#pragma unroll
    for (int half = 0; half < 2; ++half) {
        LAS unsigned char* sp = buf + (half * 16 + (lt >> 4)) * SC_STEP + piece * 16;
        *(LAS f32x4*)sp = R.w[half];
#pragma unroll
        for (int v = 0; v < 5; ++v) { const u32x2 w = R.b[v][half]; *(LAS f32x4*)(sp + (v + 1) * 256) = (f32x4){bflo(w.x), bfhi(w.x), bflo(w.y), bfhi(w.y)}; }
    }
}
constexpr int SCAN_NWG = 64;
template <int VAR>
DI void scan_phase(Frame& F, int sw) {
    const int chain = sw >> 2, quarter = sw & 3, b = chain >> 3, d = (chain >> 2) & 1, h = chain & 3;
    const int lane = F.lane, wid = F.wave, g = lane >> 4, kq = lane & 15;
    const int vrow = quarter * 16 + (wid & 3) * 4 + g;
    float* Y = (float*)(F.ws + WS_YDIR) + (size_t)d * NROW * 256;
    constexpr int NCHUNK = TPB / SC_CH;
    f32x2 S01 = (f32x2){0.f, 0.f}, S23 = (f32x2){0.f, 0.f};
    ScanRegs R;
    const int lt = F.tid - 256;
    if (wid >= 4) { scan_load(F, b, d, h, 0, lt, R); scan_store(F, 0, lt, R); scan_load(F, b, d, h, 1, lt, R); }
    __syncthreads();
    for (int c = 0; c < NCHUNK; ++c) {
        if (wid >= 4) {
            if (c + 1 < NCHUNK) scan_store(F, c + 1, lt, R);
            if (c + 2 < NCHUNK) scan_load(F, b, d, h, c + 2, lt, R);
        } else {
            const LAS unsigned char* buf = F.lds + (c & 1) * SC_BUF + kq * 16;
            const LAS unsigned char* vbuf = F.lds + (c & 1) * SC_BUF + 1280 + vrow * 4;
            f32x4 w4 = *(const LAS f32x4*)(buf), kd4 = *(const LAS f32x4*)(buf + 256), bb4 = *(const LAS f32x4*)(buf + 512), kk4 = *(const LAS f32x4*)(buf + 768), r4 = *(const LAS f32x4*)(buf + 1024);
            float vv = *(const LAS float*)(vbuf);
#pragma unroll
            for (int half = 0; half < 2; ++half) {
                float yp[16];
#pragma unroll
                for (int s16 = 0; s16 < 16; ++s16) {
                    const int sn = half * 16 + s16 + 1 < SC_CH ? half * 16 + s16 + 1 : SC_CH - 1;
                    const LAS unsigned char* sp = buf + sn * SC_STEP;
                    const f32x4 w4n = *(const LAS f32x4*)(sp), kd4n = *(const LAS f32x4*)(sp + 256), bb4n = *(const LAS f32x4*)(sp + 512), kk4n = *(const LAS f32x4*)(sp + 768), r4n = *(const LAS f32x4*)(sp + 1024);
                    const float vvn = *(const LAS float*)(vbuf + sn * SC_STEP);
                    const f32x2 k01 = __builtin_shufflevector(kk4, kk4, 0, 1), k23 = __builtin_shufflevector(kk4, kk4, 2, 3);
                    f32x2 t2 = S01 * k01; t2 = S23 * k23 + t2;
                    const float sa = (VAR & 2) ? -(t2[0] + t2[1]) : -rsum16(t2[0] + t2[1]);
                    const f32x2 w01 = __builtin_shufflevector(w4, w4, 0, 1), w23 = __builtin_shufflevector(w4, w4, 2, 3);
                    const f32x2 d01 = __builtin_shufflevector(kd4, kd4, 0, 1), d23 = __builtin_shufflevector(kd4, kd4, 2, 3);
                    const f32x2 b01 = __builtin_shufflevector(bb4, bb4, 0, 1), b23 = __builtin_shufflevector(bb4, bb4, 2, 3);
                    S01 = b01 * sa + (d01 * vv + S01 * w01); S23 = b23 * sa + (d23 * vv + S23 * w23);
                    const f32x2 r01 = __builtin_shufflevector(r4, r4, 0, 1), r23 = __builtin_shufflevector(r4, r4, 2, 3);
                    f32x2 u2 = S01 * r01; u2 = S23 * r23 + u2;
                    yp[s16] = (VAR & 4) ? 0.f : (u2[0] + u2[1]);
                    w4 = w4n; kd4 = kd4n; bb4 = bb4n; kk4 = kk4n; r4 = r4n; vv = vvn;
                }
                float ykeep;
                {
#define DPPMOV(x, ctrl) __builtin_bit_cast(float, __builtin_amdgcn_update_dpp(0, __builtin_bit_cast(int, (x)), (ctrl), 0xf, 0xf, false))
                    const bool b3 = (kq & 8) != 0, b2 = (kq & 4) != 0, b1 = (kq & 2) != 0, b0 = (kq & 1) != 0;
#pragma unroll
                    for (int q = 0; q < 8; ++q) { const float keep = b3 ? yp[q + 8] : yp[q], send = b3 ? yp[q] : yp[q + 8]; yp[q] = keep + DPPMOV(send, 0x128); }
#pragma unroll
                    for (int q = 0; q < 4; ++q) { const float keep = b2 ? yp[q + 4] : yp[q], send = b2 ? yp[q] : yp[q + 4]; yp[q] = keep + DPPMOV(send, 0x141); }
#pragma unroll
                    for (int q = 0; q < 2; ++q) { const float keep = b1 ? yp[q + 2] : yp[q], send = b1 ? yp[q] : yp[q + 2]; yp[q] = keep + DPPMOV(send, 0x4E); }
                    { const float keep = b0 ? yp[1] : yp[0], send = b0 ? yp[0] : yp[1]; ykeep = keep + DPPMOV(send, 0xB1); }
#undef DPPMOV
                }
                const int n = c * SC_CH + half * 16 + kq;
                if (VAR == 0) *(GAS float*)(Y + (size_t)scan_row(b, d, n) * 256 + h * 64 + vrow) = ykeep; else asm volatile("" :: "v"(ykeep));
            }
        }
        asm volatile("s_waitcnt lgkmcnt(0)" ::: "memory"); __builtin_amdgcn_s_barrier(); asm volatile("" ::: "memory");
    }
    __syncthreads();
}
constexpr int NPH_LAYER = 13, NPHASE = 1 + NPH_LAYER * DEPTH + 1;
struct Args { const float* in[43]; float* out; unsigned char* ws; int ph_lo, ph_hi; };
DI void wg_sync() { __syncthreads(); }
#ifdef MIX_MERGE
DI void mix_wait(unsigned* p, unsigned n) {
    if (threadIdx.x == 0) { unsigned sp = 0; while (xb_ld(p) < n) { __builtin_amdgcn_s_sleep(4); if (++sp > (1u << 22)) break; }
        __builtin_amdgcn_fence(__ATOMIC_ACQUIRE, "agent"); asm volatile("s_waitcnt vmcnt(0)" ::: "memory"); }
    wg_sync();
}
DI void mix_publish(unsigned* p, unsigned n) {
    asm volatile("s_waitcnt vmcnt(0)" ::: "memory"); wg_sync();
    if (threadIdx.x == 0) { __builtin_amdgcn_fence(__ATOMIC_RELEASE, "agent"); asm volatile("s_waitcnt vmcnt(0)" ::: "memory"); (void)xb_add(p, n); }
}
DI void mix_merge_tail(const Frame& F0, int l) {
    constexpr int NFCH = NROW / 64;
    {
        Frame Q = relane(F0);
        unsigned* sy = Q.ctl + CW_SYNC + l * 256;
        mix_wait(sy, (unsigned)ATT_NUNITS);
#ifdef PROBE_SEL
        if (blockIdx.x == 255 && threadIdx.x == 0) ((unsigned long long*)(F0.ws + 7 * MiB))[128 + l] = __builtin_amdgcn_s_memrealtime();
#endif
        int nch = 0;
        for (;;) {
            if (Q.tid == 0) Q.MISC[16] = xb_add(sy + 64, 1u);
            wg_sync();
            const int ch = (int)Q.MISC[16];
            wg_sync();
            if (ch >= NFCH) break;
            finish_rows<2>(Q, l, ch * 64, ch * 64 + 64, 1); ++nch;
        }
        if (nch > 0) mix_publish(sy + 128, (unsigned)nch);
        mix_wait(sy + 128, (unsigned)NFCH);
#ifdef PROBE_SEL
        if (blockIdx.x == 255 && threadIdx.x == 0) ((unsigned long long*)(F0.ws + 7 * MiB))[136 + l] = __builtin_amdgcn_s_memrealtime();
#endif
    }
    for (;;) {
        Frame Q = relane(F0);
        int ll = l; asm volatile("" : "+s"(ll));
        if (Q.tid == 0) Q.MISC[16] = xb_add(Q.ctl + CW_SYNC + ll * 256 + 192, 1u);
        wg_sync();
        const int it = (int)Q.MISC[16];
        wg_sync();
        const int lat = (ll == DEPTH - 1);
        if (it >= 3 * (lat ? 256 : 264)) break;
        const int ti = it / 3, br = 1 + it % 3;
        unsigned char* wl = Q.ws + ((ll & 1) ? WS_WL : WS_WLB);
        pg8::Gemm g{(const char*)(Q.ws + WS_YALL), (const char*)(wl + WL_WBR), 1024, 256, 256};
        SchedMerge S{Q.G, ti, lat, br, 1, 1};
        bf16_t* dst = (bf16_t*)(Q.ws + (br == 1 ? WS_HB : WS_OPART)) + (size_t)(br == 3 ? 1 : 0) * NROW * 1024;
        EpiMergeP E{FP(Q), dst};
        pg8::gemm_phase(Q.lds, g, S, E, Q.wave);
    }
}
#endif
template <int NS>
DI void ctx_splitk_tail(const Frame& F0, int l, const char* A, const char* Bt, int ld, int which, int cw) {
    Frame Q = relane(F0);
    const int kc = ld / NS;
    pg8::Gemm g2{A, Bt, ld, ld, kc};
    SchedCtxK S2{Q.G, Q.bx, NS, kc, ld, ld}; EpiSlab E2{(float*)(Q.ws + WS_SLAB)};
    pg8::gemm_phase(Q.lds, g2, S2, E2, Q.wave);
    Q = relane(F0);
    const int sl = Q.bx % NS, t = Q.bx / NS, pn = t & 3, pm = (t >> 2) ? 33 : 0;
    unsigned* cnt = Q.ctl + CW_SLABCNT + l * 64 + cw + t;
    mix_publish(cnt, 1u);
    mix_wait(cnt, (unsigned)NS);
    constexpr int RPS = (256 + NS - 1) / NS;
    const int r0 = sl * RPS, r1 = r0 + RPS < 256 ? r0 + RPS : 256;
    const float* slab = (const float*)(Q.ws + WS_SLAB);
    const float* gv = FMOD(Q) + (size_t)l * 3 * 6144 + ((size_t)2 * 6 + which) * 1024 + pn * 256 + 4 * (Q.tid & 63);
    const f32x4 gg = *(const GAS f32x4*)gv;
    for (int r = r0 + (Q.tid >> 6); r < r1; r += 8) {
        const size_t so = ((size_t)((pm == 33 ? 256 : 0) + r)) * 1024 + pn * 256 + 4 * (Q.tid & 63);
        f32x4 a = *(const GAS f32x4*)(slab + so);
#pragma unroll
        for (int q = 1; q < NS; ++q) a = a + *(const GAS f32x4*)(slab + (size_t)q * 512 * 1024 + so);
        float* xp = FX(Q) + ((size_t)pm * 256 + r) * 1024 + pn * 256 + 4 * (Q.tid & 63);
        *(GAS f32x4*)xp = *(const GAS f32x4*)xp + gg * a;
    }
}
#ifdef NOPK
#define KATTR __attribute__((target("no-packed-fp32-ops")))
#else
#define KATTR
#endif
__global__ void __launch_bounds__(512, 2) KATTR hfb_fwd(Args args) {
    extern __shared__ __attribute__((aligned(16))) unsigned char lds_raw[];
    Frame F;
    F.lds = (LAS unsigned char*)lds_raw;
    F.MISC = (volatile LAS unsigned*)(F.lds + MISC_OFF);
    F.tid = threadIdx.x; F.lane = F.tid & 63; F.wave = __builtin_amdgcn_readfirstlane(F.tid >> 6);
    F.bx = blockIdx.x; F.G = gridDim.x; { const int bx = blockIdx.x; F.vcu = (F.G % 8 == 0) ? (bx % 8) * (F.G / 8) + bx / 8 : bx; }
    F.ws = args.ws; F.ctl = (unsigned*)(args.ws + WS_CTL); F.out = args.out;
    for (int u = F.tid; u < (LDS_BYTES - MISC_OFF) / 4; u += 512) ((LAS unsigned*)(F.lds + MISC_OFF))[u] = 0u;
    wg_sync();
    const int lo = args.ph_lo, hi = args.ph_hi;
    XcdBarrier bar; bar.bar = F.ctl + CW_BAR; bar.x = 0; bar.st = nullptr;
    if (hi - lo > 1) bar = xcd_barrier_post(F.ctl + CW_BAR, F.MISC + 8);
#ifndef PH_MASK
#define PH_MASK 0xFFFFF
#endif
#define IN(k) (lo <= (k) && (k) < hi)
#define INL(j) ((((PH_MASK) >> (j)) & 1) && IN(pb + (j)))
#ifndef SKEW_K1024
#define SKEW_K1024 0
#endif
#ifndef SKEW_K3584
#define SKEW_K3584 0
#endif
#ifndef DUP_MASK
#define DUP_MASK 0
#endif
#define NREP(j) ((((DUP_MASK) >> (j)) & 1) ? 2 : 1)
#define REPBAR(j) do { if (rep + 1 < NREP(j) && hi - lo > 1) xcd_barrier_t<false>(bar); } while (0)
#ifndef PROBE_AMP
#define PROBE_AMP 4
#endif
#ifdef PROBE_SEL
    unsigned long long* const stamps = (unsigned long long*)(F.ws + 7 * MiB);
#define STAMP(i) do { if (blockIdx.x == 0 && threadIdx.x == 0) { stamps[(i)] = __builtin_amdgcn_s_memrealtime(); } } while (0)
#define STAMPB(i) do { if (blockIdx.x == 255 && threadIdx.x == 0) { stamps[(i)] = __builtin_amdgcn_s_memrealtime(); } } while (0)
#else
#define STAMP(i) do { } while (0)
#define STAMPB(i) do { } while (0)
#endif
#define SEAM(k) do { if (IN(k) && IN((k) + 1)) xcd_barrier_t<false>(bar); STAMP((k) + 1); } while (0)
    const int bx = blockIdx.x;

    STAMP(96);
    if (((PH_MASK >> 16) & 1) && IN(0)) { Frame Q = relane(F); p0_prologue(Q); }
    STAMP(0);
    if (hi - lo > 1) xcd_barrier_t<true>(bar);

    STAMP(1);
    for (int l = 0; l < DEPTH; ++l) {
        const int pb = 1 + NPH_LAYER * l;
        if (INL(0)) { Frame Q = relane(F); norm_phase<0>(Q, l); } SEAM(pb + 0);
        if (INL(1)) {
            Frame Q = relane(F); unsigned char* wl = Q.ws + ((l & 1) ? WS_WL : WS_WLB);
            pg8::Gemm g{(const char*)FHB(Q), (const char*)(wl + WL_WIN), 1024, 1024, 1024};
            SchedGrid S; S.T.init(NPANEL, NP_GEMM / 256, Q.G, Q.bx); S.lda = 1024; S.ldb = 1024; S.acol = 0; S.lat = 0;
            EpiWin E{FP(Q), 10, 0};
#ifdef DUP_NULL_WIN
            pg8::gemm_phase(Q.lds, g, S, E, Q.wave); if (hi - lo > 1) xcd_barrier_t<false>(bar);
            #if DUP_NULL_WIN == 1
            { EpiNull E0{FP(Q)}; pg8::gemm_phase(Q.lds, g, S, E0, Q.wave); }
#elif DUP_NULL_WIN == 2
            { EpiWin E0{(bf16_t*)(Q.ws + WS_RR), 1000, 0}; pg8::gemm_phase(Q.lds, g, S, E0, Q.wave); }
#elif DUP_NULL_WIN == 3
            { EpiWin E0{(bf16_t*)(Q.ws + WS_RR), 10, 0}; pg8::gemm_phase(Q.lds, g, S, E0, Q.wave); }
#elif DUP_NULL_WIN == 5
            { EpiWin E0{(bf16_t*)(Q.ws + WS_RR), 0, 0}; pg8::gemm_phase(Q.lds, g, S, E0, Q.wave); }
#else
            { EpiWin E0{(bf16_t*)(Q.ws + WS_RR), 1000, 1}; pg8::gemm_phase(Q.lds, g, S, E0, Q.wave); }
#endif
#else
            for (int rep = 0; rep < NREP(1); ++rep) { pg8::gemm_phase(Q.lds, g, S, E, Q.wave, SKEW_K1024); REPBAR(1); }
#endif
        } SEAM(pb + 1);
        if (INL(2)) { Frame Q = relane(F); prep_phase(Q, l); } SEAM(pb + 2);
        if (INL(3)) {
            Frame Q = relane(F); unsigned char* wl = Q.ws + ((l & 1) ? WS_WL : WS_WLB);
            pg8::Gemm g{(const char*)FP(Q), (const char*)(wl + WL_L1), LDP, 256, 256};
            SchedL3B S{Q.G, Q.bx};
            EpiL3B E{(bf16_t*)(Q.ws + WS_T), (bf16_t*)(Q.ws + WS_QMLA), (bf16_t*)(Q.ws + WS_KMLA), (bf16_t*)(Q.ws + WS_VMLA), (const float*)(Q.ws + WS_ROPE32)};
            for (int rep = 0; rep < NREP(3); ++rep) { pg8::gemm_phase(Q.lds, g, S, E, Q.wave); REPBAR(3); }
        } SEAM(pb + 3);
        if (INL(4)) {
            Frame Q = relane(F); unsigned char* wl = Q.ws + ((l & 1) ? WS_WL : WS_WLB);
            pg8::Gemm g{(const char*)(Q.ws + WS_T), (const char*)(wl + WL_L2), 1536, 256, 256};
            SchedL3C S{Q.G, Q.bx, l};
            EpiL3C E{l, inp(I_W0) + l * 512, inp(I_A0) + l * 512, inp(I_V0) + (l > 0 ? l - 1 : 0) * 256, inp(I_KA) + l * 256,
                     (float*)(Q.ws + WS_W), (bf16_t*)(Q.ws + WS_KD), (bf16_t*)(Q.ws + WS_BB), (const bf16_t*)(Q.ws + WS_KR), (const bf16_t*)(Q.ws + WS_KK),
                     (bf16_t*)(Q.ws + WS_V), (const bf16_t*)(Q.ws + WS_VF), (bf16_t*)(Q.ws + WS_G)};
            pg8::gemm_phase(Q.lds, g, S, E, Q.wave);
        } SEAM(pb + 4);
        if (INL(5)) {
            Frame Q = relane(F); unsigned char* wl = Q.ws + ((l & 1) ? WS_WL : WS_WLB);

#ifndef DUP_MIX
#define DUP_MIX 3
#endif
            for (int rep = 0; rep < NREP(5); ++rep) {
            if (Q.bx < SCAN_NWG && (rep == 0 || (DUP_MIX & 1))) scan_phase<0>(Q, Q.bx);
            STAMP(64 + l);
#ifdef PROBE_SEL
            if (Q.bx < SCAN_NWG && threadIdx.x == 0) stamps[192 + l * 64 + Q.bx] = __builtin_amdgcn_s_memrealtime();
#endif
#ifdef SCAN_VARIANT
            if (Q.bx < SCAN_NWG) scan_phase<SCAN_VARIANT>(Q, Q.bx);
            STAMP(80 + l);
#endif
            if (rep == 0 || (DUP_MIX & 2)) {
                const int x0 = (int)(xb_xcc_id() & 7u);
                if (Q.tid < 8) Q.MISC[32 + Q.tid] = __hip_atomic_load(Q.ctl + CW_ATTQ + ((l * 2 + rep) * 8 + Q.tid) * 64, __ATOMIC_RELAXED, __HIP_MEMORY_SCOPE_AGENT);
                else if (Q.tid == 8) Q.MISC[40] = (l + 1 < DEPTH) ? __hip_atomic_load(Q.ctl + CW_CONVQ + l * 64, __ATOMIC_RELAXED, __HIP_MEMORY_SCOPE_AGENT) : 0u;
                wg_sync();
                int ndone = 0;
                for (int qi = 0; qi < 8; ++qi) {
                    const int x = (x0 + qi) & 7, xb_ = x >> 2, xh_ = x & 3;
                    if (Q.MISC[32 + x] >= 163u) continue;
                    for (;;) {
                        if (Q.tid == 0) Q.MISC[16] = __hip_atomic_fetch_add(Q.ctl + CW_ATTQ + ((l * 2 + rep) * 8 + x) * 64, 1u, __ATOMIC_RELAXED, __HIP_MEMORY_SCOPE_AGENT);
                        wg_sync();
                        const int j = (int)Q.MISC[16];
                        wg_sync();
                        if (j >= 163) break;
                        int idx;
                        if (j < 128) { const int kind = j >> 6, jj = j & 63, split = jj >> 5, qb = jj & 31; idx = (kind << 9) | (xb_ << 8) | (xh_ << 6) | (qb << 1) | split; }
                        else if (j < 160) idx = 1024 + ((xb_ << 7) | (xh_ << 5) | (j - 128));
                        else idx = 1280 + (((j - 160) << 3) | (xb_ << 2) | xh_);
                        attn_run_unit(Q, l, idx); ++ndone;
                    }
                }
#ifdef MIX_MERGE
                if (ndone > 0) mix_publish(Q.ctl + CW_SYNC + l * 256, (unsigned)ndone);
#endif
            }
            REPBAR(5); }
            STAMPB(112 + l);
            if (l + 1 < DEPTH) {
                const int total = convert_layer_weights(Q, l + 1, ConvSel{1, 0, 0});
                if ((int)Q.MISC[40] * 64 < total)
                for (;;) {
                    if (Q.tid == 0) Q.MISC[16] = __hip_atomic_fetch_add(Q.ctl + CW_CONVQ + l * 64, 1u, __ATOMIC_RELAXED, __HIP_MEMORY_SCOPE_AGENT);
                    wg_sync();
                    const int bq = (int)Q.MISC[16];
                    wg_sync();
                    if (bq * 64 >= total) break;
                    convert_layer_weights(Q, l + 1, ConvSel{1, bq * 64, bq * 64 + 64});
                }
            }
            STAMPB(120 + l);
#ifdef MIX_MERGE
            mix_merge_tail(F, l);
            STAMPB(144 + l);
#endif
        } SEAM(pb + 5);
        if (INL(6)) { Frame Q = relane(F); for (int rep = 0; rep < NREP(6); ++rep) { finish_phase(Q, l); REPBAR(6); } } SEAM(pb + 6);
        if (INL(7)) {
            Frame Q = relane(F); unsigned char* wl = Q.ws + ((l & 1) ? WS_WL : WS_WLB);
            pg8::Gemm g{(const char*)(Q.ws + WS_YALL), (const char*)(wl + WL_WBR), 1024, 256, 256};
#ifdef MIX_MERGE
            SchedMerge S{Q.G, Q.bx, l == DEPTH - 1, 0, 1, 0};
            EpiMergeA E{FP(Q), FHB(Q), (const bf16_t*)(Q.ws + WS_OPART), (const bf16_t*)(Q.ws + WS_OPART) + (size_t)NROW * 1024};
#else
            SchedMerge S{Q.G, Q.bx, l == DEPTH - 1, 0, 4, 0};
            EpiMerge E{FP(Q), FHB(Q), 0};
#endif
            for (int rep = 0; rep < NREP(7); ++rep) { pg8::gemm_phase(Q.lds, g, S, E, Q.wave); REPBAR(7); }
        } SEAM(pb + 7);
        if (INL(8)) {
            Frame Q = relane(F); unsigned char* wl = Q.ws + ((l & 1) ? WS_WL : WS_WLB);
            pg8::Gemm g{(const char*)FHB(Q), (const char*)(wl + WL_WOUT), 1024, 1024, 1024};
            SchedGrid S; S.lat = 1; S.T.init(64, 4, Q.G, Q.bx); S.lda = 1024; S.ldb = 1024; S.acol = 0;
            EpiResid E{FX(Q), FMOD(Q) + (size_t)l * 3 * 6144, 2};
            pg8::gemm_phase(Q.lds, g, S, E, Q.wave);
            if (l < DEPTH - 1 && Q.bx < 8 * 4) { wg_sync(); ctx_splitk_tail<4>(F, l, (const char*)FHB(Q), (const char*)(wl + WL_WOUT), 1024, 2, 16); }
        } SEAM(pb + 8);
        if (INL(9)) { Frame Q = relane(F); norm_phase<1>(Q, l); } SEAM(pb + 9);
#ifndef DIAG_DENSE_ONLY
#define DIAG_DENSE_ONLY 0
#endif
#ifndef DIAG_MOE_ONLY
#define DIAG_MOE_ONLY 0
#endif
        if (!DIAG_DENSE_ONLY && ((l & 1) || DIAG_MOE_ONLY)) {
            if (INL(10)) { Frame Q = relane(F); moe_gather(Q, l); } SEAM(pb + 10);
            if (INL(11)) {
                Frame Q = relane(F); unsigned char* wl = Q.ws + ((l & 1) ? WS_WL : WS_WLB);
                pg8::Gemm g{(const char*)(Q.ws + WS_XG), (const char*)(wl + WL_W13), 1024, 1024, 1024};
                SchedMoe S; S.G = Q.G; S.c = Q.bx; S.ncol = 28; S.lda = 1024; S.ldb = 1024; S.nrowB = 7168; moe_panels(Q, l, S.cp);
                EpiSwiGlu E{(bf16_t*)(Q.ws + WS_UG), 1};
                for (int rep = 0; rep < NREP(11); ++rep) { pg8::gemm_phase(Q.lds, g, S, E, Q.wave, SKEW_K1024); REPBAR(11); }
            } SEAM(pb + 11);
            if (INL(12)) {
                Frame Q = relane(F); unsigned char* wl = Q.ws + ((l & 1) ? WS_WL : WS_WLB);
                pg8::Gemm g{(const char*)(Q.ws + WS_UG), (const char*)(wl + WL_W2), DFF, DFF, DFF};
                SchedMoe S; S.G = Q.G; S.c = Q.bx; S.ncol = 4; S.lda = DFF; S.ldb = DFF; S.nrowB = 1024; moe_panels(Q, l, S.cp);
                EpiMoeDown E{(bf16_t*)(Q.ws + WS_YG), (const float*)(Q.ws + WS_ROWGATE)};
                pg8::gemm_phase(Q.lds, g, S, E, Q.wave, SKEW_K3584);
            } SEAM(pb + 12);
        } else {
            if (INL(11)) {
                Frame Q = relane(F); unsigned char* wl = Q.ws + ((l & 1) ? WS_WL : WS_WLB);
                pg8::Gemm g{(const char*)FHB(Q), (const char*)(wl + WL_W13), 1024, 1024, 1024};
                SchedGrid S; S.T.init(NPANEL, 28, Q.G, Q.bx); S.lda = 1024; S.ldb = 1024; S.acol = 0; S.lat = 0;
                EpiSwiGlu E{(bf16_t*)(Q.ws + WS_U), 0};
                for (int rep = 0; rep < NREP(11); ++rep) { pg8::gemm_phase(Q.lds, g, S, E, Q.wave, SKEW_K1024); REPBAR(11); }
            } SEAM(pb + 11);
            if (INL(12)) {
                Frame Q = relane(F); unsigned char* wl = Q.ws + ((l & 1) ? WS_WL : WS_WLB);
                pg8::Gemm g{(const char*)(Q.ws + WS_U), (const char*)(wl + WL_W2D), DFF, DFF, DFF};
                SchedLat S; S.T.init(64, 4, Q.G, Q.bx); S.lda = DFF; S.ldb = DFF;
                EpiResid E{FX(Q), FMOD(Q) + (size_t)l * 3 * 6144, 5};
                pg8::gemm_phase(Q.lds, g, S, E, Q.wave, SKEW_K3584);
                if (Q.bx < 8 * 7) { wg_sync(); ctx_splitk_tail<7>(F, l, (const char*)(Q.ws + WS_U), (const char*)(wl + WL_W2D), DFF, 5, 0); }
            } SEAM(pb + 12);
        }
    }
    if (((PH_MASK >> 17) & 1) && IN(NPHASE - 1)) { Frame Q = relane(F); float probe_scale = 1.0f;

        norm_phase<2>(Q, DEPTH - 1, probe_scale);
#ifdef PROBE_SEL
        if (blockIdx.x == 0 && threadIdx.x == 0) {
            const unsigned long long* st = stamps; unsigned long long dt = 0;
            if (PROBE_SEL < 13) { for (int l = 0; l < DEPTH; ++l) dt += st[2 + 13 * l + PROBE_SEL] - st[1 + 13 * l + PROBE_SEL]; }
            else if (PROBE_SEL == 13) dt = st[1] - st[0];
            else if (PROBE_SEL == 17) dt = st[0] - st[96];
            else if (PROBE_SEL == 22) { for (int l = 0; l < DEPTH; ++l) { unsigned long long mx = 0; for (int b = 0; b < 64; ++b) { const unsigned long long v = st[192 + l * 64 + b]; mx = v > mx ? v : mx; } dt += mx - st[1 + 13 * l + 5]; } }
            else if (PROBE_SEL == 19) { for (int l = 0; l < DEPTH; ++l) dt += st[128 + l] - st[1 + 13 * l + 5]; }
            else if (PROBE_SEL == 20) { for (int l = 0; l < DEPTH; ++l) dt += st[136 + l] - st[1 + 13 * l + 5]; }
            else if (PROBE_SEL == 21) { for (int l = 0; l < DEPTH; ++l) dt += st[144 + l] - st[1 + 13 * l + 5]; }
            else if (PROBE_SEL == 16) { for (int l = 0; l < DEPTH; ++l) dt += st[112 + l] - st[1 + 13 * l + 5]; }
            else if (PROBE_SEL == 18) { for (int l = 0; l < DEPTH; ++l) dt += st[120 + l] - st[1 + 13 * l + 5]; }
            else if (PROBE_SEL == 15) { for (int l = 0; l < DEPTH; ++l) dt += st[64 + l] - st[1 + 13 * l + 5]; }
            else { for (int l = 0; l < DEPTH; ++l) dt += st[80 + l] - st[64 + l]; }
            const unsigned long long t0 = __builtin_amdgcn_s_memrealtime();
            while (__builtin_amdgcn_s_memrealtime() - t0 < (unsigned long long)PROBE_AMP * dt) __builtin_amdgcn_s_sleep(32);
        }
#endif
        }
#undef IN
#undef SEAM
}

extern "C" void kernel_launch(void* const* d_in, const int* in_sizes, int n_in, void* d_out, int out_size, void* d_ws, size_t ws_size, hipStream_t stream) {
    static int grid = 0;
    if (grid == 0) {
        if (n_in != 43 || out_size != NB * SEQ * DM || ws_size < WS_END) { fprintf(stderr, "kernel_launch: unexpected problem (n_in %d, out %d, ws %zu < %zu)\n", n_in, out_size, ws_size, (size_t)WS_END); grid = -1; return; }
        int dev = 0, cus = 0, per_cu = 0;
        if (hipGetDevice(&dev) != hipSuccess || hipDeviceGetAttribute(&cus, hipDeviceAttributeMultiprocessorCount, dev) != hipSuccess) { grid = -1; return; }
        if (hipFuncSetAttribute((const void*)hfb_fwd, hipFuncAttributeMaxDynamicSharedMemorySize, LDS_BYTES) != hipSuccess) { fprintf(stderr, "kernel_launch: hipFuncSetAttribute failed\n"); grid = -1; return; }
        if (hipOccupancyMaxActiveBlocksPerMultiprocessor(&per_cu, (const void*)hfb_fwd, 512, LDS_BYTES) != hipSuccess || per_cu < 1) { fprintf(stderr, "kernel_launch: occupancy query says %d\n", per_cu); }
        (void)hipGetLastError();
        grid = cus < 256 ? cus : 256;
        if (grid < 128) { grid = -1; return; }
    }
    if (grid < 0) return;
    (void)in_sizes;
    hipMemsetAsync((char*)d_ws + WS_CTL, 0, CTL_BYTES, stream);
    Args a{};
    for (int i = 0; i < 43; ++i) a.in[i] = (const float*)d_in[i];
    a.out = (float*)d_out; a.ws = (unsigned char*)d_ws;
#if MK_N_LAUNCHES == 1
    a.ph_lo = 0; a.ph_hi = NPHASE;
    hipLaunchKernelGGL(hfb_fwd, dim3(grid), dim3(512), LDS_BYTES, stream, a);
#else
    for (int p = 0; p < NPHASE; ++p) {
        const int l = (p - 1) / NPH_LAYER, k = (p - 1) % NPH_LAYER;
        if (p >= 1 && p < NPHASE - 1 && k == 10 && !(l & 1)) continue;
        a.ph_lo = p; a.ph_hi = p + 1;
        hipLaunchKernelGGL(hfb_fwd, dim3(grid), dim3(512), LDS_BYTES, stream, a);
    }
#endif
}
```

```cpp
#include <hip/hip_runtime.h>
#include <cstdio>
#include <cstdint>

#ifndef MK_N_LAUNCHES
#define MK_N_LAUNCHES 1
#endif

#define GAS __attribute__((address_space(1)))
#define LAS __attribute__((address_space(3)))
#define DI __device__ __forceinline__
typedef unsigned short bf16_t;
typedef short bf16x8 __attribute__((ext_vector_type(8)));
typedef short s16x4 __attribute__((ext_vector_type(4)));
typedef float f32x2 __attribute__((ext_vector_type(2)));
typedef float f32x4 __attribute__((ext_vector_type(4)));
typedef float f32x16 __attribute__((ext_vector_type(16)));
typedef unsigned u32x2 __attribute__((ext_vector_type(2)));
typedef unsigned u32x4 __attribute__((ext_vector_type(4)));

constexpr int DM = 1024, NB = 2, SEQ = 8192, DEPTH = 4, CTXL = 256, GRIDW = 64;
constexpr int TPB = CTXL + SEQ;
constexpr int NROW = NB * TPB;
constexpr int NPANEL = NROW / 256;
constexpr int DFF = 3584, NEXP = 8;
constexpr int IN_W = 6560;
constexpr int PC_F = 0, PC_SWQ = 1024, PC_SWK = 1280, PC_SWV = 1408, PC_CQ = 1536, PC_CKV = 1792, PC_KR = 1920,
              PC_GAQ = 2048, PC_GAK = 2304, PC_GAV = 2432, PC_GATE = 2560, PC_Z = 6656, NP_GEMM = 6656, LDP = 6912;
constexpr float LOG2E = 1.4426950408889634f;
constexpr float QS64 = 0.125f * LOG2E;
constexpr float QS96 = 0.10206207261596577f * LOG2E;
constexpr int NSPLIT = 2;
constexpr int MOE_MAXROWS = 35840;

constexpr size_t MiB = 1u << 20;
constexpr size_t WS_CTL = 0, CTL_BYTES = 1 * MiB;
constexpr size_t WS_MOD = 1 * MiB;
constexpr size_t WS_ROPE64 = 2 * MiB;
constexpr size_t WS_ROPE32 = 4 * MiB;
constexpr size_t WS_ASG = 5 * MiB;
constexpr size_t WS_ASG_GATE = 5 * MiB + 512 * 1024;
constexpr size_t WS_ASG_DST = 6 * MiB;
constexpr size_t WS_ROWGATE = 6 * MiB + 512 * 1024;
constexpr size_t WS_WL = 8 * MiB;
constexpr size_t WL_WIN = 0;
constexpr size_t WL_WBR = WL_WIN + (size_t)NP_GEMM * 1024 * 2;
constexpr size_t WL_WOUT = WL_WBR + (size_t)4 * 1024 * 256 * 2;
constexpr size_t WL_L1 = WL_WOUT + (size_t)1024 * 1024 * 2;
constexpr size_t WL_L2 = WL_L1 + (size_t)1536 * 256 * 2;
constexpr size_t WL_UQ = WL_L2 + (size_t)1536 * 256 * 2;
constexpr size_t WL_UKV = WL_UQ + (size_t)512 * 256 * 2;
constexpr size_t WL_W13 = WL_UKV + (size_t)512 * 256 * 2;
constexpr size_t WL_W2 = WL_W13 + (size_t)NEXP * 7168 * 1024 * 2;
constexpr size_t WL_END = WL_W2 + (size_t)NEXP * 1024 * 3584 * 2;
static_assert(WL_END <= 200 * MiB, "weights region");
constexpr size_t WS_X = 208 * MiB;
constexpr size_t WS_HB = 274 * MiB;
constexpr size_t WS_VF = 307 * MiB;
constexpr size_t WS_REG = 316 * MiB;
constexpr size_t WS_P = WS_REG;
constexpr size_t WS_RR = WS_REG + 223 * MiB;
constexpr size_t WS_KK = WS_RR + 9 * MiB;
constexpr size_t WS_KR = WS_KK + 9 * MiB;
constexpr size_t WS_V = WS_KR + 9 * MiB;
constexpr size_t WS_KD = WS_V + 9 * MiB;
constexpr size_t WS_BB = WS_KD + 17 * MiB;
constexpr size_t WS_W = WS_BB + 17 * MiB;
constexpr size_t WS_G = WS_W + 33 * MiB;
constexpr size_t WS_T = WS_G + 9 * MiB;
constexpr size_t WS_OPART = WS_T;
constexpr size_t WS_ML = WS_OPART + 66 * MiB;
constexpr size_t WS_YDIR = WS_ML + 3 * MiB;
constexpr size_t WS_QMLA = WS_YDIR + 33 * MiB;
constexpr size_t WS_KMLA = WS_QMLA + 13 * MiB;
constexpr size_t WS_VMLA = WS_KMLA + 13 * MiB;
constexpr size_t WS_YALL = WS_VMLA + 9 * MiB;
constexpr size_t WS_MIX_END = WS_YALL + 33 * MiB;
constexpr size_t WS_U = WS_REG;
constexpr size_t WS_XG = WS_REG;
constexpr size_t WS_UG = WS_REG + 70 * MiB;
constexpr size_t WS_YG = WS_UG + 245 * MiB;
constexpr size_t WS_FFN_END = WS_YG + 70 * MiB;
constexpr size_t WS_SLAB = WS_REG + 440 * MiB;
static_assert(WS_SLAB >= WS_FFN_END && WS_SLAB + 16 * MiB <= WS_MIX_END, "slabs");
constexpr size_t WS_WLB = 824 * MiB;
constexpr size_t WL_W2D = WL_W13 + (size_t)7168 * 1024 * 2;
static_assert(WS_WLB >= WS_MIX_END && WS_WLB >= WS_FFN_END && WL_W2D + (size_t)1024 * 3584 * 2 <= 44 * MiB, "dense weight buffer");
constexpr size_t WS_END = WS_WLB + 44 * MiB;
static_assert(WS_KR + (size_t)NROW * 256 * 2 <= WS_V && WS_T + (size_t)NROW * 1536 * 2 <= WS_ML && WS_OPART + (size_t)2 * NSPLIT * NROW * 256 * 4 <= WS_ML, "map");
static_assert((size_t)2 * NSPLIT * NROW * 8 * 4 <= 3 * MiB && (size_t)NROW * 384 * 2 <= 13 * MiB && (size_t)NROW * LDP * 2 <= 223 * MiB, "map");
static_assert((size_t)MOE_MAXROWS * 1024 * 2 <= 70 * MiB && (size_t)MOE_MAXROWS * 3584 * 2 <= 245 * MiB, "map");

constexpr int CW_BAR = 4096;
constexpr int CW_MOECNT = 16384;
constexpr int CW_ATTQ = 20480;
constexpr int CW_CONVQ = 24576;
constexpr int CW_SYNC = 28672;
constexpr int CW_SLABCNT = 30720;
constexpr int CW_WGBASE = 32768;

constexpr int RING_BYTES = 131072;
constexpr int MISC_OFF = RING_BYTES;
constexpr int LDS_BYTES = 147456;

#define LDS_WAIT() asm volatile("s_waitcnt lgkmcnt(0)" ::: "memory")
#define VM_WAIT() asm volatile("s_waitcnt vmcnt(0)" ::: "memory")
DI unsigned f2bf(float f) { unsigned u = __builtin_bit_cast(unsigned, f); return (u + 0x7fffu + ((u >> 16) & 1u)) >> 16; }
DI unsigned pk2(float lo, float hi) { return f2bf(lo) | (f2bf(hi) << 16); }
DI float bflo(unsigned w) { return __builtin_bit_cast(float, w << 16); }
DI float bfhi(unsigned w) { return __builtin_bit_cast(float, w & 0xffff0000u); }
DI float bf2f(bf16_t b) { return __builtin_bit_cast(float, ((unsigned)b) << 16); }
typedef __bf16 bf16x2_t __attribute__((ext_vector_type(2)));
DI unsigned cvt_pk_bf16(float lo, float hi) { const f32x2 v = (f32x2){lo, hi}; const bf16x2_t b = __builtin_convertvector(v, bf16x2_t); return __builtin_bit_cast(unsigned, b); }
DI float fast_exp2(float x) { return __builtin_amdgcn_exp2f(x); }
DI float fast_rcp(float x) { return __builtin_amdgcn_rcpf(x); }
DI float sigmoidf_(float x) { return fast_rcp(1.0f + fast_exp2(-x * LOG2E)); }
DI float siluf_(float x) { return x * sigmoidf_(x); }
DI float tanhf_(float x) { const float e = fast_exp2(-2.0f * LOG2E * __builtin_fabsf(x)); const float t = (1.0f - e) * fast_rcp(1.0f + e); return x < 0.f ? -t : t; }
#define DPP_ADD(x, ctrl) ((x) + __builtin_bit_cast(float, __builtin_amdgcn_update_dpp(0, __builtin_bit_cast(int, (x)), (ctrl), 0xf, 0xf, false)))
DI float rsum16(float x) { x = DPP_ADD(x, 0x128); x = DPP_ADD(x, 0x124); x = DPP_ADD(x, 0x122); x = DPP_ADD(x, 0x121); return x; }
DI float sum16(float v) { return rsum16(v); }
DI float wave_sum(float v) {
    v = rsum16(v);
    { auto rr = __builtin_amdgcn_permlane16_swap(__float_as_uint(v), __float_as_uint(v), false, false); v = __uint_as_float(rr[0]) + __uint_as_float(rr[1]); }
    { auto rr = __builtin_amdgcn_permlane32_swap(__float_as_uint(v), __float_as_uint(v), false, false); v = __uint_as_float(rr[0]) + __uint_as_float(rr[1]); }
    return v;
}
DI int row_vec(int row) { return (row % TPB) < CTXL ? 2 : row / TPB; }
#define MIX_MERGE 1
#define XB_TMO      128
#define XB_XCNT(j)  (256  + 64 * (j))
#define XB_XSUB(j)  (1280 + 64 * (j))
#define XB_XGEN(j)  (2304 + 64 * (j))
#define XB_TOP      3328
#define XB_TOPGEN   3392
#define XCD_BAR_WORDS 3456
#define XB_SPIN_CAP (1u << 25)
DI unsigned xb_ld(unsigned* p)              { return __hip_atomic_load(p, __ATOMIC_RELAXED, __HIP_MEMORY_SCOPE_AGENT); }
DI unsigned xb_add(unsigned* p, unsigned v) { return __hip_atomic_fetch_add(p, v, __ATOMIC_RELAXED, __HIP_MEMORY_SCOPE_AGENT); }
DI unsigned xb_xcc_id() { return (unsigned)__builtin_amdgcn_s_getreg((3 << 11) | 20) & 0xFu; }
#define XB_SPIN(cond, bar) do { unsigned _sp = 0; while (cond) { __builtin_amdgcn_s_sleep(1); \
    if ((++_sp & 255u) == 0u) { if (xb_ld(&(bar)[XB_TMO])) break; if (_sp > XB_SPIN_CAP) { atomicAdd(&(bar)[XB_TMO], 1u); break; } } } } while (0)
struct XcdBarrier { unsigned* bar; unsigned x; volatile LAS unsigned* st; };
DI XcdBarrier xcd_barrier_post(unsigned* bar, volatile LAS unsigned* st) {
    XcdBarrier b; b.bar = bar; b.x = xb_xcc_id(); b.st = st;
    if (threadIdx.x == 0) (void)xb_add(&bar[XB_XCNT(b.x)], 1u);
    return b;
}
DI void xcd_barrier_complete(unsigned* bar, unsigned x, unsigned& nloc, unsigned& nx) {
    const unsigned G = gridDim.x * gridDim.y * gridDim.z;
    unsigned sum, cnt, mine, sp = 0u;
    for (;;) {
        sum = 0u; cnt = 0u; mine = 0u;
#pragma unroll
        for (unsigned j = 0; j < 16; ++j) { const unsigned c = xb_ld(&bar[XB_XCNT(j)]); sum += c; cnt += (c > 0u) ? 1u : 0u; mine = (j == x) ? c : mine; }
        if (sum == G) break;
        __builtin_amdgcn_s_sleep(1);
        if ((++sp & 255u) == 0u) { if (xb_ld(&bar[XB_TMO])) break; if (sp > XB_SPIN_CAP) { atomicAdd(&bar[XB_TMO], 1u); break; } }
    }
    nloc = mine > 0u ? mine : 1u; nx = cnt > 0u ? cnt : 1u;
}
template <bool FIRST>
DI void xcd_barrier_t(const XcdBarrier& b) {
    asm volatile("s_waitcnt vmcnt(0)" ::: "memory");
    __syncthreads();
    if (threadIdx.x == 0) {
        unsigned* bar = b.bar; asm volatile("" : "+s"(bar));
        __builtin_amdgcn_s_waitcnt(0);
        unsigned nloc = b.st[0], nx = b.st[1];
        if (FIRST) { if (nloc == 0u) { xcd_barrier_complete(bar, b.x, nloc, nx); b.st[0] = nloc; b.st[1] = nx; } }
        else if (nloc == 0u) { atomicAdd(&bar[XB_TMO], 1u); nloc = 1u; nx = 1u; }
        const unsigned old = xb_add(&bar[XB_XSUB(b.x)], 1u);
        const unsigned gen = old / nloc;
        if (old + 1u == (gen + 1u) * nloc) {
            __builtin_amdgcn_fence(__ATOMIC_RELEASE, "agent");
            asm volatile("s_waitcnt vmcnt(0)" ::: "memory");
            const unsigned og = xb_add(&bar[XB_TOP], 1u);
            const unsigned tg = og / nx;
            if (og + 1u == (tg + 1u) * nx) xb_add(&bar[XB_TOPGEN], 1u);
            else XB_SPIN(xb_ld(&bar[XB_TOPGEN]) == tg, bar);
            __builtin_amdgcn_fence(__ATOMIC_ACQUIRE, "agent");
            xb_add(&bar[XB_XGEN(b.x)], 1u);
            asm volatile("s_waitcnt vmcnt(0)" ::: "memory");
        } else {
            XB_SPIN(xb_ld(&bar[XB_XGEN(b.x)]) == gen, bar);
            __builtin_amdgcn_fence(__ATOMIC_ACQUIRE, "agent");
            asm volatile("s_waitcnt vmcnt(0)" ::: "memory");
        }
    }
    __syncthreads();
}

namespace pg8 {
constexpr int BM = 256, BK = 64, HALF = 128, HTB = HALF * BK * 2, STAGE_BYTES = 8 * HTB, NXCD = 8, WGM = 8;
__host__ __device__ __forceinline__ int lds_byte(int r, int c) { const int st = (r >> 4) * 2 + (c >> 5), rr = r & 15, cc = c & 31, ob = rr * 64 + cc * 2; return st * 1024 + (ob ^ (((ob >> 9) & 1) << 5)); }
__host__ __device__ __forceinline__ void stage_rc(int b, int& R, int& C) { const int st = b / 1024, sb = b % 1024, swz = sb ^ (((sb >> 9) & 1) << 5); R = (st >> 1) * 16 + swz / 64; C = (st & 1) * 32 + (swz % 64) / 2; }
__host__ __device__ __forceinline__ int perm32(int rho) { const int n = rho >> 4, i = rho & 15; return 8 * (i >> 2) + 4 * n + (i & 3); }

struct Unit { int pm, pn, aux; size_t aoff, boff; };
struct Gemm { const char* A; const char* Bt; int lda, ldb, K; };

struct TileOrder {
    int nM, nN, nwg, G, c;
    DI void init(int nM_, int nN_, int G_, int c_) { nM = nM_; nN = nN_; nwg = nM * nN; G = G_; c = c_; }
    DI bool tile(int i, int& pm, int& pn) const {
        const long L = (long)i * G + c; if (L >= nwg) return false;
        int wgid = (int)L; { const int q = nwg / NXCD, r = nwg % NXCD, xcd = wgid % NXCD, off = wgid / NXCD; wgid = (xcd < r ? xcd * (q + 1) : r * (q + 1) + (xcd - r) * q) + off; }
        const int nig = WGM * nN, gid = wgid / nig, fm = gid * WGM, gsz = (nM - fm) < WGM ? (nM - fm) : WGM;
        pm = fm + ((wgid % nig) % gsz); pn = (wgid % nig) / gsz; return true;
    }
};

template <class Epi, class Sched>
DI void gemm_phase(LAS unsigned char* lds, const Gemm g, const Sched& S, const Epi& E, const int wave_id, const int skew = 0) {
    int lane; asm volatile("v_mbcnt_lo_u32_b32 %0, -1, 0\n\tv_mbcnt_hi_u32_b32 %0, -1, %0" : "=v"(lane));
    const int wid = wave_id, tid = wid * 64 + lane, wr = wid >> 2, wc = wid & 3, fr = lane & 15, fq = lane >> 4;
    const int K = g.K, nt = K / BK;
    unsigned voffA[2], voffB[2];
#pragma unroll
    for (int i = 0; i < 2; ++i) { int R, C; stage_rc(tid * 16 + i * 8192, R, C); const int Rb = (R & ~31) + perm32(R & 31);
        voffA[i] = (unsigned)(R * g.lda + C) * 2u; voffB[i] = (unsigned)(Rb * g.ldb + C) * 2u; }
    const size_t kstep = (size_t)(BK * 2);
    const size_t hstepA = (size_t)HALF * g.lda * 2, hstepB = (size_t)HALF * g.ldb * 2;
    const unsigned ldsw = (unsigned)wid * 1024u;
    const int aoff = lds_byte(wr * 64 + fr, fq * 8), boff = lds_byte(wc * 32 + fr, fq * 8);
#define PG8_SA(b, h) (((b) * 2 + (h)) * HTB)
#define PG8_SB(b, h) ((4 + (b) * 2 + (h)) * HTB)
#define PG8_STAGE(bufoff, gbase, voff) do { _Pragma("unroll") for (int _i = 0; _i < 2; ++_i) \
        __builtin_amdgcn_global_load_lds((const unsigned*)((const char*)(gbase) + (voff)[_i]), (LAS unsigned*)(lds + (bufoff) + ldsw + _i * 8192), 16, 0, 0); } while (0)
#define PG8_LDA(dst, b, h) do { _Pragma("unroll") for (int m = 0; m < 4; ++m) _Pragma("unroll") for (int k = 0; k < 2; ++k) dst[m][k] = *(const LAS bf16x8*)(lds + PG8_SA(b, h) + aoff + m * 2048 + k * 1024); } while (0)
#define PG8_LDB(dst, b, h) do { _Pragma("unroll") for (int n = 0; n < 2; ++n) _Pragma("unroll") for (int k = 0; k < 2; ++k) dst[n][k] = *(const LAS bf16x8*)(lds + PG8_SB(b, h) + boff + n * 2048 + k * 1024); } while (0)
#define PG8_MMA(ai, bj, At, Bt) do { __builtin_amdgcn_s_setprio(1); _Pragma("unroll") for (int m = 0; m < 4; ++m) _Pragma("unroll") for (int n = 0; n < 2; ++n) _Pragma("unroll") for (int k = 0; k < 2; ++k) \
        acc[ai][bj][m][n] = __builtin_amdgcn_mfma_f32_16x16x32_bf16(Bt[n][k], At[m][k], acc[ai][bj][m][n], 0, 0, 0); __builtin_amdgcn_s_setprio(0); } while (0)
#define PG8_WAIT_V(n) asm volatile("s_waitcnt vmcnt(" #n ")" ::: "memory")
#define PG8_WAIT_L(n) asm volatile("s_waitcnt lgkmcnt(" #n ")" ::: "memory")
#define PG8_BAR __builtin_amdgcn_s_barrier()
#define PG8_SCHED __builtin_amdgcn_sched_barrier(0)
    Unit cur, nxt; int ui = 0;
    if (!S.next(0, cur)) return;
    for (int sk = (int)((blockIdx.x >> 3) & 7u) * skew; sk > 0; sk -= 100) __builtin_amdgcn_s_sleep(100);
    f32x4 acc[2][2][4][2];
#pragma unroll
    for (int a = 0; a < 2; ++a)
#pragma unroll
        for (int b = 0; b < 2; ++b)
#pragma unroll
            for (int m = 0; m < 4; ++m)
#pragma unroll
                for (int n = 0; n < 2; ++n) acc[a][b][m][n] = (f32x4){0.f, 0.f, 0.f, 0.f};
    bf16x8 At[4][2], B0[2][2], B1[2][2];
    const char* cA = g.A + cur.aoff; const char* cB = g.Bt + cur.boff;
    {
        PG8_STAGE(PG8_SB(0, 0), cB, voffB); PG8_STAGE(PG8_SB(0, 1), cB + hstepB, voffB); PG8_STAGE(PG8_SA(0, 0), cA, voffA); PG8_STAGE(PG8_SA(0, 1), cA + hstepA, voffA);
        if (wr == 1) PG8_BAR;
        PG8_WAIT_V(2); PG8_BAR;
        PG8_STAGE(PG8_SB(1, 0), cB + kstep, voffB); PG8_STAGE(PG8_SA(1, 0), cA + kstep, voffA); PG8_STAGE(PG8_SB(1, 1), cB + hstepB + kstep, voffB);
        PG8_WAIT_V(6); PG8_BAR;
    }
    for (;;) {
        const bool has_next = S.next(ui + 1, nxt);
        const char* nA = has_next ? g.A + nxt.aoff : cA; const char* nB = has_next ? g.Bt + nxt.boff : cB;
#pragma nounroll
        for (int t = 0; t < nt; t += 2) {
            const bool last = (t == nt - 2);
            const char* a1 = cA + (size_t)(t + 1) * kstep;
            const char* a2 = last ? nA : cA + (size_t)(t + 2) * kstep; const char* b2 = last ? nB : cB + (size_t)(t + 2) * kstep;
            const char* a3 = a2 + kstep; const char* b3 = b2 + kstep;
            PG8_LDB(B0, 0, 0); PG8_LDB(B1, 0, 1); PG8_SCHED; PG8_LDA(At, 0, 0); PG8_STAGE(PG8_SA(1, 1), a1 + hstepA, voffA);
            PG8_WAIT_V(8); PG8_WAIT_L(0); PG8_BAR; PG8_MMA(0, 0, At, B0); PG8_MMA(0, 1, At, B1); PG8_BAR; PG8_SCHED;
            PG8_LDA(At, 0, 1); PG8_STAGE(PG8_SB(0, 0), b2, voffB); PG8_STAGE(PG8_SB(0, 1), b2 + hstepB, voffB); PG8_STAGE(PG8_SA(0, 0), a2, voffA);
            PG8_WAIT_V(8); PG8_WAIT_L(0); PG8_BAR; PG8_MMA(1, 0, At, B0); PG8_MMA(1, 1, At, B1); PG8_BAR; PG8_SCHED;
            PG8_LDB(B0, 1, 0); PG8_LDB(B1, 1, 1); PG8_SCHED; PG8_LDA(At, 1, 0); PG8_STAGE(PG8_SA(0, 1), a2 + hstepA, voffA);
            PG8_WAIT_V(8); PG8_WAIT_L(0); PG8_BAR; PG8_MMA(0, 0, At, B0); PG8_MMA(0, 1, At, B1); PG8_BAR; PG8_SCHED;
            PG8_LDA(At, 1, 1); PG8_STAGE(PG8_SB(1, 0), b3, voffB); PG8_STAGE(PG8_SB(1, 1), b3 + hstepB, voffB); PG8_STAGE(PG8_SA(1, 0), a3, voffA);
            PG8_WAIT_V(8); PG8_WAIT_L(0); PG8_BAR; PG8_MMA(1, 0, At, B0); PG8_MMA(1, 1, At, B1); PG8_BAR; PG8_SCHED;
        }
        if (wr == 0) PG8_BAR;
        E(acc, cur, wr, wc, fr, fq);
        if (!has_next) break;
#pragma unroll
        for (int a = 0; a < 2; ++a)
#pragma unroll
            for (int b = 0; b < 2; ++b)
#pragma unroll
                for (int m = 0; m < 4; ++m)
#pragma unroll
                    for (int n = 0; n < 2; ++n) acc[a][b][m][n] = (f32x4){0.f, 0.f, 0.f, 0.f};
        cur = nxt; cA = nA; cB = nB; ++ui;
        if (wr == 1) PG8_BAR;
    }
    PG8_WAIT_V(0);
    PG8_BAR;
#undef PG8_SA
#undef PG8_SB
#undef PG8_STAGE
#undef PG8_LDA
#undef PG8_LDB
#undef PG8_MMA
#undef PG8_WAIT_V
#undef PG8_WAIT_L
#undef PG8_BAR
#undef PG8_SCHED
}
}
struct Frame {
    LAS unsigned char* lds;
    volatile LAS unsigned* MISC;
    unsigned* ctl;
    unsigned char* ws;
    int tid, lane, wave, vcu, G, bx;
    float* out;
};
DI Frame relane(const Frame& F) { Frame Q = F; int ln; unsigned char* w = F.ws; int wv = F.wave;
    asm volatile("v_mbcnt_lo_u32_b32 %0, -1, 0\n\tv_mbcnt_hi_u32_b32 %0, -1, %0" : "=v"(ln));
    asm volatile("" : "+s"(w), "+s"(wv)); Q.ws = w; Q.ctl = (unsigned*)w; Q.lane = ln; Q.wave = wv; Q.tid = wv * 64 + ln; return Q; }
typedef const float* cfp_t;
DI cfp_t inp(int i) { unsigned long long kp = (unsigned long long)__builtin_amdgcn_kernarg_segment_ptr(); asm volatile("" : "+s"(kp)); return ((const __attribute__((address_space(4))) cfp_t*)kp)[i]; }
#define FX(F) ((float*)((F).ws + WS_X))
#define FHB(F) ((bf16_t*)((F).ws + WS_HB))
#define FP(F) ((bf16_t*)((F).ws + WS_P))
#define FMOD(F) ((float*)((F).ws + WS_MOD))
enum { I_X = 0, I_C, I_CTX, I_CCTX, I_WMOD, I_BMOD, I_NORM1, I_NORM2, I_WIN, I_WBR, I_WOUT, I_MU, I_W0, I_W1, I_W2, I_A0, I_A1, I_A2, I_V0, I_V1, I_V2,
       I_G1, I_G2, I_KK, I_KA, I_RK, I_LNW, I_LNB, I_SINK, I_MQN, I_WUQ, I_MKVN, I_WUKV, I_GQN, I_GKN, I_FW1, I_FW3, I_FW2, I_ROUTER, I_MW1, I_MW3, I_MW2, I_FNORM };

DI const float* modp(const Frame& F, int l, int vec, int which) { return FMOD(F) + ((size_t)(l * 3 + vec) * 6 + which) * 1024; }

using pg8::Unit;
struct SchedGrid {
    pg8::TileOrder T; int lda, ldb, acol, lat;
    DI bool next(int i, Unit& u) const { int pm, pn; if (!T.tile(i, pm, pn)) return false; if (lat) pm = pm < 32 ? pm + 1 : pm + 2; u.pm = pm; u.pn = pn; u.aux = 0;
        u.aoff = ((size_t)pm * 256 * lda + acol) * 2; u.boff = (size_t)pn * 256 * ldb * 2; return true; }
};
struct SchedLat {
    pg8::TileOrder T; int lda, ldb;
    DI bool next(int i, Unit& u) const { int lp, pn; if (!T.tile(i, lp, pn)) return false; const int pm = lp < 32 ? lp + 1 : lp + 2; u.pm = pm; u.pn = pn; u.aux = 0;
        u.aoff = (size_t)pm * 256 * lda * 2; u.boff = (size_t)pn * 256 * ldb * 2; return true; }
};
struct SchedCtxK {
    int G, c, ns, kc, lda, ldb;
    DI bool next(int i, Unit& u) const { const int L = i * G + c; if (L >= 8 * ns) return false;
        const int sl = L % ns, t = L / ns, pn = t & 3, pm = (t >> 2) ? 33 : 0; u.pm = pm; u.pn = pn; u.aux = sl;
        u.aoff = ((size_t)pm * 256 * lda + (size_t)sl * kc) * 2; u.boff = ((size_t)pn * 256 * ldb + (size_t)sl * kc) * 2; return true; }
};
struct SchedL3B {
    int G, c;
    DI bool next(int i, Unit& u) const {
        int L = i * G + c; if (L >= 660) return false;
        int grp, pm, pn; size_t bb; int acol;
        if (L < 396) { grp = 0; pm = L % 66; pn = L / 66; bb = 0; acol = PC_Z; }
        else if (L < 528) { L -= 396; grp = 1; pm = L % 66; pn = L / 66; bb = WL_UQ - WL_L1; acol = PC_CQ; }
        else { L -= 528; grp = 2; pm = L % 66; pn = L / 66; bb = WL_UKV - WL_L1; acol = PC_CKV; }
        u.pm = pm; u.pn = pn; u.aux = grp; u.aoff = ((size_t)pm * 256 * LDP + acol) * 2; u.boff = bb + (size_t)pn * 256 * 256 * 2; return true;
    }
};
struct SchedL3C {
    int G, c, layer;
    DI bool next(int i, Unit& u) const {
        const int L = i * G + c; const int ntile = layer == 0 ? 5 : 6; if (L >= 66 * ntile) return false;
        const int pm = L % 66; int pn = L / 66; if (layer == 0 && pn >= 4) pn = 5;
        u.pm = pm; u.pn = pn; u.aux = 0; u.aoff = ((size_t)pm * 256 * 1536 + pn * 256) * 2; u.boff = (size_t)pn * 256 * 256 * 2; return true;
    }
};
struct SchedMerge {
    int G, c, lat, b0, nb, one;
    DI bool next(int i, Unit& u) const {
        const int ti = one ? c : (i / nb) * G + c; if (ti >= (lat ? 256 : 264) || (one && i >= nb)) return false; const int br = b0 + i % nb;
        int pm, pn; if (lat) { const int lp = ti & 63; pm = lp < 32 ? lp + 1 : lp + 2; pn = ti >> 6; } else { pm = ti % 66; pn = ti / 66; }
        u.pm = pm; u.pn = pn; u.aux = br; u.aoff = ((size_t)pm * 256 * 1024 + br * 256) * 2; u.boff = ((size_t)(br * 1024 + pn * 256) * 256) * 2; return true;
    }
};
struct SchedMoe {
    int G, c, ncol, lda, ldb, nrowB; int cp[9];
    DI bool next(int i, Unit& u) const {
        const int L = i * G + c; if (L >= cp[8] * ncol) return false;
        const int p = L / ncol, j = L % ncol; int e = 0;
#pragma unroll
        for (int q = 1; q < 8; ++q) e += (p >= cp[q]) ? 1 : 0;
        u.pm = p; u.pn = e; u.aux = j; u.aoff = (size_t)p * 256 * lda * 2; u.boff = ((size_t)e * nrowB + (size_t)j * 256) * ldb * 2; return true;
    }
};

typedef const f32x4 (&AccRef)[2][2][4][2];
#define EPI_ROWS(u) _Pragma("unroll") for (int ai = 0; ai < 2; ++ai) _Pragma("unroll") for (int m = 0; m < 4; ++m)
#define EPI_ROW(u) ((u).pm * 256 + ai * 128 + wr * 64 + m * 16 + fr)
DI u32x4 pack8(const f32x4 a, const f32x4 b) { u32x4 w; w.x = cvt_pk_bf16(a[0], a[1]); w.y = cvt_pk_bf16(a[2], a[3]); w.z = cvt_pk_bf16(b[0], b[1]); w.w = cvt_pk_bf16(b[2], b[3]); return w; }
DI void unpack8(const u32x4 w, f32x4& a, f32x4& b) { a = (f32x4){bflo(w.x), bfhi(w.x), bflo(w.y), bfhi(w.y)}; b = (f32x4){bflo(w.z), bfhi(w.z), bflo(w.w), bfhi(w.w)}; }

struct EpiWin {
    bf16_t* P; int sigfrom; int tm;
    DI void operator()(AccRef acc, const Unit& u, int wr, int wc, int fr, int fq) const {
        asm volatile("" : "+v"(fr), "+v"(fq));
        const bool sig = u.pn >= sigfrom;
        EPI_ROWS(u) { bf16_t* rp = tm ? P + (size_t)u.pn * NROW * 256 + (size_t)EPI_ROW(u) * 256 + wc * 32 + fq * 8 : P + (size_t)EPI_ROW(u) * LDP + u.pn * 256 + wc * 32 + fq * 8;
#pragma unroll
            for (int bj = 0; bj < 2; ++bj) { f32x4 a = acc[ai][bj][m][0], b = acc[ai][bj][m][1];
                if (sig) {
#pragma unroll
                    for (int j = 0; j < 4; ++j) { a[j] = sigmoidf_(a[j]); b[j] = sigmoidf_(b[j]); } }
                *(GAS u32x4*)(rp + bj * 128) = pack8(a, b); } asm volatile("" ::: "memory"); }
    }
};
struct EpiNull {
    bf16_t* P;
    DI void operator()(AccRef acc, const Unit& u, int wr, int wc, int fr, int fq) const {
        asm volatile("" : "+v"(fr), "+v"(fq));
        if (u.pm < 0) {
        EPI_ROWS(u) { bf16_t* rp = P + (size_t)EPI_ROW(u) * LDP + u.pn * 256 + wc * 32 + fq * 8;
#pragma unroll
            for (int bj = 0; bj < 2; ++bj) *(GAS u32x4*)(rp + bj * 128) = pack8(acc[ai][bj][m][0], acc[ai][bj][m][1]); } }
    }
};
struct EpiL3B {
    bf16_t* T; bf16_t* Qm; bf16_t* Km; bf16_t* Vm; const float* rope32;
    DI void operator()(AccRef acc, const Unit& u, int wr, int wc, int fr, int fq) const {
        asm volatile("" : "+v"(fr), "+v"(fq));
        const int grp = u.aux, pn = u.pn;
        EPI_ROWS(u) { const int row = EPI_ROW(u);
#pragma unroll
            for (int bj = 0; bj < 2; ++bj) { f32x4 a = acc[ai][bj][m][0], b = acc[ai][bj][m][1]; const int ct = bj * 128 + wc * 32 + fq * 8;
                if (grp == 0) {
                    if (pn < 2) {
#pragma unroll
                        for (int j = 0; j < 4; ++j) { a[j] = tanhf_(a[j]); b[j] = tanhf_(b[j]); } }
                    else if (pn == 5) {
#pragma unroll
                        for (int j = 0; j < 4; ++j) { a[j] = sigmoidf_(a[j]); b[j] = sigmoidf_(b[j]); } }
                    *(GAS u32x4*)(T + (size_t)row * 1536 + pn * 256 + ct) = pack8(a, b);
                } else if (grp == 1) {
                    const int col = pn * 256 + ct;
                    if (col < 384) {
                        const int within = col % 96; const int pos = row % TPB;
                        if (within >= 64 && pos >= CTXL) {
                            const float* rt = rope32 + ((size_t)(pos - CTXL) * 16 + ((within - 64) >> 1)) * 2;
                            const f32x4 cs0 = *(const f32x4*)rt, cs1 = *(const GAS f32x4*)(rt + 4);
                            const f32x4 a2 = (f32x4){a[0] * cs0[0] - a[1] * cs0[1], a[0] * cs0[1] + a[1] * cs0[0], a[2] * cs0[2] - a[3] * cs0[3], a[2] * cs0[3] + a[3] * cs0[2]};
                            const f32x4 b2 = (f32x4){b[0] * cs1[0] - b[1] * cs1[1], b[0] * cs1[1] + b[1] * cs1[0], b[2] * cs1[2] - b[3] * cs1[3], b[2] * cs1[3] + b[3] * cs1[2]};
                            a = a2; b = b2;
                        }
                        a = a * QS96; b = b * QS96;
                        *(GAS u32x4*)(Qm + (size_t)row * 384 + col) = pack8(a, b);
                    }
                } else {
                    const int col = pn * 256 + ct, head = col >> 7, within = col & 127;
                    if (within < 64) *(GAS u32x4*)(Km + (size_t)row * 384 + head * 96 + within) = pack8(a, b);
                    else *(GAS u32x4*)(Vm + (size_t)row * 256 + head * 64 + (within - 64)) = pack8(a, b);
                }
            } asm volatile("" ::: "memory"); }
    }
};
struct EpiL3C {
    int layer; const float* w0; const float* a0; const float* v0; const float* k_a;
    float* W; bf16_t* KD; bf16_t* BB; const bf16_t* Kr; const bf16_t* KK; bf16_t* V; const bf16_t* VF; bf16_t* Gg;
    DI void operator()(AccRef acc, const Unit& u, int wr, int wc, int fr, int fq) const {
        asm volatile("" : "+v"(fr), "+v"(fq));
        const int pn = u.pn;
        EPI_ROWS(u) { const int row = EPI_ROW(u);
#pragma unroll
            for (int bj = 0; bj < 2; ++bj) { f32x4 a = acc[ai][bj][m][0], b = acc[ai][bj][m][1]; const int ct = bj * 128 + wc * 32 + fq * 8;
                if (pn < 2) {
                    const f32x4 wa = *(const GAS f32x4*)(w0 + pn * 256 + ct), wb = *(const GAS f32x4*)(w0 + pn * 256 + ct + 4);
                    f32x4 oa, ob;
#pragma unroll
                    for (int j = 0; j < 4; ++j) { oa[j] = fast_exp2(-0.6065306597f * LOG2E * sigmoidf_(wa[j] + a[j])); ob[j] = fast_exp2(-0.6065306597f * LOG2E * sigmoidf_(wb[j] + b[j])); }
                    float* wp = W + (size_t)row * 512 + pn * 256 + ct; *(f32x4*)wp = oa; *(GAS f32x4*)(wp + 4) = ob;
                } else if (pn < 4) {
                    const int d = pn - 2;
                    const f32x4 aa = *(const GAS f32x4*)(a0 + d * 256 + ct), ab = *(const GAS f32x4*)(a0 + d * 256 + ct + 4);
                    const f32x4 ka = *(const GAS f32x4*)(k_a + ct), kb = *(const GAS f32x4*)(k_a + ct + 4);
                    f32x4 k0, k1, q0, q1; unpack8(*(const GAS u32x4*)(Kr + (size_t)row * 256 + ct), k0, k1); unpack8(*(const GAS u32x4*)(KK + (size_t)row * 256 + ct), q0, q1);
                    f32x4 kd0, kd1, bb0, bb1;
#pragma unroll
                    for (int j = 0; j < 4; ++j) { const float s0 = sigmoidf_(aa[j] + a[j]), s1 = sigmoidf_(ab[j] + b[j]);
                        kd0[j] = k0[j] * (1.0f + (s0 - 1.0f) * ka[j]); kd1[j] = k1[j] * (1.0f + (s1 - 1.0f) * kb[j]); bb0[j] = q0[j] * s0; bb1[j] = q1[j] * s1; }
                    *(GAS u32x4*)(KD + (size_t)row * 512 + d * 256 + ct) = pack8(kd0, kd1); *(GAS u32x4*)(BB + (size_t)row * 512 + d * 256 + ct) = pack8(bb0, bb1);
                } else if (pn == 4) {
                    const f32x4 va = *(const GAS f32x4*)(v0 + ct), vb = *(const GAS f32x4*)(v0 + ct + 4);
                    f32x4 r0, r1, f0, f1; unpack8(*(const GAS u32x4*)(V + (size_t)row * 256 + ct), r0, r1); unpack8(*(const GAS u32x4*)(VF + (size_t)row * 256 + ct), f0, f1);
#pragma unroll
                    for (int j = 0; j < 4; ++j) { r0[j] = r0[j] + (f0[j] - r0[j]) * sigmoidf_(va[j] + a[j]); r1[j] = r1[j] + (f1[j] - r1[j]) * sigmoidf_(vb[j] + b[j]); }
                    *(GAS u32x4*)(V + (size_t)row * 256 + ct) = pack8(r0, r1);
                } else {
                    *(GAS u32x4*)(Gg + (size_t)row * 256 + ct) = pack8(a, b);
                }
                asm volatile("" ::: "memory");
            } }
    }
};
struct EpiMerge {
    const bf16_t* P; bf16_t* MB; int init_br;
    DI void operator()(AccRef acc, const Unit& u, int wr, int wc, int fr, int fq) const {
        asm volatile("" : "+v"(fr), "+v"(fq));
        const int br = u.aux;
        const int col = u.pn * 256 + wc * 32 + fq * 8;
#pragma unroll
        for (int ai = 0; ai < 2; ++ai) {
            u32x4 gt[4][2], pm[4][2];
#pragma unroll
            for (int m = 0; m < 4; ++m) { const int row = EPI_ROW(u);
#pragma unroll
                for (int bj = 0; bj < 2; ++bj) { gt[m][bj] = *(const GAS u32x4*)(P + (size_t)row * LDP + PC_GATE + br * 1024 + col + bj * 128);
                    pm[m][bj] = br != init_br ? *(const GAS u32x4*)(MB + (size_t)row * 1024 + col + bj * 128) : (u32x4){0u, 0u, 0u, 0u}; } }
#pragma unroll
            for (int m = 0; m < 4; ++m) { const int row = EPI_ROW(u);
#pragma unroll
                for (int bj = 0; bj < 2; ++bj) { f32x4 g0, g1, p0, p1; unpack8(gt[m][bj], g0, g1); unpack8(pm[m][bj], p0, p1);
                    *(GAS u32x4*)(MB + (size_t)row * 1024 + col + bj * 128) = pack8(acc[ai][bj][m][0] * g0 + p0, acc[ai][bj][m][1] * g1 + p1); } }
            asm volatile("" ::: "memory");
        }
    }
};
struct EpiMergeP {
    const bf16_t* P; bf16_t* D;
    DI void operator()(AccRef acc, const Unit& u, int wr, int wc, int fr, int fq) const {
        asm volatile("" : "+v"(fr), "+v"(fq));
        const int br = u.aux;
        const int col = u.pn * 256 + wc * 32 + fq * 8;
#pragma unroll
        for (int ai = 0; ai < 2; ++ai) {
            u32x4 gt[4][2];
#pragma unroll
            for (int m = 0; m < 4; ++m) { const int row = EPI_ROW(u);
#pragma unroll
                for (int bj = 0; bj < 2; ++bj) gt[m][bj] = *(const GAS u32x4*)(P + (size_t)row * LDP + PC_GATE + br * 1024 + col + bj * 128); }
#pragma unroll
            for (int m = 0; m < 4; ++m) { const int row = EPI_ROW(u);
#pragma unroll
                for (int bj = 0; bj < 2; ++bj) { f32x4 g0, g1; unpack8(gt[m][bj], g0, g1);
                    *(GAS u32x4*)(D + (size_t)row * 1024 + col + bj * 128) = pack8(acc[ai][bj][m][0] * g0, acc[ai][bj][m][1] * g1); } }
            asm volatile("" ::: "memory");
        }
    }
};
struct EpiMergeA {
    const bf16_t* P; bf16_t* MB; const bf16_t* X1; const bf16_t* X2;
    DI void operator()(AccRef acc, const Unit& u, int wr, int wc, int fr, int fq) const {
        asm volatile("" : "+v"(fr), "+v"(fq));
        const int col = u.pn * 256 + wc * 32 + fq * 8;
#pragma unroll
        for (int ai = 0; ai < 2; ++ai) {
#pragma unroll
            for (int m = 0; m < 4; ++m) { const int row = EPI_ROW(u);
                u32x4 gt[2], pm[2], x1[2], x2[2];
#pragma unroll
                for (int bj = 0; bj < 2; ++bj) { const size_t o = (size_t)row * 1024 + col + bj * 128;
                    gt[bj] = *(const GAS u32x4*)(P + (size_t)row * LDP + PC_GATE + col + bj * 128); pm[bj] = *(const GAS u32x4*)(MB + o); x1[bj] = *(const GAS u32x4*)(X1 + o); x2[bj] = *(const GAS u32x4*)(X2 + o); }
#pragma unroll
                for (int bj = 0; bj < 2; ++bj) { f32x4 g0, g1, p0, p1, a0, a1, b0, b1; unpack8(gt[bj], g0, g1); unpack8(pm[bj], p0, p1); unpack8(x1[bj], a0, a1); unpack8(x2[bj], b0, b1);
                    *(GAS u32x4*)(MB + (size_t)row * 1024 + col + bj * 128) = pack8(acc[ai][bj][m][0] * g0 + ((p0 + a0) + b0), acc[ai][bj][m][1] * g1 + ((p1 + a1) + b1)); }
            }
            asm volatile("" ::: "memory");
        }
    }
};
struct EpiResid {
    float* X; const float* mod_l; int which;
    DI void operator()(AccRef acc, const Unit& u, int wr, int wc, int fr, int fq) const {
        asm volatile("" : "+v"(fr), "+v"(fq));
        const int vec = (u.pm % 33 == 0) ? 2 : u.pm / 33;
        const float* gv = mod_l + ((size_t)vec * 6 + which) * 1024 + u.pn * 256 + wc * 32 + fq * 8;
        f32x4 g[2][2];
#pragma unroll
        for (int bj = 0; bj < 2; ++bj) { g[bj][0] = *(const GAS f32x4*)(gv + bj * 128); g[bj][1] = *(const GAS f32x4*)(gv + bj * 128 + 4); }
#pragma unroll
        for (int ai = 0; ai < 2; ++ai)
#pragma unroll
            for (int mh = 0; mh < 2; ++mh) {
                f32x4 xv[2][2][2];
#pragma unroll
                for (int mm = 0; mm < 2; ++mm) { const int m = 2 * mh + mm; const float* xp = X + (size_t)EPI_ROW(u) * 1024 + u.pn * 256 + wc * 32 + fq * 8;
#pragma unroll
                    for (int bj = 0; bj < 2; ++bj) { xv[mm][bj][0] = *(const GAS f32x4*)(xp + bj * 128); xv[mm][bj][1] = *(const GAS f32x4*)(xp + bj * 128 + 4); } }
#pragma unroll
                for (int mm = 0; mm < 2; ++mm) { const int m = 2 * mh + mm; float* xp = X + (size_t)EPI_ROW(u) * 1024 + u.pn * 256 + wc * 32 + fq * 8;
#pragma unroll
                    for (int bj = 0; bj < 2; ++bj) { *(GAS f32x4*)(xp + bj * 128) = xv[mm][bj][0] + g[bj][0] * acc[ai][bj][m][0]; *(GAS f32x4*)(xp + bj * 128 + 4) = xv[mm][bj][1] + g[bj][1] * acc[ai][bj][m][1]; } }
                asm volatile("" ::: "memory");
            }
    }
};
struct EpiSlab {
    float* slab;
    DI void operator()(AccRef acc, const Unit& u, int wr, int wc, int fr, int fq) const {
        asm volatile("" : "+v"(fr), "+v"(fq));
        const int crow0 = (u.pm == 33 ? 256 : 0) - u.pm * 256;
        EPI_ROWS(u) { float* xp = slab + ((size_t)u.aux * 512 + (size_t)(EPI_ROW(u) + crow0)) * 1024 + u.pn * 256 + wc * 32 + fq * 8;
#pragma unroll
            for (int bj = 0; bj < 2; ++bj) { *(GAS f32x4*)(xp + bj * 128) = acc[ai][bj][m][0]; *(GAS f32x4*)(xp + bj * 128 + 4) = acc[ai][bj][m][1]; }
            asm volatile("" ::: "memory"); }
    }
};
struct EpiSwiGlu {
    bf16_t* U; int moe;
    DI void operator()(AccRef acc, const Unit& u, int wr, int wc, int fr, int fq) const {
        asm volatile("" : "+v"(fr), "+v"(fq));
        const int tile = moe ? u.aux : u.pn;
        EPI_ROWS(u) { bf16_t* up = U + (size_t)EPI_ROW(u) * DFF + tile * 128 + wc * 32 + fq * 8;
            f32x4 a = acc[ai][0][m][0], b = acc[ai][0][m][1]; const f32x4 c = acc[ai][1][m][0], d = acc[ai][1][m][1];
#pragma unroll
            for (int j = 0; j < 4; ++j) { a[j] = siluf_(a[j]) * c[j]; b[j] = siluf_(b[j]) * d[j]; }
            *(u32x4*)up = pack8(a, b); asm volatile("" ::: "memory"); }
    }
};
struct EpiMoeDown {
    bf16_t* Yg; const float* rowgate;
    DI void operator()(AccRef acc, const Unit& u, int wr, int wc, int fr, int fq) const {
        asm volatile("" : "+v"(fr), "+v"(fq));
        EPI_ROWS(u) { const int row = EPI_ROW(u); const float gt = *(const GAS float*)(rowgate + row); bf16_t* yp = Yg + (size_t)row * 1024 + u.aux * 256 + wc * 32 + fq * 8;
#pragma unroll
            for (int bj = 0; bj < 2; ++bj) *(GAS u32x4*)(yp + bj * 128) = pack8(acc[ai][bj][m][0] * gt, acc[ai][bj][m][1] * gt);
            asm volatile("" ::: "memory"); }
    }
};
struct ConvMat { const float* s0; const float* s1; int ld; int ksrc; bf16_t* dst; int N; int K; int kind; int nvalid; };
DI int perm64(int i) { return (i >> 1) + 32 * (i & 1); }
DI int perm32r(int i) { return (i >> 1) + 16 * (i & 1); }
DI const float* conv_col(const ConvMat& M, int n) {
    if (M.kind == 0) return n < M.nvalid ? M.s0 + n : nullptr;
    if (M.kind == 1) {
        int col;
        if (n < 1024) col = n;
        else if (n < 1280) { const int j = n - 1024; col = 1024 + (j & ~63) + perm64(j & 63); }
        else if (n < 1408) { const int j = n - 1280; col = 1280 + (j & ~63) + perm64(j & 63); }
        else if (n < 1920) col = n;
        else if (n < 1952) col = 1920 + perm32r(n - 1920);
        else if (n < 2048) return nullptr;
        else if (n < 2304) { const int j = n - 2048; col = 1952 + (j & ~63) + perm64(j & 63); }
        else if (n < 2432) { const int j = n - 2304; col = 2208 + (j & ~63) + perm64(j & 63); }
        else if (n < 2560) col = 2336 + (n - 2432);
        else col = 2464 + (n - 2560);
        return M.s0 + col;
    }
    if (M.kind == 2) {
        if (n >= 384) return nullptr;
        const int h = n / 96, w = n % 96;
        return M.s0 + (w < 64 ? n : h * 96 + 64 + perm32r(w - 64));
    }
    {
        const int t = n >> 8, half = (n >> 7) & 1, j = n & 127;
        return (const float*)((uintptr_t)M.s0 + (uintptr_t)half * ((uintptr_t)M.s1 - (uintptr_t)M.s0)) + t * 128 + j;
    }
}
DI void conv_item(const ConvMat& M, int item, LAS float* scr, int lane) {
    const int nkb = M.K / 64, nb = item / nkb, kb = item % nkb, n0 = nb * 32, k0 = kb * 64;
    const float* cp = conv_col(M, n0 + (lane & 31));
#pragma unroll 8
    for (int i = 0; i < 32; ++i) { const int kk = 2 * i + (lane >> 5); const int k = k0 + kk;
        float v = 0.f; if (cp != nullptr && k < M.ksrc) v = *(const GAS float*)(cp + (size_t)k * M.ld);
        scr[kk * 33 + (lane & 31)] = v; }
    LDS_WAIT(); asm volatile("" ::: "memory");
    const int c = lane & 7;
#pragma unroll
    for (int j = 0; j < 4; ++j) { const int n = (lane >> 3) + 8 * j; const LAS float* s = scr + (8 * c) * 33 + n;
        u32x4 o; o.x = pk2(s[0 * 33], s[1 * 33]); o.y = pk2(s[2 * 33], s[3 * 33]); o.z = pk2(s[4 * 33], s[5 * 33]); o.w = pk2(s[6 * 33], s[7 * 33]);
        *(GAS u32x4*)(M.dst + (size_t)(n0 + n) * M.K + k0 + 8 * c) = o; }
    LDS_WAIT(); asm volatile("" ::: "memory");
}
DI ConvMat mkmat(const float* s0, const float* s1, int ld, int ksrc, bf16_t* dst, int N, int K, int kind, int nvalid) { ConvMat M; M.s0 = s0; M.s1 = s1; M.ld = ld; M.ksrc = ksrc; M.dst = dst; M.N = N; M.K = K; M.kind = kind; M.nvalid = nvalid; return M; }
DI bool conv_slow_block(const ConvMat& M, int b128) { return M.kind == 2 || (M.kind == 1 && ((b128 >= 8 && b128 <= 10) || (b128 >= 15 && b128 <= 18))); }
DI void conv_item_fast(const ConvMat& M, int item, LAS bf16_t* scr, int lane) {
    const int nkb = M.K / 32, nb = item / nkb, kb = item % nkb, n0 = nb * 128, k0 = kb * 32;
    if (conv_slow_block(M, nb)) return;
    const float* cp = conv_col(M, n0);
    int nv = 128; if (M.kind == 0) { nv = M.nvalid - n0; nv = nv < 0 ? 0 : (nv > 128 ? 128 : nv); }
    const int q = lane & 31, kr = lane >> 5;
    const bool cok = cp != nullptr && 4 * q < nv;
    f32x4 v[16];
#pragma unroll
    for (int i = 0; i < 16; ++i) { const int k = k0 + 2 * i + kr; v[i] = (cok && k < M.ksrc) ? *(const GAS f32x4*)(cp + (size_t)k * M.ld + 4 * q) : (f32x4){0.f, 0.f, 0.f, 0.f}; }
#pragma unroll
    for (int i = 0; i < 16; ++i) { u32x2 o; o.x = pk2(v[i][0], v[i][1]); o.y = pk2(v[i][2], v[i][3]); *(LAS u32x2*)(scr + (2 * i + kr) * 132 + 4 * q) = o; }
    LDS_WAIT(); asm volatile("" ::: "memory");
#pragma unroll
    for (int p = 0; p < 2; ++p)
#pragma unroll
        for (int c = 0; c < 4; ++c) { const int n = lane + 64 * p; const LAS bf16_t* sp = scr + (8 * c) * 132 + n;
            u32x4 o; o.x = (unsigned)sp[0] | ((unsigned)sp[132] << 16); o.y = (unsigned)sp[2 * 132] | ((unsigned)sp[3 * 132] << 16); o.z = (unsigned)sp[4 * 132] | ((unsigned)sp[5 * 132] << 16); o.w = (unsigned)sp[6 * 132] | ((unsigned)sp[7 * 132] << 16);
            *(GAS u32x4*)(M.dst + (size_t)(n0 + n) * M.K + k0 + 8 * c) = o; }
    LDS_WAIT(); asm volatile("" ::: "memory");
}
struct ConvSel { int mode, lo, hi; };
DI void conv_run(Frame& F, const ConvMat M, int& gbase, const ConvSel sel) {
    LAS float* scr = (LAS float*)(F.lds + F.wave * 16384);
    const int gw = F.vcu * 8 + F.wave, NGW = F.G * 8;
    {
        const int nitems = (M.N / 128) * (M.K / 32);
        int it, step;
        if (sel.mode == 0) { it = (gw - gbase % NGW) % NGW; if (it < 0) it += NGW; step = NGW; }
        else { int f = sel.lo - gbase; if (f < 0) f = 0; const int ph = (gbase + f - sel.lo) & 7; it = f + ((F.wave - ph) & 7); step = 8; }
        const int end = sel.mode == 0 ? nitems : ((sel.hi - gbase) < nitems ? (sel.hi - gbase) : nitems);
        for (; it < end; it += step) conv_item_fast(M, it, (LAS bf16_t*)scr, F.lane);
        gbase += nitems;
    }
    if (M.kind == 1 || M.kind == 2) {
        const int nkb = M.K / 64;
        const int nrow32 = M.kind == 2 ? M.N / 32 : 28;
        const int nitems = nrow32 * nkb;
        int it, step;
        if (sel.mode == 0) { it = (gw - gbase % NGW) % NGW; if (it < 0) it += NGW; step = NGW; }
        else { int f = sel.lo - gbase; if (f < 0) f = 0; const int ph = (gbase + f - sel.lo) & 7; it = f + ((F.wave - ph) & 7); step = 8; }
        const int end = sel.mode == 0 ? nitems : ((sel.hi - gbase) < nitems ? (sel.hi - gbase) : nitems);
        for (; it < end; it += step) { int rb = it / nkb; const int kb = it % nkb;
            if (M.kind == 1) rb = rb < 12 ? 32 + rb : 60 + (rb - 12);
            conv_item(M, rb * nkb + kb, scr, F.lane); }
        gbase += nitems;
    }
}
DI int convert_layer_weights(Frame& F, int l, const ConvSel sel) {
    unsigned char* wl = F.ws + ((l & 1) ? WS_WL : WS_WLB);
    int start = 0;
    conv_run(F, mkmat(inp(I_WIN) + (size_t)l * 1024 * IN_W, nullptr, IN_W, 1024, (bf16_t*)(wl + WL_WIN), NP_GEMM, 1024, 1, NP_GEMM), start, sel);
    for (int i = 0; i < 4; ++i) conv_run(F, mkmat(inp(I_WBR) + (size_t)(l * 4 + i) * 256 * 1024, nullptr, 1024, 256, (bf16_t*)(wl + WL_WBR) + (size_t)i * 1024 * 256, 1024, 256, 0, 1024), start, sel);
    conv_run(F, mkmat(inp(I_WOUT) + (size_t)l * 1024 * 1024, nullptr, 1024, 1024, (bf16_t*)(wl + WL_WOUT), 1024, 1024, 0, 1024), start, sel);
    for (int d = 0; d < 2; ++d) conv_run(F, mkmat(inp(I_W1) + (size_t)(l * 2 + d) * 256 * 64, nullptr, 64, 256, (bf16_t*)(wl + WL_L1) + (size_t)d * 256 * 256, 256, 256, 0, 64), start, sel);
    for (int d = 0; d < 2; ++d) conv_run(F, mkmat(inp(I_A1) + (size_t)(l * 2 + d) * 256 * 64, nullptr, 64, 256, (bf16_t*)(wl + WL_L1) + (size_t)(2 + d) * 256 * 256, 256, 256, 0, 64), start, sel);
    conv_run(F, mkmat(inp(I_V1) + (size_t)(l > 0 ? l - 1 : 0) * 256 * 32, nullptr, 32, 256, (bf16_t*)(wl + WL_L1) + (size_t)4 * 256 * 256, 256, 256, 0, l > 0 ? 32 : 0), start, sel);
    conv_run(F, mkmat(inp(I_G1) + (size_t)l * 256 * 128, nullptr, 128, 256, (bf16_t*)(wl + WL_L1) + (size_t)5 * 256 * 256, 256, 256, 0, 128), start, sel);
    for (int d = 0; d < 2; ++d) conv_run(F, mkmat(inp(I_W2) + (size_t)(l * 2 + d) * 64 * 256, nullptr, 256, 64, (bf16_t*)(wl + WL_L2) + (size_t)d * 256 * 256, 256, 256, 0, 256), start, sel);
    for (int d = 0; d < 2; ++d) conv_run(F, mkmat(inp(I_A2) + (size_t)(l * 2 + d) * 64 * 256, nullptr, 256, 64, (bf16_t*)(wl + WL_L2) + (size_t)(2 + d) * 256 * 256, 256, 256, 0, 256), start, sel);
    conv_run(F, mkmat(inp(I_V2) + (size_t)(l > 0 ? l - 1 : 0) * 32 * 256, nullptr, 256, l > 0 ? 32 : 0, (bf16_t*)(wl + WL_L2) + (size_t)4 * 256 * 256, 256, 256, 0, 256), start, sel);
    conv_run(F, mkmat(inp(I_G2) + (size_t)l * 128 * 256, nullptr, 256, 128, (bf16_t*)(wl + WL_L2) + (size_t)5 * 256 * 256, 256, 256, 0, 256), start, sel);
    conv_run(F, mkmat(inp(I_WUQ) + (size_t)l * 256 * 384, nullptr, 384, 256, (bf16_t*)(wl + WL_UQ), 512, 256, 2, 384), start, sel);
    conv_run(F, mkmat(inp(I_WUKV) + (size_t)l * 128 * 512, nullptr, 512, 128, (bf16_t*)(wl + WL_UKV), 512, 256, 0, 512), start, sel);
    if ((l & 1) == 0) {
        conv_run(F, mkmat(inp(I_FW1) + (size_t)(l >> 1) * 1024 * DFF, inp(I_FW3) + (size_t)(l >> 1) * 1024 * DFF, DFF, 1024, (bf16_t*)(wl + WL_W13), 7168, 1024, 3, 7168), start, sel);
        conv_run(F, mkmat(inp(I_FW2) + (size_t)(l >> 1) * DFF * 1024, nullptr, 1024, DFF, (bf16_t*)(wl + WL_W2D), 1024, DFF, 0, 1024), start, sel);
    } else {
        for (int e = 0; e < NEXP; ++e) { const size_t eo = (size_t)((l >> 1) * NEXP + e) * 1024 * DFF;
            conv_run(F, mkmat(inp(I_MW1) + eo, inp(I_MW3) + eo, DFF, 1024, (bf16_t*)(wl + WL_W13) + (size_t)e * 7168 * 1024, 7168, 1024, 3, 7168), start, sel); }
        for (int e = 0; e < NEXP; ++e)
            conv_run(F, mkmat(inp(I_MW2) + (size_t)((l >> 1) * NEXP + e) * DFF * 1024, nullptr, 1024, DFF, (bf16_t*)(wl + WL_W2) + (size_t)e * 1024 * DFF, 1024, DFF, 0, 1024), start, sel);
    }
    return start;
}

DI void p0_prologue(Frame& F) {
    convert_layer_weights(F, 0, ConvSel{0, 0, 0});
    const int gw = F.vcu * 8 + F.wave, NGW = F.G * 8;
    for (int r = gw; r < NROW; r += NGW) {
        const int b = r / TPB, pos = r % TPB;
        const float* src = pos < CTXL ? inp(I_CTX) + ((size_t)b * CTXL + pos) * 1024 : inp(I_X) + ((size_t)b * SEQ + (pos - CTXL)) * 1024;
        const GAS f32x4* s4 = (const GAS f32x4*)src + F.lane; GAS f32x4* d4 = (GAS f32x4*)(FX(F) + (size_t)r * 1024) + F.lane;
#pragma unroll
        for (int j = 0; j < 4; ++j) d4[64 * j] = s4[64 * j];
    }
    {
        float* r64 = (float*)(F.ws + WS_ROPE64); float* r32 = (float*)(F.ws + WS_ROPE32);
        const int gt = (F.vcu * 512 + F.tid), NT = F.G * 512;
        for (int i = gt; i < SEQ * 48; i += NT) {
            const int t = i / 48, q = i % 48; const float row = (float)(t / GRIDW), col = (float)(t % GRIDW);
            float ang;
            if (q < 32) { const int f = q & 15; ang = (q < 16 ? row : col) * powf(10000.0f, -(float)f / 16.0f); }
            else { const int p = q - 32, f = p & 7; ang = (p < 8 ? row : col) * powf(10000.0f, -(float)f / 8.0f); }
            float sn, cs; sincosf(ang, &sn, &cs);
            if (q < 32) { r64[((size_t)t * 32 + q) * 2] = cs; r64[((size_t)t * 32 + q) * 2 + 1] = sn; }
            else { r32[((size_t)t * 16 + (q - 32)) * 2] = cs; r32[((size_t)t * 16 + (q - 32)) * 2 + 1] = sn; }
        }
    }
    __syncthreads();
    {
        LAS float* sl = (LAS float*)F.lds;
        LAS float* red = sl + 3072;
        for (int i = F.tid; i < 3072; i += 512) { const int v = i >> 10, k = i & 1023; const float cvv = v < 2 ? *(const GAS float*)(inp(I_C) + v * 1024 + k) : *(const GAS float*)(inp(I_CCTX) + k); sl[i] = siluf_(cvv); }
        __syncthreads();
        const int q = F.lane, ks = F.wave;
        for (int ch = F.vcu; ch < 4 * 24; ch += F.G) {
            const int l = ch / 24, jb = (ch % 24) * 256 + 4 * q;
            const float* wp = inp(I_WMOD) + (size_t)l * 1024 * 6144 + jb;
            f32x4 a0 = (f32x4){0.f, 0.f, 0.f, 0.f}, a1 = a0, a2 = a0;
#pragma unroll 8
            for (int k = ks * 128; k < ks * 128 + 128; ++k) { const f32x4 w = *(const GAS f32x4*)(wp + (size_t)k * 6144); a0 = a0 + w * sl[k]; a1 = a1 + w * sl[1024 + k]; a2 = a2 + w * sl[2048 + k]; }
            *(LAS f32x4*)(red + (ks * 3 + 0) * 256 + 4 * q) = a0; *(LAS f32x4*)(red + (ks * 3 + 1) * 256 + 4 * q) = a1; *(LAS f32x4*)(red + (ks * 3 + 2) * 256 + 4 * q) = a2;
            __syncthreads();
            if (F.tid < 192) { const int v = F.tid >> 6; f32x4 s4 = *(const GAS f32x4*)(inp(I_BMOD) + l * 6144 + jb);
#pragma unroll
                for (int w8 = 0; w8 < 8; ++w8) s4 = s4 + *(const LAS f32x4*)(red + (w8 * 3 + v) * 256 + 4 * q);
                *(GAS f32x4*)(FMOD(F) + (size_t)(l * 3 + v) * 6144 + jb) = s4; }
            __syncthreads();
        }
    }
}

template <int MODE>
DI void norm_phase(Frame& F, int l, float probe_scale = 1.0f) {
    const int rpw = (NROW + F.G - 1) / F.G;
    const int bid = F.bx;
    const int r0 = bid * rpw, r1 = (r0 + rpw) < NROW ? (r0 + rpw) : NROW;
    const bool combine = (MODE == 0 && l > 0 && ((l - 1) & 1)) || MODE == 2;
    const int lprev = MODE == 2 ? DEPTH - 1 : l - 1;
    const bool moe = (MODE == 1) && (l & 1);
    const bool skipctx = MODE == 2 || (MODE == 1 && l == DEPTH - 1);
    const float* nw = MODE == 0 ? inp(I_NORM1) + l * 1024 : MODE == 1 ? inp(I_NORM2) + l * 1024 : inp(I_FNORM);
    const bf16_t* Yg = (const bf16_t*)(F.ws + WS_YG);
    const int* dstp = (const int*)(F.ws + WS_ASG_DST);
    volatile LAS int* hist = (volatile LAS int*)(F.lds + MISC_OFF + 64);
    if (moe) { if (F.tid < 8) hist[F.tid] = 0; __syncthreads(); }
    f32x4 nx[2][4]; u32x2 ny0[2][4], ny1[2][4];
#define NORM_LOAD(set, rr) do { const GAS f32x4* xp_ = (const GAS f32x4*)(FX(F) + (size_t)(rr) * 1024) + F.lane; \
        _Pragma("unroll") for (int j = 0; j < 4; ++j) nx[set][j] = xp_[64 * j]; \
        if (combine && !(skipctx && ((rr) % TPB) < CTXL)) { const int d0_ = *(const GAS int*)(dstp + (rr) * 2), d1_ = *(const GAS int*)(dstp + (rr) * 2 + 1); \
            _Pragma("unroll") for (int j = 0; j < 4; ++j) { const int c_ = 4 * F.lane + 256 * j; ny0[set][j] = *(const GAS u32x2*)(Yg + (size_t)d0_ * 1024 + c_); ny1[set][j] = *(const GAS u32x2*)(Yg + (size_t)d1_ * 1024 + c_); } } } while (0)
    f32x4 nwv[4];
#pragma unroll
    for (int j = 0; j < 4; ++j) nwv[j] = *(const GAS f32x4*)(nw + 4 * F.lane + 256 * j);
    int cur_vec = -1; f32x4 scv[4], shv[4];
    float one_ = 1.f, zero_ = 0.f; asm volatile("" : "+v"(one_), "+v"(zero_));
#pragma unroll
    for (int j = 0; j < 4; ++j) { scv[j] = (f32x4){one_, one_, one_, one_}; shv[j] = (f32x4){zero_, zero_, zero_, zero_}; }
    if (r0 + F.wave < r1) NORM_LOAD(0, r0 + F.wave);
    if (r0 + F.wave + 8 < r1) NORM_LOAD(1, r0 + F.wave + 8);
    for (int rr = r0 + F.wave; rr < r1; rr += 16)
#pragma unroll
    for (int half = 0; half < 2; ++half) {
        const int r = rr + 8 * half; if (r >= r1) break;
        const int vec = row_vec(r);
        float* xr = FX(F) + (size_t)r * 1024;
        f32x4 x[4]; u32x2 y0[4], y1[4];
#pragma unroll
        for (int j = 0; j < 4; ++j) { x[j] = nx[half][j]; y0[j] = ny0[half][j]; y1[j] = ny1[half][j]; }
        if (r + 16 < r1) NORM_LOAD(half, r + 16);
        if (skipctx && (r % TPB) < CTXL) continue;
        if (combine) {
            const float* g2 = modp(F, lprev, vec, 5);
#pragma unroll
            for (int j = 0; j < 4; ++j) { const int c = 4 * F.lane + 256 * j; const f32x4 g = *(const GAS f32x4*)(g2 + c);
                x[j][0] += g[0] * (bflo(y0[j].x) + bflo(y1[j].x)); x[j][1] += g[1] * (bfhi(y0[j].x) + bfhi(y1[j].x)); x[j][2] += g[2] * (bflo(y0[j].y) + bflo(y1[j].y)); x[j][3] += g[3] * (bfhi(y0[j].y) + bfhi(y1[j].y));
                if (MODE == 0) *((GAS f32x4*)xr + F.lane + 64 * j) = x[j]; }
        }
        {
            const int nsl = 0;
            const int pos = r % TPB;
            if (nsl > 0 && pos < CTXL) {
                const int crow = (r / TPB) * 256 + pos;
                const float* gsl = (MODE == 1) ? modp(F, l, 2, 2) : modp(F, l - 1, 2, 5);
                const float* sl = (const float*)(F.ws + WS_SLAB) + (size_t)crow * 1024;
#pragma unroll
                for (int j = 0; j < 4; ++j) { const int c = 4 * F.lane + 256 * j; f32x4 a = *(const GAS f32x4*)(sl + c);
                    for (int q = 1; q < nsl; ++q) a = a + *(const GAS f32x4*)(sl + (size_t)q * 512 * 1024 + c);
                    x[j] = x[j] + *(const GAS f32x4*)(gsl + c) * a; *((GAS f32x4*)xr + F.lane + 64 * j) = x[j]; }
            }
        }
        float ss = 0.f;
#pragma unroll
        for (int j = 0; j < 4; ++j) ss += (x[j][0] * x[j][0] + x[j][1] * x[j][1]) + (x[j][2] * x[j][2] + x[j][3] * x[j][3]);
        const float rstd = 1.0f / sqrtf(wave_sum(ss) * (1.0f / 1024.0f) + 1e-6f);
        if (MODE == 2) {
            const int pos = r % TPB;
            if (pos >= CTXL) { float* op = F.out + ((size_t)(r / TPB) * SEQ + (pos - CTXL)) * 1024;
#pragma unroll
                for (int j = 0; j < 4; ++j) *((GAS f32x4*)op + F.lane + 64 * j) = x[j] * rstd * nwv[j] * probe_scale; }
            continue;
        }
        if (vec != cur_vec) {
            cur_vec = vec; const float* sc = modp(F, l, vec, MODE == 0 ? 1 : 4); const float* sh = modp(F, l, vec, MODE == 0 ? 0 : 3);
#pragma unroll
            for (int j = 0; j < 4; ++j) { const int c = 4 * F.lane + 256 * j; scv[j] = 1.0f + *(const GAS f32x4*)(sc + c); shv[j] = *(const GAS f32x4*)(sh + c); }
        }
        f32x4 h[4];
#pragma unroll
        for (int j = 0; j < 4; ++j) { const int c = 4 * F.lane + 256 * j;
            h[j] = (x[j] * rstd * nwv[j]) * scv[j] + shv[j];
            u32x2 o; o.x = pk2(h[j][0], h[j][1]); o.y = pk2(h[j][2], h[j][3]); *(GAS u32x2*)(FHB(F) + (size_t)r * 1024 + c) = o; }
        if (moe) {
            const float* wr = inp(I_ROUTER) + (size_t)(l >> 1) * 1024 * NEXP;
            float lg[8];
#pragma unroll
            for (int e = 0; e < 8; ++e) lg[e] = 0.f;
#pragma unroll
            for (int j = 0; j < 4; ++j)
#pragma unroll
                for (int q = 0; q < 4; ++q) { const int c = 4 * F.lane + 256 * j + q; const f32x4 w0 = *(const GAS f32x4*)(wr + (size_t)c * 8), w1 = *(const GAS f32x4*)(wr + (size_t)c * 8 + 4); const float hv = h[j][q];
                    lg[0] += hv * w0[0]; lg[1] += hv * w0[1]; lg[2] += hv * w0[2]; lg[3] += hv * w0[3]; lg[4] += hv * w1[0]; lg[5] += hv * w1[1]; lg[6] += hv * w1[2]; lg[7] += hv * w1[3]; }
#pragma unroll
            for (int e = 0; e < 8; ++e) lg[e] = wave_sum(lg[e]);
            int e1 = 0; float l1 = lg[0];
#pragma unroll
            for (int e = 1; e < 8; ++e) if (lg[e] > l1) { l1 = lg[e]; e1 = e; }
            int e2 = -1; float l2 = -3.0e38f;
#pragma unroll
            for (int e = 0; e < 8; ++e) if (e != e1 && lg[e] > l2) { l2 = lg[e]; e2 = e; }
            if (e2 < 0) e2 = (e1 + 1) & 7;
            if (F.lane == 0) {
                const float ex = __expf(l2 - l1); const float g1v = 1.0f / (1.0f + ex), g2v = ex / (1.0f + ex);
                const int lp1 = __hip_atomic_fetch_add((LAS int*)&hist[e1], 1, __ATOMIC_RELAXED, __HIP_MEMORY_SCOPE_WORKGROUP);
                const int lp2 = __hip_atomic_fetch_add((LAS int*)&hist[e2], 1, __ATOMIC_RELAXED, __HIP_MEMORY_SCOPE_WORKGROUP);
                int* asg = (int*)(F.ws + WS_ASG) + (size_t)r * 4; asg[0] = e1 | (e2 << 8); asg[1] = lp1; asg[2] = lp2;
                float* ag = (float*)(F.ws + WS_ASG_GATE) + (size_t)r * 2; ag[0] = g1v; ag[1] = g2v;
            }
        }
    }
#undef NORM_LOAD
    if (moe) {
        __syncthreads();
        if (F.tid < 8) { const int cnt = hist[F.tid]; const int bank = l >> 1;
            const unsigned base = cnt > 0 ? __hip_atomic_fetch_add(F.ctl + CW_MOECNT + bank * 64 + F.tid, (unsigned)cnt, __ATOMIC_RELAXED, __HIP_MEMORY_SCOPE_AGENT) : 0u;
            F.ctl[CW_WGBASE + (bank * 256 + bid) * 8 + F.tid] = base; }
    }
}
DI void moe_panels(const Frame& F, int l, int (&cp)[9]) {
    int acc = 0;
#pragma unroll
    for (int e = 0; e < 8; ++e) { cp[e] = acc; const unsigned c = __hip_atomic_load(F.ctl + CW_MOECNT + (l >> 1) * 64 + e, __ATOMIC_RELAXED, __HIP_MEMORY_SCOPE_AGENT); acc += (int)((c + 255u) >> 8); }
    cp[8] = acc;
#pragma unroll
    for (int e = 0; e < 9; ++e) cp[e] = __builtin_amdgcn_readfirstlane(cp[e]);
}
DI void moe_gather(Frame& F, int l) {
    int cp[9]; moe_panels(F, l, cp);
    const int rpw = (NROW + F.G - 1) / F.G; const int bid = F.bx;
    const int r0 = bid * rpw, r1 = (r0 + rpw) < NROW ? (r0 + rpw) : NROW;
    bf16_t* Xg = (bf16_t*)(F.ws + WS_XG); float* rowgate = (float*)(F.ws + WS_ROWGATE); int* dstp = (int*)(F.ws + WS_ASG_DST);
    const unsigned* wgb = F.ctl + CW_WGBASE + ((l >> 1) * 256 + bid) * 8;
    for (int r = r0 + F.wave; r < r1; r += 8) {
        if (l == DEPTH - 1 && (r % TPB) < CTXL) continue;
        const int* asg = (const int*)(F.ws + WS_ASG) + (size_t)r * 4; const float* ag = (const float*)(F.ws + WS_ASG_GATE) + (size_t)r * 2;
        const int ee = asg[0], e1 = ee & 255, e2 = ee >> 8;
        int cpa = 0, cpb = 0;
#pragma unroll
        for (int e = 0; e < 8; ++e) { cpa = (e == e1) ? cp[e] : cpa; cpb = (e == e2) ? cp[e] : cpb; }
        const int d0 = cpa * 256 + (int)wgb[e1] + asg[1], d1 = cpb * 256 + (int)wgb[e2] + asg[2];
        const GAS u32x4* src = (const GAS u32x4*)(FHB(F) + (size_t)r * 1024) + F.lane;
        const u32x4 v0 = src[0], v1 = src[64];
        GAS u32x4* p0 = (GAS u32x4*)(Xg + (size_t)d0 * 1024) + F.lane; GAS u32x4* p1 = (GAS u32x4*)(Xg + (size_t)d1 * 1024) + F.lane;
        p0[0] = v0; p0[64] = v1; p1[0] = v0; p1[64] = v1;
        if (F.lane == 0) { rowgate[d0] = ag[0]; rowgate[d1] = ag[1]; dstp[r * 2] = d0; dstp[r * 2 + 1] = d1; }
    }
}

DI f32x4 ld4bf(const bf16_t* p) { const u32x2 w = *(const u32x2*)p; return (f32x4){bflo(w.x), bfhi(w.x), bflo(w.y), bfhi(w.y)}; }
DI void st4bf(bf16_t* p, const f32x4 v) { u32x2 o; o.x = pk2(v[0], v[1]); o.y = pk2(v[2], v[3]); *(u32x2*)p = o; }
DI f32x4 rope2(const f32x4 v, const float* cs) {
    const f32x4 t = *(const GAS f32x4*)cs;
    return (f32x4){v[0] * t[0] - v[1] * t[1], v[0] * t[1] + v[1] * t[0], v[2] * t[2] - v[3] * t[3], v[2] * t[3] + v[3] * t[2]};
}
DI u32x2 ld8(const bf16_t* p) { return *(const GAS u32x2*)p; }
DI f32x4 bf4(const u32x2 w) { return (f32x4){bflo(w.x), bfhi(w.x), bflo(w.y), bfhi(w.y)}; }
DI f32x4 rope2v(const f32x4 v, const f32x4 t) { return (f32x4){v[0] * t[0] - v[1] * t[1], v[0] * t[1] + v[1] * t[0], v[2] * t[2] - v[3] * t[3], v[2] * t[3] + v[3] * t[2]}; }
DI void prep_phase(Frame& F, int l) {
    const int gw = F.vcu * 8 + F.wave, NGW = F.G * 8, lane = F.lane;
    bf16_t* RR = (bf16_t*)(F.ws + WS_RR); bf16_t* KK = (bf16_t*)(F.ws + WS_KK); bf16_t* KR = (bf16_t*)(F.ws + WS_KR); bf16_t* V = (bf16_t*)(F.ws + WS_V); bf16_t* VF = (bf16_t*)(F.ws + WS_VF);
    bf16_t* Km = (bf16_t*)(F.ws + WS_KMLA);
    const float* r64 = (const float*)(F.ws + WS_ROPE64); const float* r32 = (const float*)(F.ws + WS_ROPE32);
    const float* mu = inp(I_MU) + (size_t)l * 2048;
    const int c4 = 4 * lane;
    f32x4 m0[4], m1[4];
#pragma unroll
    for (int s = 0; s < 4; ++s) { m0[s] = *(const GAS f32x4*)(mu + s * 256 + c4); m1[s] = *(const GAS f32x4*)(mu + 1024 + s * 256 + c4); }
    const f32x4 kkv = *(const GAS f32x4*)(inp(I_KK) + l * 256 + c4), mqn = *(const GAS f32x4*)(inp(I_MQN) + l * 256 + c4);
    const f32x4 mkvn = lane < 32 ? *(const GAS f32x4*)(inp(I_MKVN) + l * 128 + c4) : (f32x4){0.f, 0.f, 0.f, 0.f};
    const int i0 = c4 & 63, pi = i0 >> 1;
    f32x4 gq, gk;
    { const float* gqp = inp(I_GQN) + l * 64; const float* gkp = inp(I_GKN) + l * 64;
#pragma unroll
      for (int j = 0; j < 4; ++j) { gq[j] = *(const GAS float*)(gqp + perm64(i0 + j)); gk[j] = *(const GAS float*)(gkp + perm64(i0 + j)); } }
    struct PrepRaw { u32x2 rf[4], rp[4], rn[4], rswq, rcq, rgaq, rswk, rckv, rgak, rkr; f32x4 cs64, cs32; };
    const u32x2 zz = (u32x2){0u, 0u};
#define PREP_LOAD(R, rr) do { const int pos_ = (rr) % TPB; const bool isctx_ = pos_ < CTXL; const int t_ = isctx_ ? 0 : pos_ - CTXL; \
        const bool hasp_ = isctx_ ? (pos_ > 0) : (pos_ > CTXL), hasn_ = isctx_ ? (pos_ < CTXL - 1) : (pos_ < TPB - 1); \
        const bf16_t* pr_ = FP(F) + (size_t)(rr) * LDP; \
        _Pragma("unroll") for (int s = 0; s < 4; ++s) { R.rf[s] = ld8(pr_ + s * 256 + c4); R.rp[s] = hasp_ ? ld8(pr_ - LDP + s * 256 + c4) : zz; R.rn[s] = hasn_ ? ld8(pr_ + LDP + s * 256 + c4) : zz; } \
        R.rswq = ld8(pr_ + PC_SWQ + c4); R.rcq = ld8(pr_ + PC_CQ + c4); R.rgaq = ld8(pr_ + PC_GAQ + c4); \
        R.rswk = lane < 32 ? ld8(pr_ + PC_SWK + c4) : zz; R.rckv = lane < 32 ? ld8(pr_ + PC_CKV + c4) : zz; R.rgak = lane < 32 ? ld8(pr_ + PC_GAK + c4) : zz; \
        R.rkr = lane < 8 ? ld8(pr_ + PC_KR + c4) : zz; \
        R.cs64 = *(const GAS f32x4*)(r64 + ((size_t)t_ * 32 + pi) * 2); R.cs32 = *(const GAS f32x4*)(r32 + ((size_t)t_ * 16 + 2 * (lane & 7)) * 2); } while (0)
    PrepRaw RA, RB;
    if (gw < NROW) PREP_LOAD(RA, gw);
    for (int r = gw; r < NROW; r += NGW) {
        if (r + NGW < NROW) PREP_LOAD(RB, r + NGW);
        const int pos = r % TPB; const bool isctx = pos < CTXL;
        bf16_t* pr = FP(F) + (size_t)r * LDP;
        u32x2 rf[4], rp[4], rn[4];
#pragma unroll
        for (int s = 0; s < 4; ++s) { rf[s] = RA.rf[s]; rp[s] = RA.rp[s]; rn[s] = RA.rn[s]; }
        const u32x2 rswq = RA.rswq, rcq = RA.rcq, rgaq = RA.rgaq, rswk = RA.rswk, rckv = RA.rckv, rgak = RA.rgak, rkr = RA.rkr;
        const f32x4 cs64 = RA.cs64, cs32 = RA.cs32;
        RA = RB;
        f32x4 o[4];
#pragma unroll
        for (int s = 0; s < 4; ++s) { const f32x4 f = bf4(rf[s]), fp = bf4(rp[s]), fn = bf4(rn[s]); o[s] = f + m0[s] * (fp - f) + m1[s] * (fn - f); }
        st4bf(RR + (size_t)r * 256 + c4, o[0]);
        st4bf(KR + (size_t)r * 256 + c4, o[1]);
        { const f32x4 kx = o[1] * kkv; const float ss = sum16((kx[0] * kx[0] + kx[1] * kx[1]) + (kx[2] * kx[2] + kx[3] * kx[3])); st4bf(KK + (size_t)r * 256 + c4, kx * (1.0f / sqrtf(ss + 1e-12f))); }
        st4bf(V + (size_t)r * 256 + c4, o[2]); if (l == 0) st4bf(VF + (size_t)r * 256 + c4, o[2]);
        st4bf(pr + PC_Z + c4, o[3]);
        { f32x4 q = bf4(rswq); if (!isctx) q = rope2v(q, cs64); st4bf(pr + PC_SWQ + c4, q * QS64);
          if (lane < 32 && !isctx) st4bf(pr + PC_SWK + c4, rope2v(bf4(rswk), cs64)); }
        { f32x4 q = bf4(rcq); const float ss = wave_sum((q[0] * q[0] + q[1] * q[1]) + (q[2] * q[2] + q[3] * q[3]));
          st4bf(pr + PC_CQ + c4, q * (1.0f / sqrtf(ss * (1.0f / 256.0f) + 1e-6f)) * mqn);
          f32x4 kv = bf4(rckv); const float s2 = wave_sum((kv[0] * kv[0] + kv[1] * kv[1]) + (kv[2] * kv[2] + kv[3] * kv[3]));
          if (lane < 32) st4bf(pr + PC_CKV + c4, kv * (1.0f / sqrtf(s2 * (1.0f / 128.0f) + 1e-6f)) * mkvn);
          if (lane < 8) { f32x4 kr = bf4(rkr); if (!isctx) kr = rope2v(kr, cs32);
#pragma unroll
              for (int h = 0; h < 4; ++h) st4bf(Km + (size_t)r * 384 + h * 96 + 64 + c4, kr); } }
        { f32x4 q = bf4(rgaq); const float ss = sum16((q[0] * q[0] + q[1] * q[1]) + (q[2] * q[2] + q[3] * q[3]));
          q = q * (1.0f / sqrtf(ss * (1.0f / 64.0f) + 1e-6f)) * gq; if (!isctx) q = rope2v(q, cs64); st4bf(pr + PC_GAQ + c4, q * QS64);
          f32x4 k = bf4(rgak); const float s2 = sum16((k[0] * k[0] + k[1] * k[1]) + (k[2] * k[2] + k[3] * k[3]));
          if (lane < 32) { k = k * (1.0f / sqrtf(s2 * (1.0f / 64.0f) + 1e-6f)) * gk; if (!isctx) k = rope2v(k, cs64); st4bf(pr + PC_GAK + c4, k); } }
    }
}

#undef PREP_LOAD
template <int PARTS>
DI void finish_rows(Frame& F, int l, int r0, int r1, int stride8) {
    const int gw = stride8 ? r0 + F.wave : F.vcu * 8 + F.wave, NGW = stride8 ? 8 : F.G * 8, lane = F.lane, c4 = 4 * lane, hd = lane >> 4;
    const bf16_t* RR = (const bf16_t*)(F.ws + WS_RR); const bf16_t* KD = (const bf16_t*)(F.ws + WS_KD); const bf16_t* V = (const bf16_t*)(F.ws + WS_V); const bf16_t* Gg = (const bf16_t*)(F.ws + WS_G);
    const float* Y0 = (const float*)(F.ws + WS_YDIR); const float* Y1 = Y0 + (size_t)NROW * 256;
    const float* OP = (const float*)(F.ws + WS_OPART); const float* ML = (const float*)(F.ws + WS_ML);
    bf16_t* YA = (bf16_t*)(F.ws + WS_YALL);
    const f32x4 rk = *(const GAS f32x4*)(inp(I_RK) + l * 256 + c4), lw = *(const GAS f32x4*)(inp(I_LNW) + l * 256 + c4), lb = *(const GAS f32x4*)(inp(I_LNB) + l * 256 + c4);
    for (int r = gw; r < r1; r += NGW) {
        if (PARTS & 1) {
            const f32x4 y = *(const GAS f32x4*)(Y0 + (size_t)r * 256 + c4) + *(const GAS f32x4*)(Y1 + (size_t)r * 256 + c4);
            const float mean = sum16((y[0] + y[1]) + (y[2] + y[3])) * (1.0f / 64.0f);
            const f32x4 d = y - mean;
            const float var = sum16((d[0] * d[0] + d[1] * d[1]) + (d[2] * d[2] + d[3] * d[3])) * (1.0f / 64.0f);
            const f32x4 yn = d * (1.0f / sqrtf(var + 64e-5f)) * lw + lb;
            const f32x4 rr = ld4bf(RR + (size_t)r * 256 + c4), k0 = ld4bf(KD + (size_t)r * 512 + c4), k1 = ld4bf(KD + (size_t)r * 512 + 256 + c4), v = ld4bf(V + (size_t)r * 256 + c4), g = ld4bf(Gg + (size_t)r * 256 + c4);
            const f32x4 pr = rr * (k0 + k1) * rk;
            const float bon = sum16((pr[0] + pr[1]) + (pr[2] + pr[3]));
            st4bf(YA + (size_t)r * 1024 + c4, (yn + bon * v) * g);
        }
        if (PARTS & 2)
#pragma unroll
        for (int kind = 0; kind < 2; ++kind) {
            const float* m0p = ML + (((size_t)(kind * NSPLIT + 0) * NROW + r) * 4 + hd) * 2; const float* m1p = ML + (((size_t)(kind * NSPLIT + 1) * NROW + r) * 4 + hd) * 2;
            const float m0 = m0p[0], l0 = m0p[1], m1 = m1p[0], l1 = m1p[1];
            const float mm = m0 > m1 ? m0 : m1; const float w0 = fast_exp2(m0 - mm), w1 = fast_exp2(m1 - mm);
            const f32x4 o0 = *(const GAS f32x4*)(OP + ((size_t)(kind * NSPLIT + 0) * NROW + r) * 256 + c4), o1 = *(const GAS f32x4*)(OP + ((size_t)(kind * NSPLIT + 1) * NROW + r) * 256 + c4);
            const float inv = 1.0f / (w0 * l0 + w1 * l1);
            st4bf(YA + (size_t)r * 1024 + 512 + kind * 256 + c4, (o0 * w0 + o1 * w1) * inv);
        }
    }
}
#ifdef MIX_MERGE
DI void finish_phase(Frame& F, int l) { finish_rows<1>(F, l, 0, NROW, 0); }
#else
DI void finish_phase(Frame& F, int l) { finish_rows<3>(F, l, 0, NROW, 0); }
#endif
typedef short v4i16_t __attribute__((ext_vector_type(4)));
DI s16x4 vtr(const LAS unsigned char* p) { return __builtin_bit_cast(s16x4, __builtin_amdgcn_ds_read_tr16_b64_v4i16((LAS v4i16_t*)p)); }
DI int crow(int r, int hi) { return (r & 3) + 8 * (r >> 2) + 4 * hi; }

struct AttnArgs {
    const bf16_t* Q; int qpitch;
    const bf16_t* K; int kpitch;
    const bf16_t* V; int vpitch;
    int ka0, ka1, kb0, kb1;
    int window;
    int qlat0;
    int use_sink; float sink_l2;
    int out_mode;
    bf16_t* obf; float* opf; float* mlp;
    int empty_part; float* opf2; float* mlp2;
};

template <int DQK>
DI void attn_unit(Frame& F, const AttnArgs& A) {
    constexpr int NCH = DQK / 8, KB = NCH * 1024, BUF = KB + 8192, ND = DQK / 16;
    const int tid = F.tid, lane = F.lane, wid = F.wave, r32 = lane & 31, hi = lane >> 5;
    LAS unsigned char* lds = F.lds;
    bf16x8 qr[ND];
    { const bf16_t* qp = A.Q + (size_t)(wid * 32 + r32) * A.qpitch + 8 * hi;
#pragma unroll
      for (int d0 = 0; d0 < ND; ++d0) qr[d0] = *(const GAS bf16x8*)(qp + 16 * d0); }
    const int na = (A.ka1 - A.ka0) >> 6, nb = (A.kb1 - A.kb0) >> 6, nt = na + nb;
    const bf16_t* ksrc = A.K + (size_t)lane * A.kpitch + wid * 8;
    const bf16_t* ksrc2 = A.K + (size_t)lane * A.kpitch + (8 + wid) * 8;
    const bf16_t* vsrc = A.V + (size_t)(16 * (wid & 3) + (lane >> 2)) * A.vpitch + (wid >> 2) * 32 + (lane & 3) * 8;
#define ATT_DMA(t) do { const int kr_ = (t) < na ? A.ka0 + 64 * (t) : A.kb0 + 64 * ((t) - na); LAS unsigned char* bb_ = lds + ((t) & 1) * BUF; \
        __builtin_amdgcn_global_load_lds((const unsigned*)(ksrc + (size_t)kr_ * A.kpitch), (LAS unsigned*)(bb_ + wid * 1024), 16, 0, 0); \
        if (DQK == 96 && wid < 4) __builtin_amdgcn_global_load_lds((const unsigned*)(ksrc2 + (size_t)kr_ * A.kpitch), (LAS unsigned*)(bb_ + (8 + wid) * 1024), 16, 0, 0); \
        __builtin_amdgcn_global_load_lds((const unsigned*)(vsrc + (size_t)kr_ * A.vpitch), (LAS unsigned*)(bb_ + KB + wid * 1024), 16, 0, 0); } while (0)
    constexpr float THR = 8.0f;
    float m_ref = 0.f, l_run = 0.f;
    f32x16 o0, o1, negm;
#pragma unroll
    for (int i = 0; i < 16; ++i) { o0[i] = 0.f; o1[i] = 0.f; negm[i] = 0.f; }
    const int qw0 = A.qlat0 + wid * 32;
    bool first = true;
    if (nt > 0) ATT_DMA(0);
    for (int t = 0; t < nt; ++t) {
        asm volatile("s_waitcnt vmcnt(0)" ::: "memory");
        __syncthreads();
        if (t + 1 < nt) ATT_DMA(t + 1);
        const int keyrow = t < na ? A.ka0 + 64 * t : A.kb0 + 64 * (t - na);
        const bool banded = A.window && t >= na;
        const int kj0 = keyrow - CTXL;
        if (banded && (kj0 + 63 < qw0 - 128 || kj0 > qw0 + 31 + 128)) continue;
        const LAS unsigned char* kb = lds + (t & 1) * BUF;
        const LAS unsigned char* vb = kb + KB;
        f32x16 p0 = negm, p1 = negm;
        const LAS unsigned char* kf = kb + hi * 1024 + r32 * 16;
        bf16x8 ka[2 * ND];
#pragma unroll
        for (int d0 = 0; d0 < ND; ++d0) { ka[2 * d0] = *(const LAS bf16x8*)(kf + d0 * 2048); ka[2 * d0 + 1] = *(const LAS bf16x8*)(kf + d0 * 2048 + 512); }
        __builtin_amdgcn_sched_barrier(0);
#pragma unroll
        for (int d0 = 0; d0 < ND; ++d0) {
            p0 = __builtin_amdgcn_mfma_f32_32x32x16_bf16(ka[2 * d0], qr[d0], p0, 0, 0, 0);
            p1 = __builtin_amdgcn_mfma_f32_32x32x16_bf16(ka[2 * d0 + 1], qr[d0], p1, 0, 0, 0);
        }
        const LAS unsigned char* vp = vb + ((lane >> 4) & 1) * 32 + (lane & 3) * 8 + (4 * hi + ((lane & 15) >> 2)) * 64;
        s16x4 vl0[4], vh0[4], vl1[4], vh1[4];
        { const unsigned va_ = (unsigned)(unsigned long)vp;
#define VTR_ASM(dst, off) asm volatile("ds_read_b64_tr_b16 %0, %1 offset:%2" : "=v"(dst) : "v"(va_), "n"(off) : "memory")
#pragma unroll
          for (int ks = 0; ks < 4; ++ks) { VTR_ASM(vl0[ks], ks * 1024); VTR_ASM(vh0[ks], ks * 1024 + 512); VTR_ASM(vl1[ks], 4096 + ks * 1024); VTR_ASM(vh1[ks], 4096 + ks * 1024 + 512); }
#undef VTR_ASM
        }
        if (banded) {
            const int qi = qw0 + r32;
#pragma unroll
            for (int i = 0; i < 16; ++i) { const int kj = kj0 + crow(i, hi); const int d0_ = qi - kj, d1_ = qi - (kj + 32);
                if (d0_ > 128 || d0_ < -128) p0[i] = -INFINITY; if (d1_ > 128 || d1_ < -128) p1[i] = -INFINITY; }
        }
        float mx = __builtin_fmaxf(__builtin_fmaxf(p0[0], p0[1]), p1[0]);
#pragma unroll
        for (int i = 2; i < 16; i += 2) mx = __builtin_fmaxf(__builtin_fmaxf(mx, p0[i]), p0[i + 1]);
#pragma unroll
        for (int i = 1; i < 15; i += 2) mx = __builtin_fmaxf(__builtin_fmaxf(mx, p1[i]), p1[i + 1]);
        mx = __builtin_fmaxf(mx, p1[15]);
        { auto rr = __builtin_amdgcn_permlane32_swap(__float_as_uint(mx), __float_as_uint(mx), false, false); mx = __builtin_fmaxf(__uint_as_float(rr[0]), __uint_as_float(rr[1])); }
        if (first || __any(mx > THR)) {
            const float dl = first ? mx : __builtin_fmaxf(mx, 0.f);
            first = false;
            m_ref += dl;
            const float f = fast_exp2(-dl);
            l_run *= f;
#pragma unroll
            for (int i = 0; i < 16; ++i) { p0[i] -= dl; p1[i] -= dl; o0[i] *= f; o1[i] *= f; negm[i] = -m_ref; }
        }
        float ps = 0.f;
#pragma unroll
        for (int i = 0; i < 16; ++i) { p0[i] = fast_exp2(p0[i]); p1[i] = fast_exp2(p1[i]); ps += p0[i] + p1[i]; }
        l_run += ps;
        bf16x8 pb[4];
#pragma unroll
        for (int s = 0; s < 2; ++s) {
            u32x4 w0, w1;
            w0.x = cvt_pk_bf16(p0[8 * s + 0], p0[8 * s + 1]); w0.y = cvt_pk_bf16(p0[8 * s + 2], p0[8 * s + 3]); w0.z = cvt_pk_bf16(p0[8 * s + 4], p0[8 * s + 5]); w0.w = cvt_pk_bf16(p0[8 * s + 6], p0[8 * s + 7]);
            w1.x = cvt_pk_bf16(p1[8 * s + 0], p1[8 * s + 1]); w1.y = cvt_pk_bf16(p1[8 * s + 2], p1[8 * s + 3]); w1.z = cvt_pk_bf16(p1[8 * s + 4], p1[8 * s + 5]); w1.w = cvt_pk_bf16(p1[8 * s + 6], p1[8 * s + 7]);
            pb[s] = __builtin_bit_cast(bf16x8, w0); pb[2 + s] = __builtin_bit_cast(bf16x8, w1);
        }
        asm volatile("s_waitcnt lgkmcnt(0)" : "+v"(vl0[0]), "+v"(vl0[1]), "+v"(vl0[2]), "+v"(vl0[3]), "+v"(vh0[0]), "+v"(vh0[1]), "+v"(vh0[2]), "+v"(vh0[3]),
                                              "+v"(vl1[0]), "+v"(vl1[1]), "+v"(vl1[2]), "+v"(vl1[3]), "+v"(vh1[0]), "+v"(vh1[1]), "+v"(vh1[2]), "+v"(vh1[3]) :: "memory");
#pragma unroll
        for (int ks = 0; ks < 4; ++ks) {
            const s16x4 l0 = vl0[ks], h0 = vh0[ks], l1 = vl1[ks], h1 = vh1[ks];
            const bf16x8 va = (bf16x8){l0[0], l0[1], l0[2], l0[3], h0[0], h0[1], h0[2], h0[3]}, vb2 = (bf16x8){l1[0], l1[1], l1[2], l1[3], h1[0], h1[1], h1[2], h1[3]};
            o0 = __builtin_amdgcn_mfma_f32_32x32x16_bf16(va, pb[ks], o0, 0, 0, 0);
            o1 = __builtin_amdgcn_mfma_f32_32x32x16_bf16(vb2, pb[ks], o1, 0, 0, 0);
        }
    }
    const float m_run = m_ref;
#undef ATT_DMA
    float l_tot; { auto rr = __builtin_amdgcn_permlane32_swap(__float_as_uint(l_run), __float_as_uint(l_run), false, false); l_tot = __uint_as_float(rr[0]) + __uint_as_float(rr[1]); }
    if (A.use_sink) l_tot += fast_exp2(A.sink_l2 - m_run);
    const int qrow = wid * 32 + r32;
    if (A.out_mode == 0) {
        const float inv = 1.0f / l_tot;
        bf16_t* op = A.obf + (size_t)qrow * 1024 + 4 * hi;
#pragma unroll
        for (int g = 0; g < 4; ++g) {
            u32x2 w; w.x = cvt_pk_bf16(o0[4 * g] * inv, o0[4 * g + 1] * inv); w.y = cvt_pk_bf16(o0[4 * g + 2] * inv, o0[4 * g + 3] * inv); *(GAS u32x2*)(op + 8 * g) = w;
            u32x2 w2; w2.x = cvt_pk_bf16(o1[4 * g] * inv, o1[4 * g + 1] * inv); w2.y = cvt_pk_bf16(o1[4 * g + 2] * inv, o1[4 * g + 3] * inv); *(GAS u32x2*)(op + 32 + 8 * g) = w2;
        }
    } else {
        float* op = A.opf + (size_t)qrow * 256 + 4 * hi;
#pragma unroll
        for (int g = 0; g < 4; ++g) {
            *(GAS f32x4*)(op + 8 * g) = (f32x4){o0[4 * g], o0[4 * g + 1], o0[4 * g + 2], o0[4 * g + 3]};
            *(GAS f32x4*)(op + 32 + 8 * g) = (f32x4){o1[4 * g], o1[4 * g + 1], o1[4 * g + 2], o1[4 * g + 3]};
        }
        if (hi == 0) { GAS float* mp = (GAS float*)(A.mlp + (size_t)qrow * 8); mp[0] = m_run; mp[1] = l_tot; }
        if (A.empty_part) {
            float* op2 = A.opf2 + (size_t)qrow * 256 + 4 * hi;
#pragma unroll
            for (int g = 0; g < 4; ++g) { *(GAS f32x4*)(op2 + 8 * g) = (f32x4){0.f, 0.f, 0.f, 0.f}; *(GAS f32x4*)(op2 + 32 + 8 * g) = (f32x4){0.f, 0.f, 0.f, 0.f}; }
            if (hi == 0) { GAS float* mp = (GAS float*)(A.mlp2 + (size_t)qrow * 8); float neg = -1.0e30f, zer = 0.f; asm volatile("" : "+v"(neg), "+v"(zer)); mp[0] = neg; mp[1] = zer; }
        }
    }
    __syncthreads();
}

constexpr int ATT_NUNITS = 1304;
DI void attn_run_unit(Frame& F, int l, int idx) {
    AttnArgs A;
    const bf16_t* P = FP(F); bf16_t* YA = (bf16_t*)(F.ws + WS_YALL);
    float* OP = (float*)(F.ws + WS_OPART); float* ML = (float*)(F.ws + WS_ML);
    A.window = 0; A.qlat0 = 0; A.use_sink = 0; A.sink_l2 = 0.f; A.empty_part = 0; A.opf2 = nullptr; A.mlp2 = nullptr; A.obf = nullptr; A.opf = nullptr; A.mlp = nullptr;
    A.kb0 = 0; A.kb1 = 0;
    if (idx < 1024) {
        const int kind = idx >> 9, i = idx & 511, split = i & 1, qb = (i >> 1) & 31, h = (i >> 6) & 3, b = i >> 8;
        const size_t row0 = (size_t)b * TPB + CTXL + qb * 256, brow = (size_t)b * TPB;
        A.ka0 = split * (TPB / 2); A.ka1 = A.ka0 + TPB / 2;
        A.out_mode = 1; A.opf = OP + ((size_t)(kind * NSPLIT + split) * NROW + row0) * 256 + h * 64; A.mlp = ML + (((size_t)(kind * NSPLIT + split) * NROW + row0) * 4 + h) * 2;
        if (kind == 0) {
            const bf16_t* Qm = (const bf16_t*)(F.ws + WS_QMLA); const bf16_t* Km = (const bf16_t*)(F.ws + WS_KMLA); const bf16_t* Vm = (const bf16_t*)(F.ws + WS_VMLA);
            A.Q = Qm + row0 * 384 + h * 96; A.qpitch = 384; A.K = Km + brow * 384 + h * 96; A.kpitch = 384; A.V = Vm + brow * 256 + h * 64; A.vpitch = 256;
            attn_unit<96>(F, A);
        } else {
            A.Q = P + row0 * LDP + PC_GAQ + h * 64; A.qpitch = LDP; A.K = P + brow * LDP + PC_GAK + (h >> 1) * 64; A.kpitch = LDP; A.V = P + brow * LDP + PC_GAV + (h >> 1) * 64; A.vpitch = LDP;
            attn_unit<64>(F, A);
        }
    } else if (idx < 1280) {
        const int i = idx - 1024, qb = i & 31, h = (i >> 5) & 3, b = i >> 7;
        const size_t row0 = (size_t)b * TPB + CTXL + qb * 256, brow = (size_t)b * TPB;
        const int q0 = qb * 256; int lo = q0 - 128; if (lo < 0) lo = 0; int hi_ = q0 + 256 + 128; if (hi_ > SEQ) hi_ = SEQ;
        A.ka0 = 0; A.ka1 = CTXL; A.kb0 = CTXL + lo; A.kb1 = CTXL + hi_; A.window = 1; A.qlat0 = q0;
        A.use_sink = 1; A.sink_l2 = inp(I_SINK)[l * 4 + h] * LOG2E;
        A.Q = P + row0 * LDP + PC_SWQ + h * 64; A.qpitch = LDP; A.K = P + brow * LDP + PC_SWK + (h >> 1) * 64; A.kpitch = LDP; A.V = P + brow * LDP + PC_SWV + (h >> 1) * 64; A.vpitch = LDP;
        A.out_mode = 0; A.obf = YA + row0 * 1024 + 256 + h * 64;
        attn_unit<64>(F, A);
    } else {
        const int i = idx - 1280, ck = i >> 3, b = (i >> 2) & 1, h = i & 3;
        const size_t row0 = (size_t)b * TPB, brow = row0;
        A.ka0 = 0; A.ka1 = CTXL;
        if (ck == 0) {
            const bf16_t* Qm = (const bf16_t*)(F.ws + WS_QMLA); const bf16_t* Km = (const bf16_t*)(F.ws + WS_KMLA); const bf16_t* Vm = (const bf16_t*)(F.ws + WS_VMLA);
            A.Q = Qm + row0 * 384 + h * 96; A.qpitch = 384; A.K = Km + brow * 384 + h * 96; A.kpitch = 384; A.V = Vm + brow * 256 + h * 64; A.vpitch = 256;
            A.out_mode = 1; A.opf = OP + ((size_t)(0 * NSPLIT + 0) * NROW + row0) * 256 + h * 64; A.mlp = ML + (((size_t)(0 * NSPLIT + 0) * NROW + row0) * 4 + h) * 2;
            A.empty_part = 1; A.opf2 = OP + ((size_t)(0 * NSPLIT + 1) * NROW + row0) * 256 + h * 64; A.mlp2 = ML + (((size_t)(0 * NSPLIT + 1) * NROW + row0) * 4 + h) * 2;
            attn_unit<96>(F, A);
        } else if (ck == 1) {
            A.Q = P + row0 * LDP + PC_GAQ + h * 64; A.qpitch = LDP; A.K = P + brow * LDP + PC_GAK + (h >> 1) * 64; A.kpitch = LDP; A.V = P + brow * LDP + PC_GAV + (h >> 1) * 64; A.vpitch = LDP;
            A.out_mode = 1; A.opf = OP + ((size_t)(1 * NSPLIT + 0) * NROW + row0) * 256 + h * 64; A.mlp = ML + (((size_t)(1 * NSPLIT + 0) * NROW + row0) * 4 + h) * 2;
            A.empty_part = 1; A.opf2 = OP + ((size_t)(1 * NSPLIT + 1) * NROW + row0) * 256 + h * 64; A.mlp2 = ML + (((size_t)(1 * NSPLIT + 1) * NROW + row0) * 4 + h) * 2;
            attn_unit<64>(F, A);
        } else {
            A.use_sink = 1; A.sink_l2 = inp(I_SINK)[l * 4 + h] * LOG2E;
            A.Q = P + row0 * LDP + PC_SWQ + h * 64; A.qpitch = LDP; A.K = P + brow * LDP + PC_SWK + (h >> 1) * 64; A.kpitch = LDP; A.V = P + brow * LDP + PC_SWV + (h >> 1) * 64; A.vpitch = LDP;
            A.out_mode = 0; A.obf = YA + row0 * 1024 + 256 + h * 64;
            attn_unit<64>(F, A);
        }
    }
}

constexpr int SC_CH = 32, SC_STEP = 1536, SC_BUF = SC_CH * SC_STEP;
DI int scan_row(int b, int d, int n) { return b * TPB + (d == 0 ? n : (n < CTXL ? CTXL - 1 - n : TPB + CTXL - 1 - n)); }

struct ScanRegs { f32x4 w[2]; u32x2 b[5][2]; };
DI void scan_load(const Frame& F, int b, int d, int h, int chunk, int lt, ScanRegs& R) {
    const float* W = (const float*)(F.ws + WS_W); const bf16_t* KD = (const bf16_t*)(F.ws + WS_KD); const bf16_t* BB = (const bf16_t*)(F.ws + WS_BB);
    const bf16_t* KK = (const bf16_t*)(F.ws + WS_KK); const bf16_t* RR = (const bf16_t*)(F.ws + WS_RR); const bf16_t* V = (const bf16_t*)(F.ws + WS_V);
    const int piece = lt & 15;
#pragma unroll
    for (int half = 0; half < 2; ++half) {
        const int row = scan_row(b, d, chunk * SC_CH + half * 16 + (lt >> 4));
        const size_t o512 = (size_t)row * 512 + d * 256 + h * 64 + 4 * piece, o256 = (size_t)row * 256 + h * 64 + 4 * piece;
        R.w[half] = *(const GAS f32x4*)(W + o512);
        R.b[0][half] = *(const GAS u32x2*)(KD + o512); R.b[1][half] = *(const GAS u32x2*)(BB + o512);
        R.b[2][half] = *(const GAS u32x2*)(KK + o256); R.b[3][half] = *(const GAS u32x2*)(RR + o256); R.b[4][half] = *(const GAS u32x2*)(V + o256);
    }
}
DI void scan_store(const Frame& F, int chunk, int lt, const ScanRegs& R) {
    LAS unsigned char* buf = F.lds + (chunk & 1) * SC_BUF;
    const int piece = lt & 15;
#pragma unroll
    for (int half = 0; half < 2; ++half) {
        LAS unsigned char* sp = buf + (half * 16 + (lt >> 4)) * SC_STEP + piece * 16;
        *(LAS f32x4*)sp = R.w[half];
#pragma unroll
        for (int v = 0; v < 5; ++v) { const u32x2 w = R.b[v][half]; *(LAS f32x4*)(sp + (v + 1) * 256) = (f32x4){bflo(w.x), bfhi(w.x), bflo(w.y), bfhi(w.y)}; }
    }
}
constexpr int SCAN_NWG = 64;
template <int VAR>
DI void scan_phase(Frame& F, int sw) {
    const int chain = sw >> 2, quarter = sw & 3, b = chain >> 3, d = (chain >> 2) & 1, h = chain & 3;
    const int lane = F.lane, wid = F.wave, g = lane >> 4, kq = lane & 15;
    const int vrow = quarter * 16 + (wid & 3) * 4 + g;
    float* Y = (float*)(F.ws + WS_YDIR) + (size_t)d * NROW * 256;
    constexpr int NCHUNK = TPB / SC_CH;
    f32x2 S01 = (f32x2){0.f, 0.f}, S23 = (f32x2){0.f, 0.f};
    ScanRegs R;
    const int lt = F.tid - 256;
    if (wid >= 4) { scan_load(F, b, d, h, 0, lt, R); scan_store(F, 0, lt, R); scan_load(F, b, d, h, 1, lt, R); }
    __syncthreads();
    for (int c = 0; c < NCHUNK; ++c) {
        if (wid >= 4) {
            if (c + 1 < NCHUNK) scan_store(F, c + 1, lt, R);
            if (c + 2 < NCHUNK) scan_load(F, b, d, h, c + 2, lt, R);
        } else {
            const LAS unsigned char* buf = F.lds + (c & 1) * SC_BUF + kq * 16;
            const LAS unsigned char* vbuf = F.lds + (c & 1) * SC_BUF + 1280 + vrow * 4;
            f32x4 w4 = *(const LAS f32x4*)(buf), kd4 = *(const LAS f32x4*)(buf + 256), bb4 = *(const LAS f32x4*)(buf + 512), kk4 = *(const LAS f32x4*)(buf + 768), r4 = *(const LAS f32x4*)(buf + 1024);
            float vv = *(const LAS float*)(vbuf);
#pragma unroll
            for (int half = 0; half < 2; ++half) {
                float yp[16];
#pragma unroll
                for (int s16 = 0; s16 < 16; ++s16) {
                    const int sn = half * 16 + s16 + 1 < SC_CH ? half * 16 + s16 + 1 : SC_CH - 1;
                    const LAS unsigned char* sp = buf + sn * SC_STEP;
                    const f32x4 w4n = *(const LAS f32x4*)(sp), kd4n = *(const LAS f32x4*)(sp + 256), bb4n = *(const LAS f32x4*)(sp + 512), kk4n = *(const LAS f32x4*)(sp + 768), r4n = *(const LAS f32x4*)(sp + 1024);
                    const float vvn = *(const LAS float*)(vbuf + sn * SC_STEP);
                    const f32x2 k01 = __builtin_shufflevector(kk4, kk4, 0, 1), k23 = __builtin_shufflevector(kk4, kk4, 2, 3);
                    f32x2 t2 = S01 * k01; t2 = S23 * k23 + t2;
                    const float sa = (VAR & 2) ? -(t2[0] + t2[1]) : -rsum16(t2[0] + t2[1]);
                    const f32x2 w01 = __builtin_shufflevector(w4, w4, 0, 1), w23 = __builtin_shufflevector(w4, w4, 2, 3);
                    const f32x2 d01 = __builtin_shufflevector(kd4, kd4, 0, 1), d23 = __builtin_shufflevector(kd4, kd4, 2, 3);
                    const f32x2 b01 = __builtin_shufflevector(bb4, bb4, 0, 1), b23 = __builtin_shufflevector(bb4, bb4, 2, 3);
                    S01 = b01 * sa + (d01 * vv + S01 * w01); S23 = b23 * sa + (d23 * vv + S23 * w23);
                    const f32x2 r01 = __builtin_shufflevector(r4, r4, 0, 1), r23 = __builtin_shufflevector(r4, r4, 2, 3);
                    f32x2 u2 = S01 * r01; u2 = S23 * r23 + u2;
                    yp[s16] = (VAR & 4) ? 0.f : (u2[0] + u2[1]);
                    w4 = w4n; kd4 = kd4n; bb4 = bb4n; kk4 = kk4n; r4 = r4n; vv = vvn;
                }
                float ykeep;
                {
#define DPPMOV(x, ctrl) __builtin_bit_cast(float, __builtin_amdgcn_update_dpp(0, __builtin_bit_cast(int, (x)), (ctrl), 0xf, 0xf, false))
                    const bool b3 = (kq & 8) != 0, b2 = (kq & 4) != 0, b1 = (kq & 2) != 0, b0 = (kq & 1) != 0;
#pragma unroll
                    for (int q = 0; q < 8; ++q) { const float keep = b3 ? yp[q + 8] : yp[q], send = b3 ? yp[q] : yp[q + 8]; yp[q] = keep + DPPMOV(send, 0x128); }
#pragma unroll
                    for (int q = 0; q < 4; ++q) { const float keep = b2 ? yp[q + 4] : yp[q], send = b2 ? yp[q] : yp[q + 4]; yp[q] = keep + DPPMOV(send, 0x141); }
#pragma unroll
                    for (int q = 0; q < 2; ++q) { const float keep = b1 ? yp[q + 2] : yp[q], send = b1 ? yp[q] : yp[q + 2]; yp[q] = keep + DPPMOV(send, 0x4E); }
                    { const float keep = b0 ? yp[1] : yp[0], send = b0 ? yp[0] : yp[1]; ykeep = keep + DPPMOV(send, 0xB1); }
#undef DPPMOV
                }
                const int n = c * SC_CH + half * 16 + kq;
                if (VAR == 0) *(GAS float*)(Y + (size_t)scan_row(b, d, n) * 256 + h * 64 + vrow) = ykeep; else asm volatile("" :: "v"(ykeep));
            }
        }
        asm volatile("s_waitcnt lgkmcnt(0)" ::: "memory"); __builtin_amdgcn_s_barrier(); asm volatile("" ::: "memory");
    }
    __syncthreads();
}
constexpr int NPH_LAYER = 13, NPHASE = 1 + NPH_LAYER * DEPTH + 1;
struct Args { const float* in[43]; float* out; unsigned char* ws; int ph_lo, ph_hi; };
DI void wg_sync() { __syncthreads(); }
#ifdef MIX_MERGE
DI void mix_wait(unsigned* p, unsigned n) {
    if (threadIdx.x == 0) { unsigned sp = 0; while (xb_ld(p) < n) { __builtin_amdgcn_s_sleep(4); if (++sp > (1u << 22)) break; }
        __builtin_amdgcn_fence(__ATOMIC_ACQUIRE, "agent"); asm volatile("s_waitcnt vmcnt(0)" ::: "memory"); }
    wg_sync();
}
DI void mix_publish(unsigned* p, unsigned n) {
    asm volatile("s_waitcnt vmcnt(0)" ::: "memory"); wg_sync();
    if (threadIdx.x == 0) { __builtin_amdgcn_fence(__ATOMIC_RELEASE, "agent"); asm volatile("s_waitcnt vmcnt(0)" ::: "memory"); (void)xb_add(p, n); }
}
DI void mix_merge_tail(const Frame& F0, int l) {
    constexpr int NFCH = NROW / 64;
    {
        Frame Q = relane(F0);
        unsigned* sy = Q.ctl + CW_SYNC + l * 256;
        mix_wait(sy, (unsigned)ATT_NUNITS);
#ifdef PROBE_SEL
        if (blockIdx.x == 255 && threadIdx.x == 0) ((unsigned long long*)(F0.ws + 7 * MiB))[128 + l] = __builtin_amdgcn_s_memrealtime();
#endif
        int nch = 0;
        for (;;) {
            if (Q.tid == 0) Q.MISC[16] = xb_add(sy + 64, 1u);
            wg_sync();
            const int ch = (int)Q.MISC[16];
            wg_sync();
            if (ch >= NFCH) break;
            finish_rows<2>(Q, l, ch * 64, ch * 64 + 64, 1); ++nch;
        }
        if (nch > 0) mix_publish(sy + 128, (unsigned)nch);
        mix_wait(sy + 128, (unsigned)NFCH);
#ifdef PROBE_SEL
        if (blockIdx.x == 255 && threadIdx.x == 0) ((unsigned long long*)(F0.ws + 7 * MiB))[136 + l] = __builtin_amdgcn_s_memrealtime();
#endif
    }
    for (;;) {
        Frame Q = relane(F0);
        int ll = l; asm volatile("" : "+s"(ll));
        if (Q.tid == 0) Q.MISC[16] = xb_add(Q.ctl + CW_SYNC + ll * 256 + 192, 1u);
        wg_sync();
        const int it = (int)Q.MISC[16];
        wg_sync();
        const int lat = (ll == DEPTH - 1);
        if (it >= 3 * (lat ? 256 : 264)) break;
        const int ti = it / 3, br = 1 + it % 3;
        unsigned char* wl = Q.ws + ((ll & 1) ? WS_WL : WS_WLB);
        pg8::Gemm g{(const char*)(Q.ws + WS_YALL), (const char*)(wl + WL_WBR), 1024, 256, 256};
        SchedMerge S{Q.G, ti, lat, br, 1, 1};
        bf16_t* dst = (bf16_t*)(Q.ws + (br == 1 ? WS_HB : WS_OPART)) + (size_t)(br == 3 ? 1 : 0) * NROW * 1024;
        EpiMergeP E{FP(Q), dst};
        pg8::gemm_phase(Q.lds, g, S, E, Q.wave);
    }
}
#endif
template <int NS>
DI void ctx_splitk_tail(const Frame& F0, int l, const char* A, const char* Bt, int ld, int which, int cw) {
    Frame Q = relane(F0);
    const int kc = ld / NS;
    pg8::Gemm g2{A, Bt, ld, ld, kc};
    SchedCtxK S2{Q.G, Q.bx, NS, kc, ld, ld}; EpiSlab E2{(float*)(Q.ws + WS_SLAB)};
    pg8::gemm_phase(Q.lds, g2, S2, E2, Q.wave);
    const int sl = Q.bx % NS, t = Q.bx / NS, pn = t & 3, pm = (t >> 2) ? 33 : 0;
    unsigned* cnt = Q.ctl + CW_SLABCNT + l * 64 + cw + t;
    mix_publish(cnt, 1u);
    mix_wait(cnt, (unsigned)NS);
    constexpr int RPS = (256 + NS - 1) / NS;
    const int r0 = sl * RPS, r1 = r0 + RPS < 256 ? r0 + RPS : 256;
    const float* slab = (const float*)(Q.ws + WS_SLAB);
    const float* gv = FMOD(Q) + (size_t)l * 3 * 6144 + ((size_t)2 * 6 + which) * 1024 + pn * 256 + 4 * (Q.tid & 63);
    const f32x4 gg = *(const GAS f32x4*)gv;
    for (int r = r0 + (Q.tid >> 6); r < r1; r += 8) {
        const size_t so = ((size_t)((pm == 33 ? 256 : 0) + r)) * 1024 + pn * 256 + 4 * (Q.tid & 63);
        f32x4 a = *(const GAS f32x4*)(slab + so);
#pragma unroll
        for (int q = 1; q < NS; ++q) a = a + *(const GAS f32x4*)(slab + (size_t)q * 512 * 1024 + so);
        float* xp = FX(Q) + ((size_t)pm * 256 + r) * 1024 + pn * 256 + 4 * (Q.tid & 63);
        *(GAS f32x4*)xp = *(const GAS f32x4*)xp + gg * a;
    }
}
#ifdef NOPK
#define KATTR __attribute__((target("no-packed-fp32-ops")))
#else
#define KATTR
#endif
__global__ void __launch_bounds__(512, 2) KATTR hfb_fwd(Args args) {
    extern __shared__ __attribute__((aligned(16))) unsigned char lds_raw[];
    Frame F;
    F.lds = (LAS unsigned char*)lds_raw;
    F.MISC = (volatile LAS unsigned*)(F.lds + MISC_OFF);
    F.tid = threadIdx.x; F.lane = F.tid & 63; F.wave = __builtin_amdgcn_readfirstlane(F.tid >> 6);
    F.bx = blockIdx.x; F.G = gridDim.x; { const int bx = blockIdx.x; F.vcu = (F.G % 8 == 0) ? (bx % 8) * (F.G / 8) + bx / 8 : bx; }
    F.ws = args.ws; F.ctl = (unsigned*)(args.ws + WS_CTL); F.out = args.out;
    for (int u = F.tid; u < (LDS_BYTES - MISC_OFF) / 4; u += 512) ((LAS unsigned*)(F.lds + MISC_OFF))[u] = 0u;
    wg_sync();
    const int lo = args.ph_lo, hi = args.ph_hi;
    XcdBarrier bar; bar.bar = F.ctl + CW_BAR; bar.x = 0; bar.st = nullptr;
    if (hi - lo > 1) bar = xcd_barrier_post(F.ctl + CW_BAR, F.MISC + 8);
#ifndef PH_MASK
#define PH_MASK 0xFFFFF
#endif
#define IN(k) (lo <= (k) && (k) < hi)
#define INL(j) ((((PH_MASK) >> (j)) & 1) && IN(pb + (j)))
#ifndef SKEW_K1024
#define SKEW_K1024 0
#endif
#ifndef SKEW_K3584
#define SKEW_K3584 0
#endif
#ifndef DUP_MASK
#define DUP_MASK 0
#endif
#define NREP(j) ((((DUP_MASK) >> (j)) & 1) ? 2 : 1)
#define REPBAR(j) do { if (rep + 1 < NREP(j) && hi - lo > 1) xcd_barrier_t<false>(bar); } while (0)
#ifndef PROBE_AMP
#define PROBE_AMP 4
#endif
#ifdef PROBE_SEL
    unsigned long long* const stamps = (unsigned long long*)(F.ws + 7 * MiB);
#define STAMP(i) do { if (blockIdx.x == 0 && threadIdx.x == 0) { stamps[(i)] = __builtin_amdgcn_s_memrealtime(); } } while (0)
#define STAMPB(i) do { if (blockIdx.x == 255 && threadIdx.x == 0) { stamps[(i)] = __builtin_amdgcn_s_memrealtime(); } } while (0)
#else
#define STAMP(i) do { } while (0)
#define STAMPB(i) do { } while (0)
#endif
#define SEAM(k) do { if (IN(k) && IN((k) + 1)) xcd_barrier_t<false>(bar); STAMP((k) + 1); } while (0)
    const int bx = blockIdx.x;

    STAMP(96);
    if (((PH_MASK >> 16) & 1) && IN(0)) { Frame Q = relane(F); p0_prologue(Q); }
    STAMP(0);
    if (hi - lo > 1) xcd_barrier_t<true>(bar);

    STAMP(1);
    for (int l = 0; l < DEPTH; ++l) {
        const int pb = 1 + NPH_LAYER * l;
        if (INL(0)) { Frame Q = relane(F); norm_phase<0>(Q, l); } SEAM(pb + 0);
        if (INL(1)) {
            Frame Q = relane(F); unsigned char* wl = Q.ws + ((l & 1) ? WS_WL : WS_WLB);
            pg8::Gemm g{(const char*)FHB(Q), (const char*)(wl + WL_WIN), 1024, 1024, 1024};
            SchedGrid S; S.T.init(NPANEL, NP_GEMM / 256, Q.G, Q.bx); S.lda = 1024; S.ldb = 1024; S.acol = 0; S.lat = 0;
            EpiWin E{FP(Q), 10, 0};
#ifdef DUP_NULL_WIN
            pg8::gemm_phase(Q.lds, g, S, E, Q.wave); if (hi - lo > 1) xcd_barrier_t<false>(bar);
            #if DUP_NULL_WIN == 1
            { EpiNull E0{FP(Q)}; pg8::gemm_phase(Q.lds, g, S, E0, Q.wave); }
#elif DUP_NULL_WIN == 2
            { EpiWin E0{(bf16_t*)(Q.ws + WS_RR), 1000, 0}; pg8::gemm_phase(Q.lds, g, S, E0, Q.wave); }
#elif DUP_NULL_WIN == 3
            { EpiWin E0{(bf16_t*)(Q.ws + WS_RR), 10, 0}; pg8::gemm_phase(Q.lds, g, S, E0, Q.wave); }
#elif DUP_NULL_WIN == 5
            { EpiWin E0{(bf16_t*)(Q.ws + WS_RR), 0, 0}; pg8::gemm_phase(Q.lds, g, S, E0, Q.wave); }
#else
            { EpiWin E0{(bf16_t*)(Q.ws + WS_RR), 1000, 1}; pg8::gemm_phase(Q.lds, g, S, E0, Q.wave); }
#endif
#else
            for (int rep = 0; rep < NREP(1); ++rep) { pg8::gemm_phase(Q.lds, g, S, E, Q.wave, SKEW_K1024); REPBAR(1); }
#endif
        } SEAM(pb + 1);
        if (INL(2)) { Frame Q = relane(F); prep_phase(Q, l); } SEAM(pb + 2);
        if (INL(3)) {
            Frame Q = relane(F); unsigned char* wl = Q.ws + ((l & 1) ? WS_WL : WS_WLB);
            pg8::Gemm g{(const char*)FP(Q), (const char*)(wl + WL_L1), LDP, 256, 256};
            SchedL3B S{Q.G, Q.bx};
            EpiL3B E{(bf16_t*)(Q.ws + WS_T), (bf16_t*)(Q.ws + WS_QMLA), (bf16_t*)(Q.ws + WS_KMLA), (bf16_t*)(Q.ws + WS_VMLA), (const float*)(Q.ws + WS_ROPE32)};
            for (int rep = 0; rep < NREP(3); ++rep) { pg8::gemm_phase(Q.lds, g, S, E, Q.wave); REPBAR(3); }
        } SEAM(pb + 3);
        if (INL(4)) {
            Frame Q = relane(F); unsigned char* wl = Q.ws + ((l & 1) ? WS_WL : WS_WLB);
            pg8::Gemm g{(const char*)(Q.ws + WS_T), (const char*)(wl + WL_L2), 1536, 256, 256};
            SchedL3C S{Q.G, Q.bx, l};
            EpiL3C E{l, inp(I_W0) + l * 512, inp(I_A0) + l * 512, inp(I_V0) + (l > 0 ? l - 1 : 0) * 256, inp(I_KA) + l * 256,
                     (float*)(Q.ws + WS_W), (bf16_t*)(Q.ws + WS_KD), (bf16_t*)(Q.ws + WS_BB), (const bf16_t*)(Q.ws + WS_KR), (const bf16_t*)(Q.ws + WS_KK),
                     (bf16_t*)(Q.ws + WS_V), (const bf16_t*)(Q.ws + WS_VF), (bf16_t*)(Q.ws + WS_G)};
            pg8::gemm_phase(Q.lds, g, S, E, Q.wave);
        } SEAM(pb + 4);
        if (INL(5)) {
            Frame Q = relane(F); unsigned char* wl = Q.ws + ((l & 1) ? WS_WL : WS_WLB);

#ifndef DUP_MIX
#define DUP_MIX 3
#endif
            for (int rep = 0; rep < NREP(5); ++rep) {
            if (Q.bx < SCAN_NWG && (rep == 0 || (DUP_MIX & 1))) scan_phase<0>(Q, Q.bx);
            STAMP(64 + l);
#ifdef PROBE_SEL
            if (Q.bx < SCAN_NWG && threadIdx.x == 0) stamps[192 + l * 64 + Q.bx] = __builtin_amdgcn_s_memrealtime();
#endif
#ifdef SCAN_VARIANT
            if (Q.bx < SCAN_NWG) scan_phase<SCAN_VARIANT>(Q, Q.bx);
            STAMP(80 + l);
#endif
            if (rep == 0 || (DUP_MIX & 2)) {
                const int x0 = (int)(xb_xcc_id() & 7u);
                if (Q.tid < 8) Q.MISC[32 + Q.tid] = __hip_atomic_load(Q.ctl + CW_ATTQ + ((l * 2 + rep) * 8 + Q.tid) * 64, __ATOMIC_RELAXED, __HIP_MEMORY_SCOPE_AGENT);
                wg_sync();
                int ndone = 0;
                for (int qi = 0; qi < 8; ++qi) {
                    const int x = (x0 + qi) & 7, xb_ = x >> 2, xh_ = x & 3;
                    if (Q.MISC[32 + x] >= 163u) continue;
                    for (;;) {
                        if (Q.tid == 0) Q.MISC[16] = __hip_atomic_fetch_add(Q.ctl + CW_ATTQ + ((l * 2 + rep) * 8 + x) * 64, 1u, __ATOMIC_RELAXED, __HIP_MEMORY_SCOPE_AGENT);
                        wg_sync();
                        const int j = (int)Q.MISC[16];
                        wg_sync();
                        if (j >= 163) break;
                        int idx;
                        if (j < 128) { const int kind = j >> 6, jj = j & 63, split = jj >> 5, qb = jj & 31; idx = (kind << 9) | (xb_ << 8) | (xh_ << 6) | (qb << 1) | split; }
                        else if (j < 160) idx = 1024 + ((xb_ << 7) | (xh_ << 5) | (j - 128));
                        else idx = 1280 + (((j - 160) << 3) | (xb_ << 2) | xh_);
                        attn_run_unit(Q, l, idx); ++ndone;
                    }
                }
#ifdef MIX_MERGE
                if (ndone > 0) mix_publish(Q.ctl + CW_SYNC + l * 256, (unsigned)ndone);
#endif
            }
            REPBAR(5); }
            STAMPB(112 + l);
            {
                constexpr int CONV_DEFER = 8 * 896 + 2 * 1792;
                const int nown = (l & 1) ? CONV_DEFER : 0;
                constexpr int TOT_DENSE = 2944 + 1792 + 896, TOT_MOE = 2944 + 8 * 1792 + 8 * 896;
                const int tot_own = TOT_MOE;
                const int nnext = l + 1 < DEPTH ? (((l + 1) & 1) ? TOT_MOE - CONV_DEFER : TOT_DENSE) : 0;
                for (;;) {
                    if (Q.tid == 0) Q.MISC[16] = __hip_atomic_fetch_add(Q.ctl + CW_CONVQ + l * 64, 1u, __ATOMIC_RELAXED, __HIP_MEMORY_SCOPE_AGENT);
                    wg_sync();
                    const int p = (int)Q.MISC[16] * 64;
                    wg_sync();
                    if (p >= nown + nnext) break;
                    const bool own = p < nown;
                    int cl = own ? l : l + 1, a0 = own ? tot_own - CONV_DEFER + p : p - nown, lim = own ? tot_own : nnext;
                    int a1 = a0 + 64 < lim ? a0 + 64 : lim;
                    asm volatile("" : "+s"(cl), "+s"(a0), "+s"(a1));
                    convert_layer_weights(Q, cl, ConvSel{1, a0, a1});
                }
            }
            STAMPB(120 + l);
#ifdef MIX_MERGE
            mix_merge_tail(F, l);
            STAMPB(144 + l);
#endif
        } SEAM(pb + 5);
        if (INL(6)) { Frame Q = relane(F); for (int rep = 0; rep < NREP(6); ++rep) { finish_phase(Q, l); REPBAR(6); } } SEAM(pb + 6);
        if (INL(7)) {
            Frame Q = relane(F); unsigned char* wl = Q.ws + ((l & 1) ? WS_WL : WS_WLB);
            pg8::Gemm g{(const char*)(Q.ws + WS_YALL), (const char*)(wl + WL_WBR), 1024, 256, 256};
#ifdef MIX_MERGE
            SchedMerge S{Q.G, Q.bx, l == DEPTH - 1, 0, 1, 0};
            EpiMergeA E{FP(Q), FHB(Q), (const bf16_t*)(Q.ws + WS_OPART), (const bf16_t*)(Q.ws + WS_OPART) + (size_t)NROW * 1024};
#else
            SchedMerge S{Q.G, Q.bx, l == DEPTH - 1, 0, 4, 0};
            EpiMerge E{FP(Q), FHB(Q), 0};
#endif
            for (int rep = 0; rep < NREP(7); ++rep) { pg8::gemm_phase(Q.lds, g, S, E, Q.wave); REPBAR(7); }
        } SEAM(pb + 7);
        if (INL(8)) {
            Frame Q = relane(F); unsigned char* wl = Q.ws + ((l & 1) ? WS_WL : WS_WLB);
            pg8::Gemm g{(const char*)FHB(Q), (const char*)(wl + WL_WOUT), 1024, 1024, 1024};
            SchedGrid S; S.lat = (l == DEPTH - 1); S.T.init(S.lat ? 64 : NPANEL, 4, Q.G, Q.bx); S.lda = 1024; S.ldb = 1024; S.acol = 0;
            EpiResid E{FX(Q), FMOD(Q) + (size_t)l * 3 * 6144, 2};
            pg8::gemm_phase(Q.lds, g, S, E, Q.wave);
        } SEAM(pb + 8);
        if (INL(9)) { Frame Q = relane(F); norm_phase<1>(Q, l); } SEAM(pb + 9);
#ifndef DIAG_DENSE_ONLY
#define DIAG_DENSE_ONLY 0
#endif
#ifndef DIAG_MOE_ONLY
#define DIAG_MOE_ONLY 0
#endif
        if (!DIAG_DENSE_ONLY && ((l & 1) || DIAG_MOE_ONLY)) {
            if (INL(10)) { Frame Q = relane(F); moe_gather(Q, l); } SEAM(pb + 10);
            if (INL(11)) {
                Frame Q = relane(F); unsigned char* wl = Q.ws + ((l & 1) ? WS_WL : WS_WLB);
                pg8::Gemm g{(const char*)(Q.ws + WS_XG), (const char*)(wl + WL_W13), 1024, 1024, 1024};
                SchedMoe S; S.G = Q.G; S.c = Q.bx; S.ncol = 28; S.lda = 1024; S.ldb = 1024; S.nrowB = 7168; moe_panels(Q, l, S.cp);
                EpiSwiGlu E{(bf16_t*)(Q.ws + WS_UG), 1};
                for (int rep = 0; rep < NREP(11); ++rep) { pg8::gemm_phase(Q.lds, g, S, E, Q.wave, SKEW_K1024); REPBAR(11); }
            } SEAM(pb + 11);
            if (INL(12)) {
                Frame Q = relane(F); unsigned char* wl = Q.ws + ((l & 1) ? WS_WL : WS_WLB);
                pg8::Gemm g{(const char*)(Q.ws + WS_UG), (const char*)(wl + WL_W2), DFF, DFF, DFF};
                SchedMoe S; S.G = Q.G; S.c = Q.bx; S.ncol = 4; S.lda = DFF; S.ldb = DFF; S.nrowB = 1024; moe_panels(Q, l, S.cp);
                EpiMoeDown E{(bf16_t*)(Q.ws + WS_YG), (const float*)(Q.ws + WS_ROWGATE)};
                pg8::gemm_phase(Q.lds, g, S, E, Q.wave, SKEW_K3584);
            } SEAM(pb + 12);
        } else {
            if (INL(11)) {
                Frame Q = relane(F); unsigned char* wl = Q.ws + ((l & 1) ? WS_WL : WS_WLB);
                pg8::Gemm g{(const char*)FHB(Q), (const char*)(wl + WL_W13), 1024, 1024, 1024};
                SchedGrid S; S.T.init(NPANEL, 28, Q.G, Q.bx); S.lda = 1024; S.ldb = 1024; S.acol = 0; S.lat = 0;
                EpiSwiGlu E{(bf16_t*)(Q.ws + WS_U), 0};
                for (int rep = 0; rep < NREP(11); ++rep) { pg8::gemm_phase(Q.lds, g, S, E, Q.wave, SKEW_K1024); REPBAR(11); }
            } SEAM(pb + 11);
            if (INL(12)) {
                Frame Q = relane(F); unsigned char* wl = Q.ws + ((l & 1) ? WS_WL : WS_WLB);
                pg8::Gemm g{(const char*)(Q.ws + WS_U), (const char*)(wl + WL_W2D), DFF, DFF, DFF};
                SchedLat S; S.T.init(64, 4, Q.G, Q.bx); S.lda = DFF; S.ldb = DFF;
                EpiResid E{FX(Q), FMOD(Q) + (size_t)l * 3 * 6144, 5};
                pg8::gemm_phase(Q.lds, g, S, E, Q.wave, SKEW_K3584);
                if (Q.bx < 8 * 7) { wg_sync(); ctx_splitk_tail<7>(F, l, (const char*)(Q.ws + WS_U), (const char*)(wl + WL_W2D), DFF, 5, 0); }
            } SEAM(pb + 12);
        }
    }
    if (((PH_MASK >> 17) & 1) && IN(NPHASE - 1)) { Frame Q = relane(F); float probe_scale = 1.0f;

        norm_phase<2>(Q, DEPTH - 1, probe_scale);
#ifdef PROBE_SEL
        if (blockIdx.x == 0 && threadIdx.x == 0) {
            const unsigned long long* st = stamps; unsigned long long dt = 0;
            if (PROBE_SEL < 13) { for (int l = 0; l < DEPTH; ++l) dt += st[2 + 13 * l + PROBE_SEL] - st[1 + 13 * l + PROBE_SEL]; }
            else if (PROBE_SEL == 13) dt = st[1] - st[0];
            else if (PROBE_SEL == 17) dt = st[0] - st[96];
            else if (PROBE_SEL == 22) { for (int l = 0; l < DEPTH; ++l) { unsigned long long mx = 0; for (int b = 0; b < 64; ++b) { const unsigned long long v = st[192 + l * 64 + b]; mx = v > mx ? v : mx; } dt += mx - st[1 + 13 * l + 5]; } }
            else if (PROBE_SEL == 19) { for (int l = 0; l < DEPTH; ++l) dt += st[128 + l] - st[1 + 13 * l + 5]; }
            else if (PROBE_SEL == 20) { for (int l = 0; l < DEPTH; ++l) dt += st[136 + l] - st[1 + 13 * l + 5]; }
            else if (PROBE_SEL == 21) { for (int l = 0; l < DEPTH; ++l) dt += st[144 + l] - st[1 + 13 * l + 5]; }
            else if (PROBE_SEL == 16) { for (int l = 0; l < DEPTH; ++l) dt += st[112 + l] - st[1 + 13 * l + 5]; }
            else if (PROBE_SEL == 18) { for (int l = 0; l < DEPTH; ++l) dt += st[120 + l] - st[1 + 13 * l + 5]; }
            else if (PROBE_SEL == 15) { for (int l = 0; l < DEPTH; ++l) dt += st[64 + l] - st[1 + 13 * l + 5]; }
            else { for (int l = 0; l < DEPTH; ++l) dt += st[80 + l] - st[64 + l]; }
            const unsigned long long t0 = __builtin_amdgcn_s_memrealtime();
            while (__builtin_amdgcn_s_memrealtime() - t0 < (unsigned long long)PROBE_AMP * dt) __builtin_amdgcn_s_sleep(32);
        }
#endif
        }
#undef IN
#undef SEAM
}

extern "C" void kernel_launch(void* const* d_in, const int* in_sizes, int n_in, void* d_out, int out_size, void* d_ws, size_t ws_size, hipStream_t stream) {
    static int grid = 0;
    if (grid == 0) {
        if (n_in != 43 || out_size != NB * SEQ * DM || ws_size < WS_END) { fprintf(stderr, "kernel_launch: unexpected problem (n_in %d, out %d, ws %zu < %zu)\n", n_in, out_size, ws_size, (size_t)WS_END); grid = -1; return; }
        int dev = 0, cus = 0, per_cu = 0;
        if (hipGetDevice(&dev) != hipSuccess || hipDeviceGetAttribute(&cus, hipDeviceAttributeMultiprocessorCount, dev) != hipSuccess) { grid = -1; return; }
        if (hipFuncSetAttribute((const void*)hfb_fwd, hipFuncAttributeMaxDynamicSharedMemorySize, LDS_BYTES) != hipSuccess) { fprintf(stderr, "kernel_launch: hipFuncSetAttribute failed\n"); grid = -1; return; }
        if (hipOccupancyMaxActiveBlocksPerMultiprocessor(&per_cu, (const void*)hfb_fwd, 512, LDS_BYTES) != hipSuccess || per_cu < 1) { fprintf(stderr, "kernel_launch: occupancy query says %d\n", per_cu); }
        (void)hipGetLastError();
        grid = cus < 256 ? cus : 256;
        if (grid < 128) { grid = -1; return; }
    }
    if (grid < 0) return;
    (void)in_sizes;
    hipMemsetAsync((char*)d_ws + WS_CTL, 0, CTL_BYTES, stream);
    Args a{};
    for (int i = 0; i < 43; ++i) a.in[i] = (const float*)d_in[i];
    a.out = (float*)d_out; a.ws = (unsigned char*)d_ws;
#if MK_N_LAUNCHES == 1
    a.ph_lo = 0; a.ph_hi = NPHASE;
    hipLaunchKernelGGL(hfb_fwd, dim3(grid), dim3(512), LDS_BYTES, stream, a);
#else
    for (int p = 0; p < NPHASE; ++p) {
        const int l = (p - 1) / NPH_LAYER, k = (p - 1) % NPH_LAYER;
        if (p >= 1 && p < NPHASE - 1 && k == 10 && !(l & 1)) continue;
        a.ph_lo = p; a.ph_hi = p + 1;
        hipLaunchKernelGGL(hfb_fwd, dim3(grid), dim3(512), LDS_BYTES, stream, a);
    }
#endif
}
```

```cpp
#include <hip/hip_runtime.h>
#include <cstdio>
#include <cstdint>

#ifndef MK_N_LAUNCHES
#define MK_N_LAUNCHES 1
#endif

#define GAS __attribute__((address_space(1)))
#define LAS __attribute__((address_space(3)))
#define DI __device__ __forceinline__
typedef unsigned short bf16_t;
typedef short bf16x8 __attribute__((ext_vector_type(8)));
typedef short s16x4 __attribute__((ext_vector_type(4)));
typedef float f32x2 __attribute__((ext_vector_type(2)));
typedef float f32x4 __attribute__((ext_vector_type(4)));
typedef float f32x16 __attribute__((ext_vector_type(16)));
typedef unsigned u32x2 __attribute__((ext_vector_type(2)));
typedef unsigned u32x4 __attribute__((ext_vector_type(4)));

constexpr int DM = 1024, NB = 2, SEQ = 8192, DEPTH = 4, CTXL = 256, GRIDW = 64;
constexpr int TPB = CTXL + SEQ;
constexpr int NROW = NB * TPB;
constexpr int NPANEL = NROW / 256;
constexpr int DFF = 3584, NEXP = 8;
constexpr int IN_W = 6560;
constexpr int PC_F = 0, PC_SWQ = 1024, PC_SWK = 1280, PC_SWV = 1408, PC_CQ = 1536, PC_CKV = 1792, PC_KR = 1920,
              PC_GAQ = 2048, PC_GAK = 2304, PC_GAV = 2432, PC_GATE = 2560, PC_Z = 6656, NP_GEMM = 6656, LDP = 6912;
constexpr float LOG2E = 1.4426950408889634f;
constexpr float QS64 = 0.125f * LOG2E;
constexpr float QS96 = 0.10206207261596577f * LOG2E;
constexpr int NSPLIT = 2;
constexpr int MOE_MAXROWS = 35840;

constexpr size_t MiB = 1u << 20;
constexpr size_t WS_CTL = 0, CTL_BYTES = 1 * MiB;
constexpr size_t WS_MOD = 1 * MiB;
constexpr size_t WS_ROPE64 = 2 * MiB;
constexpr size_t WS_ROPE32 = 4 * MiB;
constexpr size_t WS_ASG = 5 * MiB;
constexpr size_t WS_ASG_GATE = 5 * MiB + 512 * 1024;
constexpr size_t WS_ASG_DST = 6 * MiB;
constexpr size_t WS_ROWGATE = 6 * MiB + 512 * 1024;
constexpr size_t WS_WL = 8 * MiB;
constexpr size_t WL_WIN = 0;
constexpr size_t WL_WBR = WL_WIN + (size_t)NP_GEMM * 1024 * 2;
constexpr size_t WL_WOUT = WL_WBR + (size_t)4 * 1024 * 256 * 2;
constexpr size_t WL_L1 = WL_WOUT + (size_t)1024 * 1024 * 2;
constexpr size_t WL_L2 = WL_L1 + (size_t)1536 * 256 * 2;
constexpr size_t WL_UQ = WL_L2 + (size_t)1536 * 256 * 2;
constexpr size_t WL_UKV = WL_UQ + (size_t)512 * 256 * 2;
constexpr size_t WL_W13 = WL_UKV + (size_t)512 * 256 * 2;
constexpr size_t WL_W2 = WL_W13 + (size_t)NEXP * 7168 * 1024 * 2;
constexpr size_t WL_END = WL_W2 + (size_t)NEXP * 1024 * 3584 * 2;
static_assert(WL_END <= 200 * MiB, "weights region");
constexpr size_t WS_X = 208 * MiB;
constexpr size_t WS_HB = 274 * MiB;
constexpr size_t WS_VF = 307 * MiB;
constexpr size_t WS_REG = 316 * MiB;
constexpr size_t WS_P = WS_REG;
constexpr size_t WS_RR = WS_REG + 223 * MiB;
constexpr size_t WS_KK = WS_RR + 9 * MiB;
constexpr size_t WS_KR = WS_KK + 9 * MiB;
constexpr size_t WS_V = WS_KR + 9 * MiB;
constexpr size_t WS_KD = WS_V + 9 * MiB;
constexpr size_t WS_BB = WS_KD + 17 * MiB;
constexpr size_t WS_W = WS_BB + 17 * MiB;
constexpr size_t WS_G = WS_W + 33 * MiB;
constexpr size_t WS_T = WS_G + 9 * MiB;
constexpr size_t WS_OPART = WS_T;
constexpr size_t WS_ML = WS_OPART + 66 * MiB;
constexpr size_t WS_YDIR = WS_ML + 3 * MiB;
constexpr size_t WS_QMLA = WS_YDIR + 33 * MiB;
constexpr size_t WS_KMLA = WS_QMLA + 13 * MiB;
constexpr size_t WS_VMLA = WS_KMLA + 13 * MiB;
constexpr size_t WS_YALL = WS_VMLA + 9 * MiB;
constexpr size_t WS_MIX_END = WS_YALL + 33 * MiB;
constexpr size_t WS_U = WS_REG;
constexpr size_t WS_XG = WS_REG;
constexpr size_t WS_UG = WS_REG + 70 * MiB;
constexpr size_t WS_YG = WS_UG + 245 * MiB;
constexpr size_t WS_FFN_END = WS_YG + 70 * MiB;
constexpr size_t WS_SLAB = WS_REG + 440 * MiB;
static_assert(WS_SLAB >= WS_FFN_END && WS_SLAB + 16 * MiB <= WS_MIX_END, "slabs");
constexpr size_t WS_WLB = 824 * MiB;
constexpr size_t WL_W2D = WL_W13 + (size_t)7168 * 1024 * 2;
static_assert(WS_WLB >= WS_MIX_END && WS_WLB >= WS_FFN_END && WL_W2D + (size_t)1024 * 3584 * 2 <= 44 * MiB, "dense weight buffer");
constexpr size_t WS_END = WS_WLB + 44 * MiB;
static_assert(WS_KR + (size_t)NROW * 256 * 2 <= WS_V && WS_T + (size_t)NROW * 1536 * 2 <= WS_ML && WS_OPART + (size_t)2 * NSPLIT * NROW * 256 * 4 <= WS_ML, "map");
static_assert((size_t)2 * NSPLIT * NROW * 8 * 4 <= 3 * MiB && (size_t)NROW * 384 * 2 <= 13 * MiB && (size_t)NROW * LDP * 2 <= 223 * MiB, "map");
static_assert((size_t)MOE_MAXROWS * 1024 * 2 <= 70 * MiB && (size_t)MOE_MAXROWS * 3584 * 2 <= 245 * MiB, "map");

constexpr int CW_BAR = 4096;
constexpr int CW_MOECNT = 16384;
constexpr int CW_ATTQ = 20480;
constexpr int CW_CONVQ = 24576;
constexpr int CW_SYNC = 28672;
constexpr int CW_SLABCNT = 30720;
constexpr int CW_WGBASE = 32768;

constexpr int RING_BYTES = 131072;
constexpr int MISC_OFF = RING_BYTES;
constexpr int LDS_BYTES = 147456;

#define LDS_WAIT() asm volatile("s_waitcnt lgkmcnt(0)" ::: "memory")
#define VM_WAIT() asm volatile("s_waitcnt vmcnt(0)" ::: "memory")
DI unsigned f2bf(float f) { unsigned u = __builtin_bit_cast(unsigned, f); return (u + 0x7fffu + ((u >> 16) & 1u)) >> 16; }
DI unsigned pk2(float lo, float hi) { return f2bf(lo) | (f2bf(hi) << 16); }
DI float bflo(unsigned w) { return __builtin_bit_cast(float, w << 16); }
DI float bfhi(unsigned w) { return __builtin_bit_cast(float, w & 0xffff0000u); }
DI float bf2f(bf16_t b) { return __builtin_bit_cast(float, ((unsigned)b) << 16); }
typedef __bf16 bf16x2_t __attribute__((ext_vector_type(2)));
DI unsigned cvt_pk_bf16(float lo, float hi) { const f32x2 v = (f32x2){lo, hi}; const bf16x2_t b = __builtin_convertvector(v, bf16x2_t); return __builtin_bit_cast(unsigned, b); }
DI float fast_exp2(float x) { return __builtin_amdgcn_exp2f(x); }
DI float fast_rcp(float x) { return __builtin_amdgcn_rcpf(x); }
DI float sigmoidf_(float x) { return fast_rcp(1.0f + fast_exp2(-x * LOG2E)); }
DI float siluf_(float x) { return x * sigmoidf_(x); }
DI float tanhf_(float x) { const float e = fast_exp2(-2.0f * LOG2E * __builtin_fabsf(x)); const float t = (1.0f - e) * fast_rcp(1.0f + e); return x < 0.f ? -t : t; }
#define DPP_ADD(x, ctrl) ((x) + __builtin_bit_cast(float, __builtin_amdgcn_update_dpp(0, __builtin_bit_cast(int, (x)), (ctrl), 0xf, 0xf, false)))
DI float rsum16(float x) { x = DPP_ADD(x, 0x128); x = DPP_ADD(x, 0x124); x = DPP_ADD(x, 0x122); x = DPP_ADD(x, 0x121); return x; }
DI float sum16(float v) { return rsum16(v); }
DI float wave_sum(float v) {
    v = rsum16(v);
    { auto rr = __builtin_amdgcn_permlane16_swap(__float_as_uint(v), __float_as_uint(v), false, false); v = __uint_as_float(rr[0]) + __uint_as_float(rr[1]); }
    { auto rr = __builtin_amdgcn_permlane32_swap(__float_as_uint(v), __float_as_uint(v), false, false); v = __uint_as_float(rr[0]) + __uint_as_float(rr[1]); }
    return v;
}
DI int row_vec(int row) { return (row % TPB) < CTXL ? 2 : row / TPB; }
#define MIX_MERGE 1
#define XB_TMO      128
#define XB_XCNT(j)  (256  + 64 * (j))
#define XB_XSUB(j)  (1280 + 64 * (j))
#define XB_XGEN(j)  (2304 + 64 * (j))
#define XB_TOP      3328
#define XB_TOPGEN   3392
#define XCD_BAR_WORDS 3456
#define XB_SPIN_CAP (1u << 25)
DI unsigned xb_ld(unsigned* p)              { return __hip_atomic_load(p, __ATOMIC_RELAXED, __HIP_MEMORY_SCOPE_AGENT); }
DI unsigned xb_add(unsigned* p, unsigned v) { return __hip_atomic_fetch_add(p, v, __ATOMIC_RELAXED, __HIP_MEMORY_SCOPE_AGENT); }
DI unsigned xb_xcc_id() { return (unsigned)__builtin_amdgcn_s_getreg((3 << 11) | 20) & 0xFu; }
#define XB_SPIN(cond, bar) do { unsigned _sp = 0; while (cond) { __builtin_amdgcn_s_sleep(1); \
    if ((++_sp & 255u) == 0u) { if (xb_ld(&(bar)[XB_TMO])) break; if (_sp > XB_SPIN_CAP) { atomicAdd(&(bar)[XB_TMO], 1u); break; } } } } while (0)
struct XcdBarrier { unsigned* bar; unsigned x; volatile LAS unsigned* st; };
DI XcdBarrier xcd_barrier_post(unsigned* bar, volatile LAS unsigned* st) {
    XcdBarrier b; b.bar = bar; b.x = xb_xcc_id(); b.st = st;
    if (threadIdx.x == 0) (void)xb_add(&bar[XB_XCNT(b.x)], 1u);
    return b;
}
DI void xcd_barrier_complete(unsigned* bar, unsigned x, unsigned& nloc, unsigned& nx) {
    const unsigned G = gridDim.x * gridDim.y * gridDim.z;
    unsigned sum, cnt, mine, sp = 0u;
    for (;;) {
        sum = 0u; cnt = 0u; mine = 0u;
#pragma unroll
        for (unsigned j = 0; j < 16; ++j) { const unsigned c = xb_ld(&bar[XB_XCNT(j)]); sum += c; cnt += (c > 0u) ? 1u : 0u; mine = (j == x) ? c : mine; }
        if (sum == G) break;
        __builtin_amdgcn_s_sleep(1);
        if ((++sp & 255u) == 0u) { if (xb_ld(&bar[XB_TMO])) break; if (sp > XB_SPIN_CAP) { atomicAdd(&bar[XB_TMO], 1u); break; } }
    }
    nloc = mine > 0u ? mine : 1u; nx = cnt > 0u ? cnt : 1u;
}
template <bool FIRST>
DI void xcd_barrier_t(const XcdBarrier& b) {
    asm volatile("s_waitcnt vmcnt(0)" ::: "memory");
    __syncthreads();
    if (threadIdx.x == 0) {
        unsigned* bar = b.bar; asm volatile("" : "+s"(bar));
        __builtin_amdgcn_s_waitcnt(0);
        unsigned nloc = b.st[0], nx = b.st[1];
        if (FIRST) { if (nloc == 0u) { xcd_barrier_complete(bar, b.x, nloc, nx); b.st[0] = nloc; b.st[1] = nx; } }
        else if (nloc == 0u) { atomicAdd(&bar[XB_TMO], 1u); nloc = 1u; nx = 1u; }
        const unsigned old = xb_add(&bar[XB_XSUB(b.x)], 1u);
        const unsigned gen = old / nloc;
        if (old + 1u == (gen + 1u) * nloc) {
            __builtin_amdgcn_fence(__ATOMIC_RELEASE, "agent");
            asm volatile("s_waitcnt vmcnt(0)" ::: "memory");
            const unsigned og = xb_add(&bar[XB_TOP], 1u);
            const unsigned tg = og / nx;
            if (og + 1u == (tg + 1u) * nx) xb_add(&bar[XB_TOPGEN], 1u);
            else XB_SPIN(xb_ld(&bar[XB_TOPGEN]) == tg, bar);
            __builtin_amdgcn_fence(__ATOMIC_ACQUIRE, "agent");
            xb_add(&bar[XB_XGEN(b.x)], 1u);
            asm volatile("s_waitcnt vmcnt(0)" ::: "memory");
        } else {
            XB_SPIN(xb_ld(&bar[XB_XGEN(b.x)]) == gen, bar);
            __builtin_amdgcn_fence(__ATOMIC_ACQUIRE, "agent");
            asm volatile("s_waitcnt vmcnt(0)" ::: "memory");
        }
    }
    __syncthreads();
}

namespace pg8 {
constexpr int BM = 256, BK = 64, HALF = 128, HTB = HALF * BK * 2, STAGE_BYTES = 8 * HTB, NXCD = 8, WGM = 8;
__host__ __device__ __forceinline__ int lds_byte(int r, int c) { const int st = (r >> 4) * 2 + (c >> 5), rr = r & 15, cc = c & 31, ob = rr * 64 + cc * 2; return st * 1024 + (ob ^ (((ob >> 9) & 1) << 5)); }
__host__ __device__ __forceinline__ void stage_rc(int b, int& R, int& C) { const int st = b / 1024, sb = b % 1024, swz = sb ^ (((sb >> 9) & 1) << 5); R = (st >> 1) * 16 + swz / 64; C = (st & 1) * 32 + (swz % 64) / 2; }
__host__ __device__ __forceinline__ int perm32(int rho) { const int n = rho >> 4, i = rho & 15; return 8 * (i >> 2) + 4 * n + (i & 3); }

struct Unit { int pm, pn, aux; size_t aoff, boff; };
struct Gemm { const char* A; const char* Bt; int lda, ldb, K; };

struct TileOrder {
    int nM, nN, nwg, G, c;
    DI void init(int nM_, int nN_, int G_, int c_) { nM = nM_; nN = nN_; nwg = nM * nN; G = G_; c = c_; }
    DI bool tile(int i, int& pm, int& pn) const {
        const long L = (long)i * G + c; if (L >= nwg) return false;
        int wgid = (int)L; { const int q = nwg / NXCD, r = nwg % NXCD, xcd = wgid % NXCD, off = wgid / NXCD; wgid = (xcd < r ? xcd * (q + 1) : r * (q + 1) + (xcd - r) * q) + off; }
        const int nig = WGM * nN, gid = wgid / nig, fm = gid * WGM, gsz = (nM - fm) < WGM ? (nM - fm) : WGM;
        pm = fm + ((wgid % nig) % gsz); pn = (wgid % nig) / gsz; return true;
    }
};

template <class Epi, class Sched>
DI void gemm_phase(LAS unsigned char* lds, const Gemm g, const Sched& S, const Epi& E, const int wave_id, const int skew = 0) {
    int lane; asm volatile("v_mbcnt_lo_u32_b32 %0, -1, 0\n\tv_mbcnt_hi_u32_b32 %0, -1, %0" : "=v"(lane));
    const int wid = wave_id, tid = wid * 64 + lane, wr = wid >> 2, wc = wid & 3, fr = lane & 15, fq = lane >> 4;
    const int K = g.K, nt = K / BK;
    unsigned voffA[2], voffB[2];
#pragma unroll
    for (int i = 0; i < 2; ++i) { int R, C; stage_rc(tid * 16 + i * 8192, R, C); const int Rb = (R & ~31) + perm32(R & 31);
        voffA[i] = (unsigned)(R * g.lda + C) * 2u; voffB[i] = (unsigned)(Rb * g.ldb + C) * 2u; }
    const size_t kstep = (size_t)(BK * 2);
    const size_t hstepA = (size_t)HALF * g.lda * 2, hstepB = (size_t)HALF * g.ldb * 2;
    const unsigned ldsw = (unsigned)wid * 1024u;
    const int aoff = lds_byte(wr * 64 + fr, fq * 8), boff = lds_byte(wc * 32 + fr, fq * 8);
#define PG8_SA(b, h) (((b) * 2 + (h)) * HTB)
#define PG8_SB(b, h) ((4 + (b) * 2 + (h)) * HTB)
#define PG8_STAGE(bufoff, gbase, voff) do { _Pragma("unroll") for (int _i = 0; _i < 2; ++_i) \
        __builtin_amdgcn_global_load_lds((const unsigned*)((const char*)(gbase) + (voff)[_i]), (LAS unsigned*)(lds + (bufoff) + ldsw + _i * 8192), 16, 0, 0); } while (0)
#define PG8_LDA(dst, b, h) do { _Pragma("unroll") for (int m = 0; m < 4; ++m) _Pragma("unroll") for (int k = 0; k < 2; ++k) dst[m][k] = *(const LAS bf16x8*)(lds + PG8_SA(b, h) + aoff + m * 2048 + k * 1024); } while (0)
#define PG8_LDB(dst, b, h) do { _Pragma("unroll") for (int n = 0; n < 2; ++n) _Pragma("unroll") for (int k = 0; k < 2; ++k) dst[n][k] = *(const LAS bf16x8*)(lds + PG8_SB(b, h) + boff + n * 2048 + k * 1024); } while (0)
#define PG8_MMA(ai, bj, At, Bt) do { __builtin_amdgcn_s_setprio(1); _Pragma("unroll") for (int m = 0; m < 4; ++m) _Pragma("unroll") for (int n = 0; n < 2; ++n) _Pragma("unroll") for (int k = 0; k < 2; ++k) \
        acc[ai][bj][m][n] = __builtin_amdgcn_mfma_f32_16x16x32_bf16(Bt[n][k], At[m][k], acc[ai][bj][m][n], 0, 0, 0); __builtin_amdgcn_s_setprio(0); } while (0)
#define PG8_WAIT_V(n) asm volatile("s_waitcnt vmcnt(" #n ")" ::: "memory")
#define PG8_WAIT_L(n) asm volatile("s_waitcnt lgkmcnt(" #n ")" ::: "memory")
#define PG8_BAR __builtin_amdgcn_s_barrier()
#define PG8_SCHED __builtin_amdgcn_sched_barrier(0)
    Unit cur, nxt; int ui = 0;
    if (!S.next(0, cur)) return;
    for (int sk = (int)((blockIdx.x >> 3) & 7u) * skew; sk > 0; sk -= 100) __builtin_amdgcn_s_sleep(100);
    f32x4 acc[2][2][4][2];
#pragma unroll
    for (int a = 0; a < 2; ++a)
#pragma unroll
        for (int b = 0; b < 2; ++b)
#pragma unroll
            for (int m = 0; m < 4; ++m)
#pragma unroll
                for (int n = 0; n < 2; ++n) acc[a][b][m][n] = (f32x4){0.f, 0.f, 0.f, 0.f};
    bf16x8 At[4][2], B0[2][2], B1[2][2];
    const char* cA = g.A + cur.aoff; const char* cB = g.Bt + cur.boff;
    {
        PG8_STAGE(PG8_SB(0, 0), cB, voffB); PG8_STAGE(PG8_SB(0, 1), cB + hstepB, voffB); PG8_STAGE(PG8_SA(0, 0), cA, voffA); PG8_STAGE(PG8_SA(0, 1), cA + hstepA, voffA);
        if (wr == 1) PG8_BAR;
        PG8_WAIT_V(2); PG8_BAR;
        PG8_STAGE(PG8_SB(1, 0), cB + kstep, voffB); PG8_STAGE(PG8_SA(1, 0), cA + kstep, voffA); PG8_STAGE(PG8_SB(1, 1), cB + hstepB + kstep, voffB);
        PG8_WAIT_V(6); PG8_BAR;
    }
    for (;;) {
        const bool has_next = S.next(ui + 1, nxt);
        const char* nA = has_next ? g.A + nxt.aoff : cA; const char* nB = has_next ? g.Bt + nxt.boff : cB;
#pragma nounroll
        for (int t = 0; t < nt; t += 2) {
            const bool last = (t == nt - 2);
            const char* a1 = cA + (size_t)(t + 1) * kstep;
            const char* a2 = last ? nA : cA + (size_t)(t + 2) * kstep; const char* b2 = last ? nB : cB + (size_t)(t + 2) * kstep;
            const char* a3 = a2 + kstep; const char* b3 = b2 + kstep;
            PG8_LDB(B0, 0, 0); PG8_LDB(B1, 0, 1); PG8_SCHED; PG8_LDA(At, 0, 0); PG8_STAGE(PG8_SA(1, 1), a1 + hstepA, voffA);
            PG8_WAIT_V(8); PG8_WAIT_L(0); PG8_BAR; PG8_MMA(0, 0, At, B0); PG8_MMA(0, 1, At, B1); PG8_BAR; PG8_SCHED;
            PG8_LDA(At, 0, 1); PG8_STAGE(PG8_SB(0, 0), b2, voffB); PG8_STAGE(PG8_SB(0, 1), b2 + hstepB, voffB); PG8_STAGE(PG8_SA(0, 0), a2, voffA);
            PG8_WAIT_V(8); PG8_WAIT_L(0); PG8_BAR; PG8_MMA(1, 0, At, B0); PG8_MMA(1, 1, At, B1); PG8_BAR; PG8_SCHED;
            PG8_LDB(B0, 1, 0); PG8_LDB(B1, 1, 1); PG8_SCHED; PG8_LDA(At, 1, 0); PG8_STAGE(PG8_SA(0, 1), a2 + hstepA, voffA);
            PG8_WAIT_V(8); PG8_WAIT_L(0); PG8_BAR; PG8_MMA(0, 0, At, B0); PG8_MMA(0, 1, At, B1); PG8_BAR; PG8_SCHED;
            PG8_LDA(At, 1, 1); PG8_STAGE(PG8_SB(1, 0), b3, voffB); PG8_STAGE(PG8_SB(1, 1), b3 + hstepB, voffB); PG8_STAGE(PG8_SA(1, 0), a3, voffA);
            PG8_WAIT_V(8); PG8_WAIT_L(0); PG8_BAR; PG8_MMA(1, 0, At, B0); PG8_MMA(1, 1, At, B1); PG8_BAR; PG8_SCHED;
        }
        if (wr == 0) PG8_BAR;
        E(acc, cur, wr, wc, fr, fq);
        if (!has_next) break;
#pragma unroll
        for (int a = 0; a < 2; ++a)
#pragma unroll
            for (int b = 0; b < 2; ++b)
#pragma unroll
                for (int m = 0; m < 4; ++m)
#pragma unroll
                    for (int n = 0; n < 2; ++n) acc[a][b][m][n] = (f32x4){0.f, 0.f, 0.f, 0.f};
        cur = nxt; cA = nA; cB = nB; ++ui;
        if (wr == 1) PG8_BAR;
    }
    PG8_WAIT_V(0);
    PG8_BAR;
#undef PG8_SA
#undef PG8_SB
#undef PG8_STAGE
#undef PG8_LDA
#undef PG8_LDB
#undef PG8_MMA
#undef PG8_WAIT_V
#undef PG8_WAIT_L
#undef PG8_BAR
#undef PG8_SCHED
}
}
struct Frame {
    LAS unsigned char* lds;
    volatile LAS unsigned* MISC;
    unsigned* ctl;
    unsigned char* ws;
    int tid, lane, wave, vcu, G, bx;
    float* out;
};
DI Frame relane(const Frame& F) { Frame Q = F; int ln; unsigned char* w = F.ws; int wv = F.wave;
    asm volatile("v_mbcnt_lo_u32_b32 %0, -1, 0\n\tv_mbcnt_hi_u32_b32 %0, -1, %0" : "=v"(ln));
    asm volatile("" : "+s"(w), "+s"(wv)); Q.ws = w; Q.ctl = (unsigned*)w; Q.lane = ln; Q.wave = wv; Q.tid = wv * 64 + ln; return Q; }
typedef const float* cfp_t;
DI cfp_t inp(int i) { unsigned long long kp = (unsigned long long)__builtin_amdgcn_kernarg_segment_ptr(); asm volatile("" : "+s"(kp)); return ((const __attribute__((address_space(4))) cfp_t*)kp)[i]; }
#define FX(F) ((float*)((F).ws + WS_X))
#define FHB(F) ((bf16_t*)((F).ws + WS_HB))
#define FP(F) ((bf16_t*)((F).ws + WS_P))
#define FMOD(F) ((float*)((F).ws + WS_MOD))
enum { I_X = 0, I_C, I_CTX, I_CCTX, I_WMOD, I_BMOD, I_NORM1, I_NORM2, I_WIN, I_WBR, I_WOUT, I_MU, I_W0, I_W1, I_W2, I_A0, I_A1, I_A2, I_V0, I_V1, I_V2,
       I_G1, I_G2, I_KK, I_KA, I_RK, I_LNW, I_LNB, I_SINK, I_MQN, I_WUQ, I_MKVN, I_WUKV, I_GQN, I_GKN, I_FW1, I_FW3, I_FW2, I_ROUTER, I_MW1, I_MW3, I_MW2, I_FNORM };

DI const float* modp(const Frame& F, int l, int vec, int which) { return FMOD(F) + ((size_t)(l * 3 + vec) * 6 + which) * 1024; }

using pg8::Unit;
struct SchedGrid {
    pg8::TileOrder T; int lda, ldb, acol, lat;
    DI bool next(int i, Unit& u) const { int pm, pn; if (!T.tile(i, pm, pn)) return false; if (lat) pm = pm < 32 ? pm + 1 : pm + 2; u.pm = pm; u.pn = pn; u.aux = 0;
        u.aoff = ((size_t)pm * 256 * lda + acol) * 2; u.boff = (size_t)pn * 256 * ldb * 2; return true; }
};
struct SchedLat {
    pg8::TileOrder T; int lda, ldb;
    DI bool next(int i, Unit& u) const { int lp, pn; if (!T.tile(i, lp, pn)) return false; const int pm = lp < 32 ? lp + 1 : lp + 2; u.pm = pm; u.pn = pn; u.aux = 0;
        u.aoff = (size_t)pm * 256 * lda * 2; u.boff = (size_t)pn * 256 * ldb * 2; return true; }
};
struct SchedCtxK {
    int G, c, ns, kc, lda, ldb;
    DI bool next(int i, Unit& u) const { const int L = i * G + c; if (L >= 8 * ns) return false;
        const int sl = L % ns, t = L / ns, pn = t & 3, pm = (t >> 2) ? 33 : 0; u.pm = pm; u.pn = pn; u.aux = sl;
        u.aoff = ((size_t)pm * 256 * lda + (size_t)sl * kc) * 2; u.boff = ((size_t)pn * 256 * ldb + (size_t)sl * kc) * 2; return true; }
};
struct SchedL3B {
    int G, c;
    DI bool next(int i, Unit& u) const {
        int L = i * G + c; if (L >= 660) return false;
        int grp, pm, pn; size_t bb; int acol;
        if (L < 396) { grp = 0; pm = L % 66; pn = L / 66; bb = 0; acol = PC_Z; }
        else if (L < 528) { L -= 396; grp = 1; pm = L % 66; pn = L / 66; bb = WL_UQ - WL_L1; acol = PC_CQ; }
        else { L -= 528; grp = 2; pm = L % 66; pn = L / 66; bb = WL_UKV - WL_L1; acol = PC_CKV; }
        u.pm = pm; u.pn = pn; u.aux = grp; u.aoff = ((size_t)pm * 256 * LDP + acol) * 2; u.boff = bb + (size_t)pn * 256 * 256 * 2; return true;
    }
};
struct SchedL3C {
    int G, c, layer;
    DI bool next(int i, Unit& u) const {
        const int L = i * G + c; const int ntile = layer == 0 ? 5 : 6; if (L >= 66 * ntile) return false;
        const int pm = L % 66; int pn = L / 66; if (layer == 0 && pn >= 4) pn = 5;
        u.pm = pm; u.pn = pn; u.aux = 0; u.aoff = ((size_t)pm * 256 * 1536 + pn * 256) * 2; u.boff = (size_t)pn * 256 * 256 * 2; return true;
    }
};
struct SchedMerge {
    int G, c, lat, b0, nb, one;
    DI bool next(int i, Unit& u) const {
        const int ti = one ? c : (i / nb) * G + c; if (ti >= (lat ? 256 : 264) || (one && i >= nb)) return false; const int br = b0 + i % nb;
        int pm, pn; if (lat) { const int lp = ti & 63; pm = lp < 32 ? lp + 1 : lp + 2; pn = ti >> 6; } else { pm = ti % 66; pn = ti / 66; }
        u.pm = pm; u.pn = pn; u.aux = br; u.aoff = ((size_t)pm * 256 * 1024 + br * 256) * 2; u.boff = ((size_t)(br * 1024 + pn * 256) * 256) * 2; return true;
    }
};
struct SchedMoe {
    int G, c, ncol, lda, ldb, nrowB; int cp[9];
    DI bool next(int i, Unit& u) const {
        const int L = i * G + c; if (L >= cp[8] * ncol) return false;
        const int p = L / ncol, j = L % ncol; int e = 0;
#pragma unroll
        for (int q = 1; q < 8; ++q) e += (p >= cp[q]) ? 1 : 0;
        u.pm = p; u.pn = e; u.aux = j; u.aoff = (size_t)p * 256 * lda * 2; u.boff = ((size_t)e * nrowB + (size_t)j * 256) * ldb * 2; return true;
    }
};

typedef const f32x4 (&AccRef)[2][2][4][2];
#define EPI_ROWS(u) _Pragma("unroll") for (int ai = 0; ai < 2; ++ai) _Pragma("unroll") for (int m = 0; m < 4; ++m)
#define EPI_ROW(u) ((u).pm * 256 + ai * 128 + wr * 64 + m * 16 + fr)
DI u32x4 pack8(const f32x4 a, const f32x4 b) { u32x4 w; w.x = cvt_pk_bf16(a[0], a[1]); w.y = cvt_pk_bf16(a[2], a[3]); w.z = cvt_pk_bf16(b[0], b[1]); w.w = cvt_pk_bf16(b[2], b[3]); return w; }
DI void unpack8(const u32x4 w, f32x4& a, f32x4& b) { a = (f32x4){bflo(w.x), bfhi(w.x), bflo(w.y), bfhi(w.y)}; b = (f32x4){bflo(w.z), bfhi(w.z), bflo(w.w), bfhi(w.w)}; }

struct EpiWin {
    bf16_t* P; int sigfrom; int tm;
    DI void operator()(AccRef acc, const Unit& u, int wr, int wc, int fr, int fq) const {
        asm volatile("" : "+v"(fr), "+v"(fq));
        const bool sig = u.pn >= sigfrom;
        EPI_ROWS(u) { bf16_t* rp = tm ? P + (size_t)u.pn * NROW * 256 + (size_t)EPI_ROW(u) * 256 + wc * 32 + fq * 8 : P + (size_t)EPI_ROW(u) * LDP + u.pn * 256 + wc * 32 + fq * 8;
#pragma unroll
            for (int bj = 0; bj < 2; ++bj) { f32x4 a = acc[ai][bj][m][0], b = acc[ai][bj][m][1];
                if (sig) {
#pragma unroll
                    for (int j = 0; j < 4; ++j) { a[j] = sigmoidf_(a[j]); b[j] = sigmoidf_(b[j]); } }
                *(GAS u32x4*)(rp + bj * 128) = pack8(a, b); } asm volatile("" ::: "memory"); }
    }
};
struct EpiNull {
    bf16_t* P;
    DI void operator()(AccRef acc, const Unit& u, int wr, int wc, int fr, int fq) const {
        asm volatile("" : "+v"(fr), "+v"(fq));
        if (u.pm < 0) {
        EPI_ROWS(u) { bf16_t* rp = P + (size_t)EPI_ROW(u) * LDP + u.pn * 256 + wc * 32 + fq * 8;
#pragma unroll
            for (int bj = 0; bj < 2; ++bj) *(GAS u32x4*)(rp + bj * 128) = pack8(acc[ai][bj][m][0], acc[ai][bj][m][1]); } }
    }
};
struct EpiL3B {
    bf16_t* T; bf16_t* Qm; bf16_t* Km; bf16_t* Vm; const float* rope32;
    DI void operator()(AccRef acc, const Unit& u, int wr, int wc, int fr, int fq) const {
        asm volatile("" : "+v"(fr), "+v"(fq));
        const int grp = u.aux, pn = u.pn;
        EPI_ROWS(u) { const int row = EPI_ROW(u);
#pragma unroll
            for (int bj = 0; bj < 2; ++bj) { f32x4 a = acc[ai][bj][m][0], b = acc[ai][bj][m][1]; const int ct = bj * 128 + wc * 32 + fq * 8;
                if (grp == 0) {
                    if (pn < 2) {
#pragma unroll
                        for (int j = 0; j < 4; ++j) { a[j] = tanhf_(a[j]); b[j] = tanhf_(b[j]); } }
                    else if (pn == 5) {
#pragma unroll
                        for (int j = 0; j < 4; ++j) { a[j] = sigmoidf_(a[j]); b[j] = sigmoidf_(b[j]); } }
                    *(GAS u32x4*)(T + (size_t)row * 1536 + pn * 256 + ct) = pack8(a, b);
                } else if (grp == 1) {
                    const int col = pn * 256 + ct;
                    if (col < 384) {
                        const int within = col % 96; const int pos = row % TPB;
                        if (within >= 64 && pos >= CTXL) {
                            const float* rt = rope32 + ((size_t)(pos - CTXL) * 16 + ((within - 64) >> 1)) * 2;
                            const f32x4 cs0 = *(const f32x4*)rt, cs1 = *(const GAS f32x4*)(rt + 4);
                            const f32x4 a2 = (f32x4){a[0] * cs0[0] - a[1] * cs0[1], a[0] * cs0[1] + a[1] * cs0[0], a[2] * cs0[2] - a[3] * cs0[3], a[2] * cs0[3] + a[3] * cs0[2]};
                            const f32x4 b2 = (f32x4){b[0] * cs1[0] - b[1] * cs1[1], b[0] * cs1[1] + b[1] * cs1[0], b[2] * cs1[2] - b[3] * cs1[3], b[2] * cs1[3] + b[3] * cs1[2]};
                            a = a2; b = b2;
                        }
                        a = a * QS96; b = b * QS96;
                        *(GAS u32x4*)(Qm + (size_t)row * 384 + col) = pack8(a, b);
                    }
                } else {
                    const int col = pn * 256 + ct, head = col >> 7, within = col & 127;
                    if (within < 64) *(GAS u32x4*)(Km + (size_t)row * 384 + head * 96 + within) = pack8(a, b);
                    else *(GAS u32x4*)(Vm + (size_t)row * 256 + head * 64 + (within - 64)) = pack8(a, b);
                }
            } asm volatile("" ::: "memory"); }
    }
};
struct EpiL3C {
    int layer; const float* w0; const float* a0; const float* v0; const float* k_a;
    float* W; bf16_t* KD; bf16_t* BB; const bf16_t* Kr; const bf16_t* KK; bf16_t* V; const bf16_t* VF; bf16_t* Gg;
    DI void operator()(AccRef acc, const Unit& u, int wr, int wc, int fr, int fq) const {
        asm volatile("" : "+v"(fr), "+v"(fq));
        const int pn = u.pn;
        EPI_ROWS(u) { const int row = EPI_ROW(u);
#pragma unroll
            for (int bj = 0; bj < 2; ++bj) { f32x4 a = acc[ai][bj][m][0], b = acc[ai][bj][m][1]; const int ct = bj * 128 + wc * 32 + fq * 8;
                if (pn < 2) {
                    const f32x4 wa = *(const GAS f32x4*)(w0 + pn * 256 + ct), wb = *(const GAS f32x4*)(w0 + pn * 256 + ct + 4);
                    f32x4 oa, ob;
#pragma unroll
                    for (int j = 0; j < 4; ++j) { oa[j] = fast_exp2(-0.6065306597f * LOG2E * sigmoidf_(wa[j] + a[j])); ob[j] = fast_exp2(-0.6065306597f * LOG2E * sigmoidf_(wb[j] + b[j])); }
                    float* wp = W + (size_t)row * 512 + pn * 256 + ct; *(f32x4*)wp = oa; *(GAS f32x4*)(wp + 4) = ob;
                } else if (pn < 4) {
                    const int d = pn - 2;
                    const f32x4 aa = *(const GAS f32x4*)(a0 + d * 256 + ct), ab = *(const GAS f32x4*)(a0 + d * 256 + ct + 4);
                    const f32x4 ka = *(const GAS f32x4*)(k_a + ct), kb = *(const GAS f32x4*)(k_a + ct + 4);
                    f32x4 k0, k1, q0, q1; unpack8(*(const GAS u32x4*)(Kr + (size_t)row * 256 + ct), k0, k1); unpack8(*(const GAS u32x4*)(KK + (size_t)row * 256 + ct), q0, q1);
                    f32x4 kd0, kd1, bb0, bb1;
#pragma unroll
                    for (int j = 0; j < 4; ++j) { const float s0 = sigmoidf_(aa[j] + a[j]), s1 = sigmoidf_(ab[j] + b[j]);
                        kd0[j] = k0[j] * (1.0f + (s0 - 1.0f) * ka[j]); kd1[j] = k1[j] * (1.0f + (s1 - 1.0f) * kb[j]); bb0[j] = q0[j] * s0; bb1[j] = q1[j] * s1; }
                    *(GAS u32x4*)(KD + (size_t)row * 512 + d * 256 + ct) = pack8(kd0, kd1); *(GAS u32x4*)(BB + (size_t)row * 512 + d * 256 + ct) = pack8(bb0, bb1);
                } else if (pn == 4) {
                    const f32x4 va = *(const GAS f32x4*)(v0 + ct), vb = *(const GAS f32x4*)(v0 + ct + 4);
                    f32x4 r0, r1, f0, f1; unpack8(*(const GAS u32x4*)(V + (size_t)row * 256 + ct), r0, r1); unpack8(*(const GAS u32x4*)(VF + (size_t)row * 256 + ct), f0, f1);
#pragma unroll
                    for (int j = 0; j < 4; ++j) { r0[j] = r0[j] + (f0[j] - r0[j]) * sigmoidf_(va[j] + a[j]); r1[j] = r1[j] + (f1[j] - r1[j]) * sigmoidf_(vb[j] + b[j]); }
                    *(GAS u32x4*)(V + (size_t)row * 256 + ct) = pack8(r0, r1);
                } else {
                    *(GAS u32x4*)(Gg + (size_t)row * 256 + ct) = pack8(a, b);
                }
                asm volatile("" ::: "memory");
            } }
    }
};
struct EpiMerge {
    const bf16_t* P; bf16_t* MB; int init_br;
    DI void operator()(AccRef acc, const Unit& u, int wr, int wc, int fr, int fq) const {
        asm volatile("" : "+v"(fr), "+v"(fq));
        const int br = u.aux;
        const int col = u.pn * 256 + wc * 32 + fq * 8;
#pragma unroll
        for (int ai = 0; ai < 2; ++ai) {
            u32x4 gt[4][2], pm[4][2];
#pragma unroll
            for (int m = 0; m < 4; ++m) { const int row = EPI_ROW(u);
#pragma unroll
                for (int bj = 0; bj < 2; ++bj) { gt[m][bj] = *(const GAS u32x4*)(P + (size_t)row * LDP + PC_GATE + br * 1024 + col + bj * 128);
                    pm[m][bj] = br != init_br ? *(const GAS u32x4*)(MB + (size_t)row * 1024 + col + bj * 128) : (u32x4){0u, 0u, 0u, 0u}; } }
#pragma unroll
            for (int m = 0; m < 4; ++m) { const int row = EPI_ROW(u);
#pragma unroll
                for (int bj = 0; bj < 2; ++bj) { f32x4 g0, g1, p0, p1; unpack8(gt[m][bj], g0, g1); unpack8(pm[m][bj], p0, p1);
                    *(GAS u32x4*)(MB + (size_t)row * 1024 + col + bj * 128) = pack8(acc[ai][bj][m][0] * g0 + p0, acc[ai][bj][m][1] * g1 + p1); } }
            asm volatile("" ::: "memory");
        }
    }
};
struct EpiMergeP {
    const bf16_t* P; bf16_t* D;
    DI void operator()(AccRef acc, const Unit& u, int wr, int wc, int fr, int fq) const {
        asm volatile("" : "+v"(fr), "+v"(fq));
        const int br = u.aux;
        const int col = u.pn * 256 + wc * 32 + fq * 8;
#pragma unroll
        for (int ai = 0; ai < 2; ++ai) {
            u32x4 gt[4][2];
#pragma unroll
            for (int m = 0; m < 4; ++m) { const int row = EPI_ROW(u);
#pragma unroll
                for (int bj = 0; bj < 2; ++bj) gt[m][bj] = *(const GAS u32x4*)(P + (size_t)row * LDP + PC_GATE + br * 1024 + col + bj * 128); }
#pragma unroll
            for (int m = 0; m < 4; ++m) { const int row = EPI_ROW(u);
#pragma unroll
                for (int bj = 0; bj < 2; ++bj) { f32x4 g0, g1; unpack8(gt[m][bj], g0, g1);
                    *(GAS u32x4*)(D + (size_t)row * 1024 + col + bj * 128) = pack8(acc[ai][bj][m][0] * g0, acc[ai][bj][m][1] * g1); } }
            asm volatile("" ::: "memory");
        }
    }
};
struct EpiMergeA {
    const bf16_t* P; bf16_t* MB; const bf16_t* X1; const bf16_t* X2;
    DI void operator()(AccRef acc, const Unit& u, int wr, int wc, int fr, int fq) const {
        asm volatile("" : "+v"(fr), "+v"(fq));
        const int col = u.pn * 256 + wc * 32 + fq * 8;
#pragma unroll
        for (int ai = 0; ai < 2; ++ai) {
#pragma unroll
            for (int m = 0; m < 4; ++m) { const int row = EPI_ROW(u);
                u32x4 gt[2], pm[2], x1[2], x2[2];
#pragma unroll
                for (int bj = 0; bj < 2; ++bj) { const size_t o = (size_t)row * 1024 + col + bj * 128;
                    gt[bj] = *(const GAS u32x4*)(P + (size_t)row * LDP + PC_GATE + col + bj * 128); pm[bj] = *(const GAS u32x4*)(MB + o); x1[bj] = *(const GAS u32x4*)(X1 + o); x2[bj] = *(const GAS u32x4*)(X2 + o); }
#pragma unroll
                for (int bj = 0; bj < 2; ++bj) { f32x4 g0, g1, p0, p1, a0, a1, b0, b1; unpack8(gt[bj], g0, g1); unpack8(pm[bj], p0, p1); unpack8(x1[bj], a0, a1); unpack8(x2[bj], b0, b1);
                    *(GAS u32x4*)(MB + (size_t)row * 1024 + col + bj * 128) = pack8(acc[ai][bj][m][0] * g0 + ((p0 + a0) + b0), acc[ai][bj][m][1] * g1 + ((p1 + a1) + b1)); }
            }
            asm volatile("" ::: "memory");
        }
    }
};
struct EpiResid {
    float* X; const float* mod_l; int which;
    DI void operator()(AccRef acc, const Unit& u, int wr, int wc, int fr, int fq) const {
        asm volatile("" : "+v"(fr), "+v"(fq));
        const int vec = (u.pm % 33 == 0) ? 2 : u.pm / 33;
        const float* gv = mod_l + ((size_t)vec * 6 + which) * 1024 + u.pn * 256 + wc * 32 + fq * 8;
        f32x4 g[2][2];
#pragma unroll
        for (int bj = 0; bj < 2; ++bj) { g[bj][0] = *(const GAS f32x4*)(gv + bj * 128); g[bj][1] = *(const GAS f32x4*)(gv + bj * 128 + 4); }
#pragma unroll
        for (int ai = 0; ai < 2; ++ai)
#pragma unroll
            for (int mh = 0; mh < 2; ++mh) {
                f32x4 xv[2][2][2];
#pragma unroll
                for (int mm = 0; mm < 2; ++mm) { const int m = 2 * mh + mm; const float* xp = X + (size_t)EPI_ROW(u) * 1024 + u.pn * 256 + wc * 32 + fq * 8;
#pragma unroll
                    for (int bj = 0; bj < 2; ++bj) { xv[mm][bj][0] = *(const GAS f32x4*)(xp + bj * 128); xv[mm][bj][1] = *(const GAS f32x4*)(xp + bj * 128 + 4); } }
#pragma unroll
                for (int mm = 0; mm < 2; ++mm) { const int m = 2 * mh + mm; float* xp = X + (size_t)EPI_ROW(u) * 1024 + u.pn * 256 + wc * 32 + fq * 8;
#pragma unroll
                    for (int bj = 0; bj < 2; ++bj) { *(GAS f32x4*)(xp + bj * 128) = xv[mm][bj][0] + g[bj][0] * acc[ai][bj][m][0]; *(GAS f32x4*)(xp + bj * 128 + 4) = xv[mm][bj][1] + g[bj][1] * acc[ai][bj][m][1]; } }
                asm volatile("" ::: "memory");
            }
    }
};
struct EpiSlab {
    float* slab;
    DI void operator()(AccRef acc, const Unit& u, int wr, int wc, int fr, int fq) const {
        asm volatile("" : "+v"(fr), "+v"(fq));
        const int crow0 = (u.pm == 33 ? 256 : 0) - u.pm * 256;
        EPI_ROWS(u) { float* xp = slab + ((size_t)u.aux * 512 + (size_t)(EPI_ROW(u) + crow0)) * 1024 + u.pn * 256 + wc * 32 + fq * 8;
#pragma unroll
            for (int bj = 0; bj < 2; ++bj) { *(GAS f32x4*)(xp + bj * 128) = acc[ai][bj][m][0]; *(GAS f32x4*)(xp + bj * 128 + 4) = acc[ai][bj][m][1]; }
            asm volatile("" ::: "memory"); }
    }
};
struct EpiSwiGlu {
    bf16_t* U; int moe;
    DI void operator()(AccRef acc, const Unit& u, int wr, int wc, int fr, int fq) const {
        asm volatile("" : "+v"(fr), "+v"(fq));
        const int tile = moe ? u.aux : u.pn;
        EPI_ROWS(u) { bf16_t* up = U + (size_t)EPI_ROW(u) * DFF + tile * 128 + wc * 32 + fq * 8;
            f32x4 a = acc[ai][0][m][0], b = acc[ai][0][m][1]; const f32x4 c = acc[ai][1][m][0], d = acc[ai][1][m][1];
#pragma unroll
            for (int j = 0; j < 4; ++j) { a[j] = siluf_(a[j]) * c[j]; b[j] = siluf_(b[j]) * d[j]; }
            *(u32x4*)up = pack8(a, b); asm volatile("" ::: "memory"); }
    }
};
struct EpiMoeDown {
    bf16_t* Yg; const float* rowgate;
    DI void operator()(AccRef acc, const Unit& u, int wr, int wc, int fr, int fq) const {
        asm volatile("" : "+v"(fr), "+v"(fq));
        EPI_ROWS(u) { const int row = EPI_ROW(u); const float gt = *(const GAS float*)(rowgate + row); bf16_t* yp = Yg + (size_t)row * 1024 + u.aux * 256 + wc * 32 + fq * 8;
#pragma unroll
            for (int bj = 0; bj < 2; ++bj) *(GAS u32x4*)(yp + bj * 128) = pack8(acc[ai][bj][m][0] * gt, acc[ai][bj][m][1] * gt);
            asm volatile("" ::: "memory"); }
    }
};
struct ConvMat { const float* s0; const float* s1; int ld; int ksrc; bf16_t* dst; int N; int K; int kind; int nvalid; };
DI int perm64(int i) { return (i >> 1) + 32 * (i & 1); }
DI int perm32r(int i) { return (i >> 1) + 16 * (i & 1); }
DI const float* conv_col(const ConvMat& M, int n) {
    if (M.kind == 0) return n < M.nvalid ? M.s0 + n : nullptr;
    if (M.kind == 1) {
        int col;
        if (n < 1024) col = n;
        else if (n < 1280) { const int j = n - 1024; col = 1024 + (j & ~63) + perm64(j & 63); }
        else if (n < 1408) { const int j = n - 1280; col = 1280 + (j & ~63) + perm64(j & 63); }
        else if (n < 1920) col = n;
        else if (n < 1952) col = 1920 + perm32r(n - 1920);
        else if (n < 2048) return nullptr;
        else if (n < 2304) { const int j = n - 2048; col = 1952 + (j & ~63) + perm64(j & 63); }
        else if (n < 2432) { const int j = n - 2304; col = 2208 + (j & ~63) + perm64(j & 63); }
        else if (n < 2560) col = 2336 + (n - 2432);
        else col = 2464 + (n - 2560);
        return M.s0 + col;
    }
    if (M.kind == 2) {
        if (n >= 384) return nullptr;
        const int h = n / 96, w = n % 96;
        return M.s0 + (w < 64 ? n : h * 96 + 64 + perm32r(w - 64));
    }
    {
        const int t = n >> 8, half = (n >> 7) & 1, j = n & 127;
        return (const float*)((uintptr_t)M.s0 + (uintptr_t)half * ((uintptr_t)M.s1 - (uintptr_t)M.s0)) + t * 128 + j;
    }
}
DI void conv_item(const ConvMat& M, int item, LAS float* scr, int lane) {
    const int nkb = M.K / 64, nb = item / nkb, kb = item % nkb, n0 = nb * 32, k0 = kb * 64;
    const float* cp = conv_col(M, n0 + (lane & 31));
#pragma unroll 8
    for (int i = 0; i < 32; ++i) { const int kk = 2 * i + (lane >> 5); const int k = k0 + kk;
        float v = 0.f; if (cp != nullptr && k < M.ksrc) v = *(const GAS float*)(cp + (size_t)k * M.ld);
        scr[kk * 33 + (lane & 31)] = v; }
    LDS_WAIT(); asm volatile("" ::: "memory");
    const int c = lane & 7;
#pragma unroll
    for (int j = 0; j < 4; ++j) { const int n = (lane >> 3) + 8 * j; const LAS float* s = scr + (8 * c) * 33 + n;
        u32x4 o; o.x = pk2(s[0 * 33], s[1 * 33]); o.y = pk2(s[2 * 33], s[3 * 33]); o.z = pk2(s[4 * 33], s[5 * 33]); o.w = pk2(s[6 * 33], s[7 * 33]);
        *(GAS u32x4*)(M.dst + (size_t)(n0 + n) * M.K + k0 + 8 * c) = o; }
    LDS_WAIT(); asm volatile("" ::: "memory");
}
DI ConvMat mkmat(const float* s0, const float* s1, int ld, int ksrc, bf16_t* dst, int N, int K, int kind, int nvalid) { ConvMat M; M.s0 = s0; M.s1 = s1; M.ld = ld; M.ksrc = ksrc; M.dst = dst; M.N = N; M.K = K; M.kind = kind; M.nvalid = nvalid; return M; }
DI bool conv_slow_block(const ConvMat& M, int b128) { return M.kind == 2 || (M.kind == 1 && ((b128 >= 8 && b128 <= 10) || (b128 >= 15 && b128 <= 18))); }
DI void conv_item_fast(const ConvMat& M, int item, LAS bf16_t* scr, int lane) {
    const int nkb = M.K / 32, nb = item / nkb, kb = item % nkb, n0 = nb * 128, k0 = kb * 32;
    if (conv_slow_block(M, nb)) return;
    const float* cp = conv_col(M, n0);
    int nv = 128; if (M.kind == 0) { nv = M.nvalid - n0; nv = nv < 0 ? 0 : (nv > 128 ? 128 : nv); }
    const int q = lane & 31, kr = lane >> 5;
    const bool cok = cp != nullptr && 4 * q < nv;
    f32x4 v[16];
#pragma unroll
    for (int i = 0; i < 16; ++i) { const int k = k0 + 2 * i + kr; v[i] = (cok && k < M.ksrc) ? *(const GAS f32x4*)(cp + (size_t)k * M.ld + 4 * q) : (f32x4){0.f, 0.f, 0.f, 0.f}; }
#pragma unroll
    for (int i = 0; i < 16; ++i) { u32x2 o; o.x = pk2(v[i][0], v[i][1]); o.y = pk2(v[i][2], v[i][3]); *(LAS u32x2*)(scr + (2 * i + kr) * 132 + 4 * q) = o; }
    LDS_WAIT(); asm volatile("" ::: "memory");
#pragma unroll
    for (int p = 0; p < 2; ++p)
#pragma unroll
        for (int c = 0; c < 4; ++c) { const int n = lane + 64 * p; const LAS bf16_t* sp = scr + (8 * c) * 132 + n;
            u32x4 o; o.x = (unsigned)sp[0] | ((unsigned)sp[132] << 16); o.y = (unsigned)sp[2 * 132] | ((unsigned)sp[3 * 132] << 16); o.z = (unsigned)sp[4 * 132] | ((unsigned)sp[5 * 132] << 16); o.w = (unsigned)sp[6 * 132] | ((unsigned)sp[7 * 132] << 16);
            *(GAS u32x4*)(M.dst + (size_t)(n0 + n) * M.K + k0 + 8 * c) = o; }
    LDS_WAIT(); asm volatile("" ::: "memory");
}
struct ConvSel { int mode, lo, hi; };
DI void conv_run(Frame& F, const ConvMat M, int& gbase, const ConvSel sel) {
    LAS float* scr = (LAS float*)(F.lds + F.wave * 16384);
    const int gw = F.vcu * 8 + F.wave, NGW = F.G * 8;
    {
        const int nitems = (M.N / 128) * (M.K / 32);
        int it, step;
        if (sel.mode == 0) { it = (gw - gbase % NGW) % NGW; if (it < 0) it += NGW; step = NGW; }
        else { int f = sel.lo - gbase; if (f < 0) f = 0; const int ph = (gbase + f - sel.lo) & 7; it = f + ((F.wave - ph) & 7); step = 8; }
        const int end = sel.mode == 0 ? nitems : ((sel.hi - gbase) < nitems ? (sel.hi - gbase) : nitems);
        for (; it < end; it += step) conv_item_fast(M, it, (LAS bf16_t*)scr, F.lane);
        gbase += nitems;
    }
    if (M.kind == 1 || M.kind == 2) {
        const int nkb = M.K / 64;
        const int nrow32 = M.kind == 2 ? M.N / 32 : 28;
        const int nitems = nrow32 * nkb;
        int it, step;
        if (sel.mode == 0) { it = (gw - gbase % NGW) % NGW; if (it < 0) it += NGW; step = NGW; }
        else { int f = sel.lo - gbase; if (f < 0) f = 0; const int ph = (gbase + f - sel.lo) & 7; it = f + ((F.wave - ph) & 7); step = 8; }
        const int end = sel.mode == 0 ? nitems : ((sel.hi - gbase) < nitems ? (sel.hi - gbase) : nitems);
        for (; it < end; it += step) { int rb = it / nkb; const int kb = it % nkb;
            if (M.kind == 1) rb = rb < 12 ? 32 + rb : 60 + (rb - 12);
            conv_item(M, rb * nkb + kb, scr, F.lane); }
        gbase += nitems;
    }
}
DI int convert_layer_weights(Frame& F, int l, const ConvSel sel) {
    unsigned char* wl = F.ws + ((l & 1) ? WS_WL : WS_WLB);
    int start = 0;
    conv_run(F, mkmat(inp(I_WIN) + (size_t)l * 1024 * IN_W, nullptr, IN_W, 1024, (bf16_t*)(wl + WL_WIN), NP_GEMM, 1024, 1, NP_GEMM), start, sel);
    for (int i = 0; i < 4; ++i) conv_run(F, mkmat(inp(I_WBR) + (size_t)(l * 4 + i) * 256 * 1024, nullptr, 1024, 256, (bf16_t*)(wl + WL_WBR) + (size_t)i * 1024 * 256, 1024, 256, 0, 1024), start, sel);
    conv_run(F, mkmat(inp(I_WOUT) + (size_t)l * 1024 * 1024, nullptr, 1024, 1024, (bf16_t*)(wl + WL_WOUT), 1024, 1024, 0, 1024), start, sel);
    for (int d = 0; d < 2; ++d) conv_run(F, mkmat(inp(I_W1) + (size_t)(l * 2 + d) * 256 * 64, nullptr, 64, 256, (bf16_t*)(wl + WL_L1) + (size_t)d * 256 * 256, 256, 256, 0, 64), start, sel);
    for (int d = 0; d < 2; ++d) conv_run(F, mkmat(inp(I_A1) + (size_t)(l * 2 + d) * 256 * 64, nullptr, 64, 256, (bf16_t*)(wl + WL_L1) + (size_t)(2 + d) * 256 * 256, 256, 256, 0, 64), start, sel);
    conv_run(F, mkmat(inp(I_V1) + (size_t)(l > 0 ? l - 1 : 0) * 256 * 32, nullptr, 32, 256, (bf16_t*)(wl + WL_L1) + (size_t)4 * 256 * 256, 256, 256, 0, l > 0 ? 32 : 0), start, sel);
    conv_run(F, mkmat(inp(I_G1) + (size_t)l * 256 * 128, nullptr, 128, 256, (bf16_t*)(wl + WL_L1) + (size_t)5 * 256 * 256, 256, 256, 0, 128), start, sel);
    for (int d = 0; d < 2; ++d) conv_run(F, mkmat(inp(I_W2) + (size_t)(l * 2 + d) * 64 * 256, nullptr, 256, 64, (bf16_t*)(wl + WL_L2) + (size_t)d * 256 * 256, 256, 256, 0, 256), start, sel);
    for (int d = 0; d < 2; ++d) conv_run(F, mkmat(inp(I_A2) + (size_t)(l * 2 + d) * 64 * 256, nullptr, 256, 64, (bf16_t*)(wl + WL_L2) + (size_t)(2 + d) * 256 * 256, 256, 256, 0, 256), start, sel);
    conv_run(F, mkmat(inp(I_V2) + (size_t)(l > 0 ? l - 1 : 0) * 32 * 256, nullptr, 256, l > 0 ? 32 : 0, (bf16_t*)(wl + WL_L2) + (size_t)4 * 256 * 256, 256, 256, 0, 256), start, sel);
    conv_run(F, mkmat(inp(I_G2) + (size_t)l * 128 * 256, nullptr, 256, 128, (bf16_t*)(wl + WL_L2) + (size_t)5 * 256 * 256, 256, 256, 0, 256), start, sel);
    conv_run(F, mkmat(inp(I_WUQ) + (size_t)l * 256 * 384, nullptr, 384, 256, (bf16_t*)(wl + WL_UQ), 512, 256, 2, 384), start, sel);
    conv_run(F, mkmat(inp(I_WUKV) + (size_t)l * 128 * 512, nullptr, 512, 128, (bf16_t*)(wl + WL_UKV), 512, 256, 0, 512), start, sel);
    if ((l & 1) == 0) {
        conv_run(F, mkmat(inp(I_FW1) + (size_t)(l >> 1) * 1024 * DFF, inp(I_FW3) + (size_t)(l >> 1) * 1024 * DFF, DFF, 1024, (bf16_t*)(wl + WL_W13), 7168, 1024, 3, 7168), start, sel);
        conv_run(F, mkmat(inp(I_FW2) + (size_t)(l >> 1) * DFF * 1024, nullptr, 1024, DFF, (bf16_t*)(wl + WL_W2D), 1024, DFF, 0, 1024), start, sel);
    } else {
        for (int e = 0; e < NEXP; ++e) { const size_t eo = (size_t)((l >> 1) * NEXP + e) * 1024 * DFF;
            conv_run(F, mkmat(inp(I_MW1) + eo, inp(I_MW3) + eo, DFF, 1024, (bf16_t*)(wl + WL_W13) + (size_t)e * 7168 * 1024, 7168, 1024, 3, 7168), start, sel); }
        for (int e = 0; e < NEXP; ++e)
            conv_run(F, mkmat(inp(I_MW2) + (size_t)((l >> 1) * NEXP + e) * DFF * 1024, nullptr, 1024, DFF, (bf16_t*)(wl + WL_W2) + (size_t)e * 1024 * DFF, 1024, DFF, 0, 1024), start, sel);
    }
    return start;
}

DI void p0_prologue(Frame& F) {
    convert_layer_weights(F, 0, ConvSel{0, 0, 0});
    const int gw = F.vcu * 8 + F.wave, NGW = F.G * 8;
    for (int r = gw; r < NROW; r += NGW) {
        const int b = r / TPB, pos = r % TPB;
        const float* src = pos < CTXL ? inp(I_CTX) + ((size_t)b * CTXL + pos) * 1024 : inp(I_X) + ((size_t)b * SEQ + (pos - CTXL)) * 1024;
        const GAS f32x4* s4 = (const GAS f32x4*)src + F.lane; GAS f32x4* d4 = (GAS f32x4*)(FX(F) + (size_t)r * 1024) + F.lane;
#pragma unroll
        for (int j = 0; j < 4; ++j) d4[64 * j] = s4[64 * j];
    }
    {
        float* r64 = (float*)(F.ws + WS_ROPE64); float* r32 = (float*)(F.ws + WS_ROPE32);
        const int gt = (F.vcu * 512 + F.tid), NT = F.G * 512;
        for (int i = gt; i < SEQ * 48; i += NT) {
            const int t = i / 48, q = i % 48; const float row = (float)(t / GRIDW), col = (float)(t % GRIDW);
            float ang;
            if (q < 32) { const int f = q & 15; ang = (q < 16 ? row : col) * powf(10000.0f, -(float)f / 16.0f); }
            else { const int p = q - 32, f = p & 7; ang = (p < 8 ? row : col) * powf(10000.0f, -(float)f / 8.0f); }
            float sn, cs; sincosf(ang, &sn, &cs);
            if (q < 32) { r64[((size_t)t * 32 + q) * 2] = cs; r64[((size_t)t * 32 + q) * 2 + 1] = sn; }
            else { r32[((size_t)t * 16 + (q - 32)) * 2] = cs; r32[((size_t)t * 16 + (q - 32)) * 2 + 1] = sn; }
        }
    }
    __syncthreads();
    {
        LAS float* sl = (LAS float*)F.lds;
        LAS float* red = sl + 3072;
        for (int i = F.tid; i < 3072; i += 512) { const int v = i >> 10, k = i & 1023; const float cvv = v < 2 ? *(const GAS float*)(inp(I_C) + v * 1024 + k) : *(const GAS float*)(inp(I_CCTX) + k); sl[i] = siluf_(cvv); }
        __syncthreads();
        const int q = F.lane, ks = F.wave;
        for (int ch = F.vcu; ch < 4 * 24; ch += F.G) {
            const int l = ch / 24, jb = (ch % 24) * 256 + 4 * q;
            const float* wp = inp(I_WMOD) + (size_t)l * 1024 * 6144 + jb;
            f32x4 a0 = (f32x4){0.f, 0.f, 0.f, 0.f}, a1 = a0, a2 = a0;
#pragma unroll 8
            for (int k = ks * 128; k < ks * 128 + 128; ++k) { const f32x4 w = *(const GAS f32x4*)(wp + (size_t)k * 6144); a0 = a0 + w * sl[k]; a1 = a1 + w * sl[1024 + k]; a2 = a2 + w * sl[2048 + k]; }
            *(LAS f32x4*)(red + (ks * 3 + 0) * 256 + 4 * q) = a0; *(LAS f32x4*)(red + (ks * 3 + 1) * 256 + 4 * q) = a1; *(LAS f32x4*)(red + (ks * 3 + 2) * 256 + 4 * q) = a2;
            __syncthreads();
            if (F.tid < 192) { const int v = F.tid >> 6; f32x4 s4 = *(const GAS f32x4*)(inp(I_BMOD) + l * 6144 + jb);
#pragma unroll
                for (int w8 = 0; w8 < 8; ++w8) s4 = s4 + *(const LAS f32x4*)(red + (w8 * 3 + v) * 256 + 4 * q);
                *(GAS f32x4*)(FMOD(F) + (size_t)(l * 3 + v) * 6144 + jb) = s4; }
            __syncthreads();
        }
    }
}

template <int MODE>
DI void norm_phase(Frame& F, int l, float probe_scale = 1.0f) {
    const int rpw = (NROW + F.G - 1) / F.G;
    const int bid = F.bx;
    const int r0 = bid * rpw, r1 = (r0 + rpw) < NROW ? (r0 + rpw) : NROW;
    const bool combine = (MODE == 0 && l > 0 && ((l - 1) & 1)) || MODE == 2;
    const int lprev = MODE == 2 ? DEPTH - 1 : l - 1;
    const bool moe = (MODE == 1) && (l & 1);
    const bool skipctx = MODE == 2 || (MODE == 1 && l == DEPTH - 1);
    const float* nw = MODE == 0 ? inp(I_NORM1) + l * 1024 : MODE == 1 ? inp(I_NORM2) + l * 1024 : inp(I_FNORM);
    const bf16_t* Yg = (const bf16_t*)(F.ws + WS_YG);
    const int* dstp = (const int*)(F.ws + WS_ASG_DST);
    volatile LAS int* hist = (volatile LAS int*)(F.lds + MISC_OFF + 64);
    if (moe) { if (F.tid < 8) hist[F.tid] = 0; __syncthreads(); }
    f32x4 nx[2][4]; u32x2 ny0[2][4], ny1[2][4];
#define NORM_LOAD(set, rr) do { const GAS f32x4* xp_ = (const GAS f32x4*)(FX(F) + (size_t)(rr) * 1024) + F.lane; \
        _Pragma("unroll") for (int j = 0; j < 4; ++j) nx[set][j] = xp_[64 * j]; \
        if (combine && !(skipctx && ((rr) % TPB) < CTXL)) { const int d0_ = *(const GAS int*)(dstp + (rr) * 2), d1_ = *(const GAS int*)(dstp + (rr) * 2 + 1); \
            _Pragma("unroll") for (int j = 0; j < 4; ++j) { const int c_ = 4 * F.lane + 256 * j; ny0[set][j] = *(const GAS u32x2*)(Yg + (size_t)d0_ * 1024 + c_); ny1[set][j] = *(const GAS u32x2*)(Yg + (size_t)d1_ * 1024 + c_); } } } while (0)
    f32x4 nwv[4];
#pragma unroll
    for (int j = 0; j < 4; ++j) nwv[j] = *(const GAS f32x4*)(nw + 4 * F.lane + 256 * j);
    int cur_vec = -1; f32x4 scv[4], shv[4];
    float one_ = 1.f, zero_ = 0.f; asm volatile("" : "+v"(one_), "+v"(zero_));
#pragma unroll
    for (int j = 0; j < 4; ++j) { scv[j] = (f32x4){one_, one_, one_, one_}; shv[j] = (f32x4){zero_, zero_, zero_, zero_}; }
    if (r0 + F.wave < r1) NORM_LOAD(0, r0 + F.wave);
    if (r0 + F.wave + 8 < r1) NORM_LOAD(1, r0 + F.wave + 8);
    for (int rr = r0 + F.wave; rr < r1; rr += 16)
#pragma unroll
    for (int half = 0; half < 2; ++half) {
        const int r = rr + 8 * half; if (r >= r1) break;
        const int vec = row_vec(r);
        float* xr = FX(F) + (size_t)r * 1024;
        f32x4 x[4]; u32x2 y0[4], y1[4];
#pragma unroll
        for (int j = 0; j < 4; ++j) { x[j] = nx[half][j]; y0[j] = ny0[half][j]; y1[j] = ny1[half][j]; }
        if (r + 16 < r1) NORM_LOAD(half, r + 16);
        if (skipctx && (r % TPB) < CTXL) continue;
        if (combine) {
            const float* g2 = modp(F, lprev, vec, 5);
#pragma unroll
            for (int j = 0; j < 4; ++j) { const int c = 4 * F.lane + 256 * j; const f32x4 g = *(const GAS f32x4*)(g2 + c);
                x[j][0] += g[0] * (bflo(y0[j].x) + bflo(y1[j].x)); x[j][1] += g[1] * (bfhi(y0[j].x) + bfhi(y1[j].x)); x[j][2] += g[2] * (bflo(y0[j].y) + bflo(y1[j].y)); x[j][3] += g[3] * (bfhi(y0[j].y) + bfhi(y1[j].y));
                if (MODE == 0) *((GAS f32x4*)xr + F.lane + 64 * j) = x[j]; }
        }
        {
            const int nsl = 0;
            const int pos = r % TPB;
            if (nsl > 0 && pos < CTXL) {
                const int crow = (r / TPB) * 256 + pos;
                const float* gsl = (MODE == 1) ? modp(F, l, 2, 2) : modp(F, l - 1, 2, 5);
                const float* sl = (const float*)(F.ws + WS_SLAB) + (size_t)crow * 1024;
#pragma unroll
                for (int j = 0; j < 4; ++j) { const int c = 4 * F.lane + 256 * j; f32x4 a = *(const GAS f32x4*)(sl + c);
                    for (int q = 1; q < nsl; ++q) a = a + *(const GAS f32x4*)(sl + (size_t)q * 512 * 1024 + c);
                    x[j] = x[j] + *(const GAS f32x4*)(gsl + c) * a; *((GAS f32x4*)xr + F.lane + 64 * j) = x[j]; }
            }
        }
        float ss = 0.f;
#pragma unroll
        for (int j = 0; j < 4; ++j) ss += (x[j][0] * x[j][0] + x[j][1] * x[j][1]) + (x[j][2] * x[j][2] + x[j][3] * x[j][3]);
        const float rstd = 1.0f / sqrtf(wave_sum(ss) * (1.0f / 1024.0f) + 1e-6f);
        if (MODE == 2) {
            const int pos = r % TPB;
            if (pos >= CTXL) { float* op = F.out + ((size_t)(r / TPB) * SEQ + (pos - CTXL)) * 1024;
#pragma unroll
                for (int j = 0; j < 4; ++j) *((GAS f32x4*)op + F.lane + 64 * j) = x[j] * rstd * nwv[j] * probe_scale; }
            continue;
        }
        if (vec != cur_vec) {
            cur_vec = vec; const float* sc = modp(F, l, vec, MODE == 0 ? 1 : 4); const float* sh = modp(F, l, vec, MODE == 0 ? 0 : 3);
#pragma unroll
            for (int j = 0; j < 4; ++j) { const int c = 4 * F.lane + 256 * j; scv[j] = 1.0f + *(const GAS f32x4*)(sc + c); shv[j] = *(const GAS f32x4*)(sh + c); }
        }
        f32x4 h[4];
#pragma unroll
        for (int j = 0; j < 4; ++j) { const int c = 4 * F.lane + 256 * j;
            h[j] = (x[j] * rstd * nwv[j]) * scv[j] + shv[j];
            u32x2 o; o.x = pk2(h[j][0], h[j][1]); o.y = pk2(h[j][2], h[j][3]); *(GAS u32x2*)(FHB(F) + (size_t)r * 1024 + c) = o; }
        if (moe) {
            const float* wr = inp(I_ROUTER) + (size_t)(l >> 1) * 1024 * NEXP;
            float lg[8];
#pragma unroll
            for (int e = 0; e < 8; ++e) lg[e] = 0.f;
#pragma unroll
            for (int j = 0; j < 4; ++j)
#pragma unroll
                for (int q = 0; q < 4; ++q) { const int c = 4 * F.lane + 256 * j + q; const f32x4 w0 = *(const GAS f32x4*)(wr + (size_t)c * 8), w1 = *(const GAS f32x4*)(wr + (size_t)c * 8 + 4); const float hv = h[j][q];
                    lg[0] += hv * w0[0]; lg[1] += hv * w0[1]; lg[2] += hv * w0[2]; lg[3] += hv * w0[3]; lg[4] += hv * w1[0]; lg[5] += hv * w1[1]; lg[6] += hv * w1[2]; lg[7] += hv * w1[3]; }
#pragma unroll
            for (int e = 0; e < 8; ++e) lg[e] = wave_sum(lg[e]);
            int e1 = 0; float l1 = lg[0];
#pragma unroll
            for (int e = 1; e < 8; ++e) if (lg[e] > l1) { l1 = lg[e]; e1 = e; }
            int e2 = -1; float l2 = -3.0e38f;
#pragma unroll
            for (int e = 0; e < 8; ++e) if (e != e1 && lg[e] > l2) { l2 = lg[e]; e2 = e; }
            if (e2 < 0) e2 = (e1 + 1) & 7;
            if (F.lane == 0) {
                const float ex = __expf(l2 - l1); const float g1v = 1.0f / (1.0f + ex), g2v = ex / (1.0f + ex);
                const int lp1 = __hip_atomic_fetch_add((LAS int*)&hist[e1], 1, __ATOMIC_RELAXED, __HIP_MEMORY_SCOPE_WORKGROUP);
                const int lp2 = __hip_atomic_fetch_add((LAS int*)&hist[e2], 1, __ATOMIC_RELAXED, __HIP_MEMORY_SCOPE_WORKGROUP);
                int* asg = (int*)(F.ws + WS_ASG) + (size_t)r * 4; asg[0] = e1 | (e2 << 8); asg[1] = lp1; asg[2] = lp2;
                float* ag = (float*)(F.ws + WS_ASG_GATE) + (size_t)r * 2; ag[0] = g1v; ag[1] = g2v;
            }
        }
    }
#undef NORM_LOAD
    if (moe) {
        __syncthreads();
        if (F.tid < 8) { const int cnt = hist[F.tid]; const int bank = l >> 1;
            const unsigned base = cnt > 0 ? __hip_atomic_fetch_add(F.ctl + CW_MOECNT + bank * 64 + F.tid, (unsigned)cnt, __ATOMIC_RELAXED, __HIP_MEMORY_SCOPE_AGENT) : 0u;
            F.ctl[CW_WGBASE + (bank * 256 + bid) * 8 + F.tid] = base; }
    }
}
DI void moe_panels(const Frame& F, int l, int (&cp)[9]) {
    int acc = 0;
#pragma unroll
    for (int e = 0; e < 8; ++e) { cp[e] = acc; const unsigned c = __hip_atomic_load(F.ctl + CW_MOECNT + (l >> 1) * 64 + e, __ATOMIC_RELAXED, __HIP_MEMORY_SCOPE_AGENT); acc += (int)((c + 255u) >> 8); }
    cp[8] = acc;
#pragma unroll
    for (int e = 0; e < 9; ++e) cp[e] = __builtin_amdgcn_readfirstlane(cp[e]);
}
DI void moe_gather(Frame& F, int l) {
    int cp[9]; moe_panels(F, l, cp);
    const int rpw = (NROW + F.G - 1) / F.G; const int bid = F.bx;
    const int r0 = bid * rpw, r1 = (r0 + rpw) < NROW ? (r0 + rpw) : NROW;
    bf16_t* Xg = (bf16_t*)(F.ws + WS_XG); float* rowgate = (float*)(F.ws + WS_ROWGATE); int* dstp = (int*)(F.ws + WS_ASG_DST);
    const unsigned* wgb = F.ctl + CW_WGBASE + ((l >> 1) * 256 + bid) * 8;
    for (int r = r0 + F.wave; r < r1; r += 8) {
        if (l == DEPTH - 1 && (r % TPB) < CTXL) continue;
        const int* asg = (const int*)(F.ws + WS_ASG) + (size_t)r * 4; const float* ag = (const float*)(F.ws + WS_ASG_GATE) + (size_t)r * 2;
        const int ee = asg[0], e1 = ee & 255, e2 = ee >> 8;
        int cpa = 0, cpb = 0;
#pragma unroll
        for (int e = 0; e < 8; ++e) { cpa = (e == e1) ? cp[e] : cpa; cpb = (e == e2) ? cp[e] : cpb; }
        const int d0 = cpa * 256 + (int)wgb[e1] + asg[1], d1 = cpb * 256 + (int)wgb[e2] + asg[2];
        const GAS u32x4* src = (const GAS u32x4*)(FHB(F) + (size_t)r * 1024) + F.lane;
        const u32x4 v0 = src[0], v1 = src[64];
        GAS u32x4* p0 = (GAS u32x4*)(Xg + (size_t)d0 * 1024) + F.lane; GAS u32x4* p1 = (GAS u32x4*)(Xg + (size_t)d1 * 1024) + F.lane;
        p0[0] = v0; p0[64] = v1; p1[0] = v0; p1[64] = v1;
        if (F.lane == 0) { rowgate[d0] = ag[0]; rowgate[d1] = ag[1]; dstp[r * 2] = d0; dstp[r * 2 + 1] = d1; }
    }
}

DI f32x4 ld4bf(const bf16_t* p) { const u32x2 w = *(const u32x2*)p; return (f32x4){bflo(w.x), bfhi(w.x), bflo(w.y), bfhi(w.y)}; }
DI void st4bf(bf16_t* p, const f32x4 v) { u32x2 o; o.x = pk2(v[0], v[1]); o.y = pk2(v[2], v[3]); *(u32x2*)p = o; }
DI f32x4 rope2(const f32x4 v, const float* cs) {
    const f32x4 t = *(const GAS f32x4*)cs;
    return (f32x4){v[0] * t[0] - v[1] * t[1], v[0] * t[1] + v[1] * t[0], v[2] * t[2] - v[3] * t[3], v[2] * t[3] + v[3] * t[2]};
}
DI u32x2 ld8(const bf16_t* p) { return *(const GAS u32x2*)p; }
DI f32x4 bf4(const u32x2 w) { return (f32x4){bflo(w.x), bfhi(w.x), bflo(w.y), bfhi(w.y)}; }
DI f32x4 rope2v(const f32x4 v, const f32x4 t) { return (f32x4){v[0] * t[0] - v[1] * t[1], v[0] * t[1] + v[1] * t[0], v[2] * t[2] - v[3] * t[3], v[2] * t[3] + v[3] * t[2]}; }
DI void prep_phase(Frame& F, int l) {
    const int gw = F.vcu * 8 + F.wave, NGW = F.G * 8, lane = F.lane;
    bf16_t* RR = (bf16_t*)(F.ws + WS_RR); bf16_t* KK = (bf16_t*)(F.ws + WS_KK); bf16_t* KR = (bf16_t*)(F.ws + WS_KR); bf16_t* V = (bf16_t*)(F.ws + WS_V); bf16_t* VF = (bf16_t*)(F.ws + WS_VF);
    bf16_t* Km = (bf16_t*)(F.ws + WS_KMLA);
    const float* r64 = (const float*)(F.ws + WS_ROPE64); const float* r32 = (const float*)(F.ws + WS_ROPE32);
    const float* mu = inp(I_MU) + (size_t)l * 2048;
    const int c4 = 4 * lane;
    f32x4 m0[4], m1[4];
#pragma unroll
    for (int s = 0; s < 4; ++s) { m0[s] = *(const GAS f32x4*)(mu + s * 256 + c4); m1[s] = *(const GAS f32x4*)(mu + 1024 + s * 256 + c4); }
    const f32x4 kkv = *(const GAS f32x4*)(inp(I_KK) + l * 256 + c4), mqn = *(const GAS f32x4*)(inp(I_MQN) + l * 256 + c4);
    const f32x4 mkvn = lane < 32 ? *(const GAS f32x4*)(inp(I_MKVN) + l * 128 + c4) : (f32x4){0.f, 0.f, 0.f, 0.f};
    const int i0 = c4 & 63, pi = i0 >> 1;
    f32x4 gq, gk;
    { const float* gqp = inp(I_GQN) + l * 64; const float* gkp = inp(I_GKN) + l * 64;
#pragma unroll
      for (int j = 0; j < 4; ++j) { gq[j] = *(const GAS float*)(gqp + perm64(i0 + j)); gk[j] = *(const GAS float*)(gkp + perm64(i0 + j)); } }
    struct PrepRaw { u32x2 rf[4], rp[4], rn[4], rswq, rcq, rgaq, rswk, rckv, rgak, rkr; f32x4 cs64, cs32; };
    const u32x2 zz = (u32x2){0u, 0u};
#define PREP_LOAD(R, rr) do { const int pos_ = (rr) % TPB; const bool isctx_ = pos_ < CTXL; const int t_ = isctx_ ? 0 : pos_ - CTXL; \
        const bool hasp_ = isctx_ ? (pos_ > 0) : (pos_ > CTXL), hasn_ = isctx_ ? (pos_ < CTXL - 1) : (pos_ < TPB - 1); \
        const bf16_t* pr_ = FP(F) + (size_t)(rr) * LDP; \
        _Pragma("unroll") for (int s = 0; s < 4; ++s) { R.rf[s] = ld8(pr_ + s * 256 + c4); R.rp[s] = hasp_ ? ld8(pr_ - LDP + s * 256 + c4) : zz; R.rn[s] = hasn_ ? ld8(pr_ + LDP + s * 256 + c4) : zz; } \
        R.rswq = ld8(pr_ + PC_SWQ + c4); R.rcq = ld8(pr_ + PC_CQ + c4); R.rgaq = ld8(pr_ + PC_GAQ + c4); \
        R.rswk = lane < 32 ? ld8(pr_ + PC_SWK + c4) : zz; R.rckv = lane < 32 ? ld8(pr_ + PC_CKV + c4) : zz; R.rgak = lane < 32 ? ld8(pr_ + PC_GAK + c4) : zz; \
        R.rkr = lane < 8 ? ld8(pr_ + PC_KR + c4) : zz; \
        R.cs64 = *(const GAS f32x4*)(r64 + ((size_t)t_ * 32 + pi) * 2); R.cs32 = *(const GAS f32x4*)(r32 + ((size_t)t_ * 16 + 2 * (lane & 7)) * 2); } while (0)
    PrepRaw RA, RB;
    if (gw < NROW) PREP_LOAD(RA, gw);
    for (int r = gw; r < NROW; r += NGW) {
        if (r + NGW < NROW) PREP_LOAD(RB, r + NGW);
        const int pos = r % TPB; const bool isctx = pos < CTXL;
        bf16_t* pr = FP(F) + (size_t)r * LDP;
        u32x2 rf[4], rp[4], rn[4];
#pragma unroll
        for (int s = 0; s < 4; ++s) { rf[s] = RA.rf[s]; rp[s] = RA.rp[s]; rn[s] = RA.rn[s]; }
        const u32x2 rswq = RA.rswq, rcq = RA.rcq, rgaq = RA.rgaq, rswk = RA.rswk, rckv = RA.rckv, rgak = RA.rgak, rkr = RA.rkr;
        const f32x4 cs64 = RA.cs64, cs32 = RA.cs32;
        RA = RB;
        f32x4 o[4];
#pragma unroll
        for (int s = 0; s < 4; ++s) { const f32x4 f = bf4(rf[s]), fp = bf4(rp[s]), fn = bf4(rn[s]); o[s] = f + m0[s] * (fp - f) + m1[s] * (fn - f); }
        st4bf(RR + (size_t)r * 256 + c4, o[0]);
        st4bf(KR + (size_t)r * 256 + c4, o[1]);
        { const f32x4 kx = o[1] * kkv; const float ss = sum16((kx[0] * kx[0] + kx[1] * kx[1]) + (kx[2] * kx[2] + kx[3] * kx[3])); st4bf(KK + (size_t)r * 256 + c4, kx * (1.0f / sqrtf(ss + 1e-12f))); }
        st4bf(V + (size_t)r * 256 + c4, o[2]); if (l == 0) st4bf(VF + (size_t)r * 256 + c4, o[2]);
        st4bf(pr + PC_Z + c4, o[3]);
        { f32x4 q = bf4(rswq); if (!isctx) q = rope2v(q, cs64); st4bf(pr + PC_SWQ + c4, q * QS64);
          if (lane < 32 && !isctx) st4bf(pr + PC_SWK + c4, rope2v(bf4(rswk), cs64)); }
        { f32x4 q = bf4(rcq); const float ss = wave_sum((q[0] * q[0] + q[1] * q[1]) + (q[2] * q[2] + q[3] * q[3]));
          st4bf(pr + PC_CQ + c4, q * (1.0f / sqrtf(ss * (1.0f / 256.0f) + 1e-6f)) * mqn);
          f32x4 kv = bf4(rckv); const float s2 = wave_sum((kv[0] * kv[0] + kv[1] * kv[1]) + (kv[2] * kv[2] + kv[3] * kv[3]));
          if (lane < 32) st4bf(pr + PC_CKV + c4, kv * (1.0f / sqrtf(s2 * (1.0f / 128.0f) + 1e-6f)) * mkvn);
          if (lane < 8) { f32x4 kr = bf4(rkr); if (!isctx) kr = rope2v(kr, cs32);
#pragma unroll
              for (int h = 0; h < 4; ++h) st4bf(Km + (size_t)r * 384 + h * 96 + 64 + c4, kr); } }
        { f32x4 q = bf4(rgaq); const float ss = sum16((q[0] * q[0] + q[1] * q[1]) + (q[2] * q[2] + q[3] * q[3]));
          q = q * (1.0f / sqrtf(ss * (1.0f / 64.0f) + 1e-6f)) * gq; if (!isctx) q = rope2v(q, cs64); st4bf(pr + PC_GAQ + c4, q * QS64);
          f32x4 k = bf4(rgak); const float s2 = sum16((k[0] * k[0] + k[1] * k[1]) + (k[2] * k[2] + k[3] * k[3]));
          if (lane < 32) { k = k * (1.0f / sqrtf(s2 * (1.0f / 64.0f) + 1e-6f)) * gk; if (!isctx) k = rope2v(k, cs64); st4bf(pr + PC_GAK + c4, k); } }
    }
}

#undef PREP_LOAD
template <int PARTS>
DI void finish_rows(Frame& F, int l, int r0, int r1, int stride8) {
    const int gw = stride8 ? r0 + F.wave : F.vcu * 8 + F.wave, NGW = stride8 ? 8 : F.G * 8, lane = F.lane, c4 = 4 * lane, hd = lane >> 4;
    const bf16_t* RR = (const bf16_t*)(F.ws + WS_RR); const bf16_t* KD = (const bf16_t*)(F.ws + WS_KD); const bf16_t* V = (const bf16_t*)(F.ws + WS_V); const bf16_t* Gg = (const bf16_t*)(F.ws + WS_G);
    const float* Y0 = (const float*)(F.ws + WS_YDIR); const float* Y1 = Y0 + (size_t)NROW * 256;
    const float* OP = (const float*)(F.ws + WS_OPART); const float* ML = (const float*)(F.ws + WS_ML);
    bf16_t* YA = (bf16_t*)(F.ws + WS_YALL);
    const f32x4 rk = *(const GAS f32x4*)(inp(I_RK) + l * 256 + c4), lw = *(const GAS f32x4*)(inp(I_LNW) + l * 256 + c4), lb = *(const GAS f32x4*)(inp(I_LNB) + l * 256 + c4);
    for (int r = gw; r < r1; r += NGW) {
        if (PARTS & 1) {
            const f32x4 y = *(const GAS f32x4*)(Y0 + (size_t)r * 256 + c4) + *(const GAS f32x4*)(Y1 + (size_t)r * 256 + c4);
            const float mean = sum16((y[0] + y[1]) + (y[2] + y[3])) * (1.0f / 64.0f);
            const f32x4 d = y - mean;
            const float var = sum16((d[0] * d[0] + d[1] * d[1]) + (d[2] * d[2] + d[3] * d[3])) * (1.0f / 64.0f);
            const f32x4 yn = d * (1.0f / sqrtf(var + 64e-5f)) * lw + lb;
            const f32x4 rr = ld4bf(RR + (size_t)r * 256 + c4), k0 = ld4bf(KD + (size_t)r * 512 + c4), k1 = ld4bf(KD + (size_t)r * 512 + 256 + c4), v = ld4bf(V + (size_t)r * 256 + c4), g = ld4bf(Gg + (size_t)r * 256 + c4);
            const f32x4 pr = rr * (k0 + k1) * rk;
            const float bon = sum16((pr[0] + pr[1]) + (pr[2] + pr[3]));
            st4bf(YA + (size_t)r * 1024 + c4, (yn + bon * v) * g);
        }
        if (PARTS & 2)
#pragma unroll
        for (int kind = 0; kind < 2; ++kind) {
            const float* m0p = ML + (((size_t)(kind * NSPLIT + 0) * NROW + r) * 4 + hd) * 2; const float* m1p = ML + (((size_t)(kind * NSPLIT + 1) * NROW + r) * 4 + hd) * 2;
            const float m0 = m0p[0], l0 = m0p[1], m1 = m1p[0], l1 = m1p[1];
            const float mm = m0 > m1 ? m0 : m1; const float w0 = fast_exp2(m0 - mm), w1 = fast_exp2(m1 - mm);
            const f32x4 o0 = *(const GAS f32x4*)(OP + ((size_t)(kind * NSPLIT + 0) * NROW + r) * 256 + c4), o1 = *(const GAS f32x4*)(OP + ((size_t)(kind * NSPLIT + 1) * NROW + r) * 256 + c4);
            const float inv = 1.0f / (w0 * l0 + w1 * l1);
            st4bf(YA + (size_t)r * 1024 + 512 + kind * 256 + c4, (o0 * w0 + o1 * w1) * inv);
        }
    }
}
#ifdef MIX_MERGE
DI void finish_phase(Frame& F, int l) { finish_rows<1>(F, l, 0, NROW, 0); }
#else
DI void finish_phase(Frame& F, int l) { finish_rows<3>(F, l, 0, NROW, 0); }
#endif
typedef short v4i16_t __attribute__((ext_vector_type(4)));
DI s16x4 vtr(const LAS unsigned char* p) { return __builtin_bit_cast(s16x4, __builtin_amdgcn_ds_read_tr16_b64_v4i16((LAS v4i16_t*)p)); }
DI int crow(int r, int hi) { return (r & 3) + 8 * (r >> 2) + 4 * hi; }

struct AttnArgs {
    const bf16_t* Q; int qpitch;
    const bf16_t* K; int kpitch;
    const bf16_t* V; int vpitch;
    int ka0, ka1, kb0, kb1;
    int window;
    int qlat0;
    int use_sink; float sink_l2;
    int out_mode;
    bf16_t* obf; float* opf; float* mlp;
    int empty_part; float* opf2; float* mlp2;
};

template <int DQK>
DI void attn_unit(Frame& F, const AttnArgs& A) {
    constexpr int NCH = DQK / 8, KB = NCH * 1024, BUF = KB + 8192, ND = DQK / 16;
    const int tid = F.tid, lane = F.lane, wid = F.wave, r32 = lane & 31, hi = lane >> 5;
    LAS unsigned char* lds = F.lds;
    bf16x8 qr[ND];
    { const bf16_t* qp = A.Q + (size_t)(wid * 32 + r32) * A.qpitch + 8 * hi;
#pragma unroll
      for (int d0 = 0; d0 < ND; ++d0) qr[d0] = *(const GAS bf16x8*)(qp + 16 * d0); }
    const int na = (A.ka1 - A.ka0) >> 6, nb = (A.kb1 - A.kb0) >> 6, nt = na + nb;
    const bf16_t* ksrc = A.K + (size_t)lane * A.kpitch + wid * 8;
    const bf16_t* ksrc2 = A.K + (size_t)lane * A.kpitch + (8 + wid) * 8;
    const bf16_t* vsrc = A.V + (size_t)(16 * (wid & 3) + (lane >> 2)) * A.vpitch + (wid >> 2) * 32 + (lane & 3) * 8;
#define ATT_DMA(t) do { const int kr_ = (t) < na ? A.ka0 + 64 * (t) : A.kb0 + 64 * ((t) - na); LAS unsigned char* bb_ = lds + ((t) & 1) * BUF; \
        __builtin_amdgcn_global_load_lds((const unsigned*)(ksrc + (size_t)kr_ * A.kpitch), (LAS unsigned*)(bb_ + wid * 1024), 16, 0, 0); \
        if (DQK == 96 && wid < 4) __builtin_amdgcn_global_load_lds((const unsigned*)(ksrc2 + (size_t)kr_ * A.kpitch), (LAS unsigned*)(bb_ + (8 + wid) * 1024), 16, 0, 0); \
        __builtin_amdgcn_global_load_lds((const unsigned*)(vsrc + (size_t)kr_ * A.vpitch), (LAS unsigned*)(bb_ + KB + wid * 1024), 16, 0, 0); } while (0)
    constexpr float THR = 8.0f;
    float m_ref = 0.f, l_run = 0.f;
    f32x16 o0, o1, negm;
#pragma unroll
    for (int i = 0; i < 16; ++i) { o0[i] = 0.f; o1[i] = 0.f; negm[i] = 0.f; }
    const int qw0 = A.qlat0 + wid * 32;
    bool first = true;
    if (nt > 0) ATT_DMA(0);
    for (int t = 0; t < nt; ++t) {
        asm volatile("s_waitcnt vmcnt(0)" ::: "memory");
        __syncthreads();
        if (t + 1 < nt) ATT_DMA(t + 1);
        const int keyrow = t < na ? A.ka0 + 64 * t : A.kb0 + 64 * (t - na);
        const bool banded = A.window && t >= na;
        const int kj0 = keyrow - CTXL;
        if (banded && (kj0 + 63 < qw0 - 128 || kj0 > qw0 + 31 + 128)) continue;
        const LAS unsigned char* kb = lds + (t & 1) * BUF;
        const LAS unsigned char* vb = kb + KB;
        f32x16 p0 = negm, p1 = negm;
        const LAS unsigned char* kf = kb + hi * 1024 + r32 * 16;
        bf16x8 ka[2 * ND];
#pragma unroll
        for (int d0 = 0; d0 < ND; ++d0) { ka[2 * d0] = *(const LAS bf16x8*)(kf + d0 * 2048); ka[2 * d0 + 1] = *(const LAS bf16x8*)(kf + d0 * 2048 + 512); }
        __builtin_amdgcn_sched_barrier(0);
#pragma unroll
        for (int d0 = 0; d0 < ND; ++d0) {
            p0 = __builtin_amdgcn_mfma_f32_32x32x16_bf16(ka[2 * d0], qr[d0], p0, 0, 0, 0);
            p1 = __builtin_amdgcn_mfma_f32_32x32x16_bf16(ka[2 * d0 + 1], qr[d0], p1, 0, 0, 0);
        }
        const LAS unsigned char* vp = vb + ((lane >> 4) & 1) * 32 + (lane & 3) * 8 + (4 * hi + ((lane & 15) >> 2)) * 64;
        s16x4 vl0[4], vh0[4], vl1[4], vh1[4];
        { const unsigned va_ = (unsigned)(unsigned long)vp;
#define VTR_ASM(dst, off) asm volatile("ds_read_b64_tr_b16 %0, %1 offset:%2" : "=v"(dst) : "v"(va_), "n"(off) : "memory")
#pragma unroll
          for (int ks = 0; ks < 4; ++ks) { VTR_ASM(vl0[ks], ks * 1024); VTR_ASM(vh0[ks], ks * 1024 + 512); VTR_ASM(vl1[ks], 4096 + ks * 1024); VTR_ASM(vh1[ks], 4096 + ks * 1024 + 512); }
#undef VTR_ASM
        }
        if (banded) {
            const int qi = qw0 + r32;
#pragma unroll
            for (int i = 0; i < 16; ++i) { const int kj = kj0 + crow(i, hi); const int d0_ = qi - kj, d1_ = qi - (kj + 32);
                if (d0_ > 128 || d0_ < -128) p0[i] = -INFINITY; if (d1_ > 128 || d1_ < -128) p1[i] = -INFINITY; }
        }
        float mx = __builtin_fmaxf(__builtin_fmaxf(p0[0], p0[1]), p1[0]);
#pragma unroll
        for (int i = 2; i < 16; i += 2) mx = __builtin_fmaxf(__builtin_fmaxf(mx, p0[i]), p0[i + 1]);
#pragma unroll
        for (int i = 1; i < 15; i += 2) mx = __builtin_fmaxf(__builtin_fmaxf(mx, p1[i]), p1[i + 1]);
        mx = __builtin_fmaxf(mx, p1[15]);
        { auto rr = __builtin_amdgcn_permlane32_swap(__float_as_uint(mx), __float_as_uint(mx), false, false); mx = __builtin_fmaxf(__uint_as_float(rr[0]), __uint_as_float(rr[1])); }
        if (first || __any(mx > THR)) {
            const float dl = first ? mx : __builtin_fmaxf(mx, 0.f);
            first = false;
            m_ref += dl;
            const float f = fast_exp2(-dl);
            l_run *= f;
#pragma unroll
            for (int i = 0; i < 16; ++i) { p0[i] -= dl; p1[i] -= dl; o0[i] *= f; o1[i] *= f; negm[i] = -m_ref; }
        }
        float ps = 0.f;
#pragma unroll
        for (int i = 0; i < 16; ++i) { p0[i] = fast_exp2(p0[i]); p1[i] = fast_exp2(p1[i]); ps += p0[i] + p1[i]; }
        l_run += ps;
        bf16x8 pb[4];
#pragma unroll
        for (int s = 0; s < 2; ++s) {
            u32x4 w0, w1;
            w0.x = cvt_pk_bf16(p0[8 * s + 0], p0[8 * s + 1]); w0.y = cvt_pk_bf16(p0[8 * s + 2], p0[8 * s + 3]); w0.z = cvt_pk_bf16(p0[8 * s + 4], p0[8 * s + 5]); w0.w = cvt_pk_bf16(p0[8 * s + 6], p0[8 * s + 7]);
            w1.x = cvt_pk_bf16(p1[8 * s + 0], p1[8 * s + 1]); w1.y = cvt_pk_bf16(p1[8 * s + 2], p1[8 * s + 3]); w1.z = cvt_pk_bf16(p1[8 * s + 4], p1[8 * s + 5]); w1.w = cvt_pk_bf16(p1[8 * s + 6], p1[8 * s + 7]);
            pb[s] = __builtin_bit_cast(bf16x8, w0); pb[2 + s] = __builtin_bit_cast(bf16x8, w1);
        }
        asm volatile("s_waitcnt lgkmcnt(0)" : "+v"(vl0[0]), "+v"(vl0[1]), "+v"(vl0[2]), "+v"(vl0[3]), "+v"(vh0[0]), "+v"(vh0[1]), "+v"(vh0[2]), "+v"(vh0[3]),
                                              "+v"(vl1[0]), "+v"(vl1[1]), "+v"(vl1[2]), "+v"(vl1[3]), "+v"(vh1[0]), "+v"(vh1[1]), "+v"(vh1[2]), "+v"(vh1[3]) :: "memory");
#pragma unroll
        for (int ks = 0; ks < 4; ++ks) {
            const s16x4 l0 = vl0[ks], h0 = vh0[ks], l1 = vl1[ks], h1 = vh1[ks];
            const bf16x8 va = (bf16x8){l0[0], l0[1], l0[2], l0[3], h0[0], h0[1], h0[2], h0[3]}, vb2 = (bf16x8){l1[0], l1[1], l1[2], l1[3], h1[0], h1[1], h1[2], h1[3]};
            o0 = __builtin_amdgcn_mfma_f32_32x32x16_bf16(va, pb[ks], o0, 0, 0, 0);
            o1 = __builtin_amdgcn_mfma_f32_32x32x16_bf16(vb2, pb[ks], o1, 0, 0, 0);
        }
    }
    const float m_run = m_ref;
#undef ATT_DMA
    float l_tot; { auto rr = __builtin_amdgcn_permlane32_swap(__float_as_uint(l_run), __float_as_uint(l_run), false, false); l_tot = __uint_as_float(rr[0]) + __uint_as_float(rr[1]); }
    if (A.use_sink) l_tot += fast_exp2(A.sink_l2 - m_run);
    const int qrow = wid * 32 + r32;
    if (A.out_mode == 0) {
        const float inv = 1.0f / l_tot;
        bf16_t* op = A.obf + (size_t)qrow * 1024 + 4 * hi;
#pragma unroll
        for (int g = 0; g < 4; ++g) {
            u32x2 w; w.x = cvt_pk_bf16(o0[4 * g] * inv, o0[4 * g + 1] * inv); w.y = cvt_pk_bf16(o0[4 * g + 2] * inv, o0[4 * g + 3] * inv); *(GAS u32x2*)(op + 8 * g) = w;
            u32x2 w2; w2.x = cvt_pk_bf16(o1[4 * g] * inv, o1[4 * g + 1] * inv); w2.y = cvt_pk_bf16(o1[4 * g + 2] * inv, o1[4 * g + 3] * inv); *(GAS u32x2*)(op + 32 + 8 * g) = w2;
        }
    } else {
        float* op = A.opf + (size_t)qrow * 256 + 4 * hi;
#pragma unroll
        for (int g = 0; g < 4; ++g) {
            *(GAS f32x4*)(op + 8 * g) = (f32x4){o0[4 * g], o0[4 * g + 1], o0[4 * g + 2], o0[4 * g + 3]};
            *(GAS f32x4*)(op + 32 + 8 * g) = (f32x4){o1[4 * g], o1[4 * g + 1], o1[4 * g + 2], o1[4 * g + 3]};
        }
        if (hi == 0) { GAS float* mp = (GAS float*)(A.mlp + (size_t)qrow * 8); mp[0] = m_run; mp[1] = l_tot; }
        if (A.empty_part) {
            float* op2 = A.opf2 + (size_t)qrow * 256 + 4 * hi;
#pragma unroll
            for (int g = 0; g < 4; ++g) { *(GAS f32x4*)(op2 + 8 * g) = (f32x4){0.f, 0.f, 0.f, 0.f}; *(GAS f32x4*)(op2 + 32 + 8 * g) = (f32x4){0.f, 0.f, 0.f, 0.f}; }
            if (hi == 0) { GAS float* mp = (GAS float*)(A.mlp2 + (size_t)qrow * 8); float neg = -1.0e30f, zer = 0.f; asm volatile("" : "+v"(neg), "+v"(zer)); mp[0] = neg; mp[1] = zer; }
        }
    }
    __syncthreads();
}

constexpr int ATT_NUNITS = 1304;
DI void attn_run_unit(Frame& F, int l, int idx) {
    AttnArgs A;
    const bf16_t* P = FP(F); bf16_t* YA = (bf16_t*)(F.ws + WS_YALL);
    float* OP = (float*)(F.ws + WS_OPART); float* ML = (float*)(F.ws + WS_ML);
    A.window = 0; A.qlat0 = 0; A.use_sink = 0; A.sink_l2 = 0.f; A.empty_part = 0; A.opf2 = nullptr; A.mlp2 = nullptr; A.obf = nullptr; A.opf = nullptr; A.mlp = nullptr;
    A.kb0 = 0; A.kb1 = 0;
    if (idx < 1024) {
        const int kind = idx >> 9, i = idx & 511, split = i & 1, qb = (i >> 1) & 31, h = (i >> 6) & 3, b = i >> 8;
        const size_t row0 = (size_t)b * TPB + CTXL + qb * 256, brow = (size_t)b * TPB;
        A.ka0 = split * (TPB / 2); A.ka1 = A.ka0 + TPB / 2;
        A.out_mode = 1; A.opf = OP + ((size_t)(kind * NSPLIT + split) * NROW + row0) * 256 + h * 64; A.mlp = ML + (((size_t)(kind * NSPLIT + split) * NROW + row0) * 4 + h) * 2;
        if (kind == 0) {
            const bf16_t* Qm = (const bf16_t*)(F.ws + WS_QMLA); const bf16_t* Km = (const bf16_t*)(F.ws + WS_KMLA); const bf16_t* Vm = (const bf16_t*)(F.ws + WS_VMLA);
            A.Q = Qm + row0 * 384 + h * 96; A.qpitch = 384; A.K = Km + brow * 384 + h * 96; A.kpitch = 384; A.V = Vm + brow * 256 + h * 64; A.vpitch = 256;
            attn_unit<96>(F, A);
        } else {
            A.Q = P + row0 * LDP + PC_GAQ + h * 64; A.qpitch = LDP; A.K = P + brow * LDP + PC_GAK + (h >> 1) * 64; A.kpitch = LDP; A.V = P + brow * LDP + PC_GAV + (h >> 1) * 64; A.vpitch = LDP;
            attn_unit<64>(F, A);
        }
    } else if (idx < 1280) {
        const int i = idx - 1024, qb = i & 31, h = (i >> 5) & 3, b = i >> 7;
        const size_t row0 = (size_t)b * TPB + CTXL + qb * 256, brow = (size_t)b * TPB;
        const int q0 = qb * 256; int lo = q0 - 128; if (lo < 0) lo = 0; int hi_ = q0 + 256 + 128; if (hi_ > SEQ) hi_ = SEQ;
        A.ka0 = 0; A.ka1 = CTXL; A.kb0 = CTXL + lo; A.kb1 = CTXL + hi_; A.window = 1; A.qlat0 = q0;
        A.use_sink = 1; A.sink_l2 = inp(I_SINK)[l * 4 + h] * LOG2E;
        A.Q = P + row0 * LDP + PC_SWQ + h * 64; A.qpitch = LDP; A.K = P + brow * LDP + PC_SWK + (h >> 1) * 64; A.kpitch = LDP; A.V = P + brow * LDP + PC_SWV + (h >> 1) * 64; A.vpitch = LDP;
        A.out_mode = 0; A.obf = YA + row0 * 1024 + 256 + h * 64;
        attn_unit<64>(F, A);
    } else {
        const int i = idx - 1280, ck = i >> 3, b = (i >> 2) & 1, h = i & 3;
        const size_t row0 = (size_t)b * TPB, brow = row0;
        A.ka0 = 0; A.ka1 = CTXL;
        if (ck == 0) {
            const bf16_t* Qm = (const bf16_t*)(F.ws + WS_QMLA); const bf16_t* Km = (const bf16_t*)(F.ws + WS_KMLA); const bf16_t* Vm = (const bf16_t*)(F.ws + WS_VMLA);
            A.Q = Qm + row0 * 384 + h * 96; A.qpitch = 384; A.K = Km + brow * 384 + h * 96; A.kpitch = 384; A.V = Vm + brow * 256 + h * 64; A.vpitch = 256;
            A.out_mode = 1; A.opf = OP + ((size_t)(0 * NSPLIT + 0) * NROW + row0) * 256 + h * 64; A.mlp = ML + (((size_t)(0 * NSPLIT + 0) * NROW + row0) * 4 + h) * 2;
            A.empty_part = 1; A.opf2 = OP + ((size_t)(0 * NSPLIT + 1) * NROW + row0) * 256 + h * 64; A.mlp2 = ML + (((size_t)(0 * NSPLIT + 1) * NROW + row0) * 4 + h) * 2;
            attn_unit<96>(F, A);
        } else if (ck == 1) {
            A.Q = P + row0 * LDP + PC_GAQ + h * 64; A.qpitch = LDP; A.K = P + brow * LDP + PC_GAK + (h >> 1) * 64; A.kpitch = LDP; A.V = P + brow * LDP + PC_GAV + (h >> 1) * 64; A.vpitch = LDP;
            A.out_mode = 1; A.opf = OP + ((size_t)(1 * NSPLIT + 0) * NROW + row0) * 256 + h * 64; A.mlp = ML + (((size_t)(1 * NSPLIT + 0) * NROW + row0) * 4 + h) * 2;
            A.empty_part = 1; A.opf2 = OP + ((size_t)(1 * NSPLIT + 1) * NROW + row0) * 256 + h * 64; A.mlp2 = ML + (((size_t)(1 * NSPLIT + 1) * NROW + row0) * 4 + h) * 2;
            attn_unit<64>(F, A);
        } else {
            A.use_sink = 1; A.sink_l2 = inp(I_SINK)[l * 4 + h] * LOG2E;
            A.Q = P + row0 * LDP + PC_SWQ + h * 64; A.qpitch = LDP; A.K = P + brow * LDP + PC_SWK + (h >> 1) * 64; A.kpitch = LDP; A.V = P + brow * LDP + PC_SWV + (h >> 1) * 64; A.vpitch = LDP;
            A.out_mode = 0; A.obf = YA + row0 * 1024 + 256 + h * 64;
            attn_unit<64>(F, A);
        }
    }
}

constexpr int SC_CH = 32, SC_STEP = 1536, SC_BUF = SC_CH * SC_STEP;
DI int scan_row(int b, int d, int n) { return b * TPB + (d == 0 ? n : (n < CTXL ? CTXL - 1 - n : TPB + CTXL - 1 - n)); }

struct ScanRegs { f32x4 w[2]; u32x2 b[5][2]; };
DI void scan_load(const Frame& F, int b, int d, int h, int chunk, int lt, ScanRegs& R) {
    const float* W = (const float*)(F.ws + WS_W); const bf16_t* KD = (const bf16_t*)(F.ws + WS_KD); const bf16_t* BB = (const bf16_t*)(F.ws + WS_BB);
    const bf16_t* KK = (const bf16_t*)(F.ws + WS_KK); const bf16_t* RR = (const bf16_t*)(F.ws + WS_RR); const bf16_t* V = (const bf16_t*)(F.ws + WS_V);
    const int piece = lt & 15;
#pragma unroll
    for (int half = 0; half < 2; ++half) {
        const int row = scan_row(b, d, chunk * SC_CH + half * 16 + (lt >> 4));
        const size_t o512 = (size_t)row * 512 + d * 256 + h * 64 + 4 * piece, o256 = (size_t)row * 256 + h * 64 + 4 * piece;
        R.w[half] = *(const GAS f32x4*)(W + o512);
        R.b[0][half] = *(const GAS u32x2*)(KD + o512); R.b[1][half] = *(const GAS u32x2*)(BB + o512);
        R.b[2][half] = *(const GAS u32x2*)(KK + o256); R.b[3][half] = *(const GAS u32x2*)(RR + o256); R.b[4][half] = *(const GAS u32x2*)(V + o256);
    }
}
DI void scan_store(const Frame& F, int chunk, int lt, const ScanRegs& R) {
    LAS unsigned char* buf = F.lds + (chunk & 1) * SC_BUF;
    const int piece = lt & 15;
#pragma unroll
    for (int half = 0; half < 2; ++half) {
        LAS unsigned char* sp = buf + (half * 16 + (lt >> 4)) * SC_STEP + piece * 16;
        *(LAS f32x4*)sp = R.w[half];
#pragma unroll
        for (int v = 0; v < 5; ++v) { const u32x2 w = R.b[v][half]; *(LAS f32x4*)(sp + (v + 1) * 256) = (f32x4){bflo(w.x), bfhi(w.x), bflo(w.y), bfhi(w.y)}; }
    }
}
constexpr int SCAN_NWG = 64;
template <int VAR>
DI void scan_phase(Frame& F, int sw) {
    const int chain = sw >> 2, quarter = sw & 3, b = chain >> 3, d = (chain >> 2) & 1, h = chain & 3;
    const int lane = F.lane, wid = F.wave, g = lane >> 4, kq = lane & 15;
    const int vrow = quarter * 16 + (wid & 3) * 4 + g;
    float* Y = (float*)(F.ws + WS_YDIR) + (size_t)d * NROW * 256;
    constexpr int NCHUNK = TPB / SC_CH;
    f32x2 S01 = (f32x2){0.f, 0.f}, S23 = (f32x2){0.f, 0.f};
    ScanRegs R2[2];
    const int lt = F.tid - 256;
    if (wid >= 4) { scan_load(F, b, d, h, 0, lt, R2[0]); scan_store(F, 0, lt, R2[0]); scan_load(F, b, d, h, 1, lt, R2[0]); scan_load(F, b, d, h, 2, lt, R2[1]); }
    __syncthreads();
    static_assert(NCHUNK % 2 == 0, "trip pairs");
    for (int c2 = 0; c2 < NCHUNK; c2 += 2)
#pragma unroll
    for (int cu = 0; cu < 2; ++cu) {
        const int c = c2 + cu;
        if (wid >= 4) {
            if (c + 1 < NCHUNK) scan_store(F, c + 1, lt, R2[cu]);
            if (c + 3 < NCHUNK) scan_load(F, b, d, h, c + 3, lt, R2[cu]);
        } else {
            const LAS unsigned char* buf = F.lds + (c & 1) * SC_BUF + kq * 16;
            const LAS unsigned char* vbuf = F.lds + (c & 1) * SC_BUF + 1280 + vrow * 4;
            f32x4 w4 = *(const LAS f32x4*)(buf), kd4 = *(const LAS f32x4*)(buf + 256), bb4 = *(const LAS f32x4*)(buf + 512), kk4 = *(const LAS f32x4*)(buf + 768), r4 = *(const LAS f32x4*)(buf + 1024);
            float vv = *(const LAS float*)(vbuf);
#pragma unroll
            for (int half = 0; half < 2; ++half) {
                float yp[16];
#pragma unroll
                for (int s16 = 0; s16 < 16; ++s16) {
                    const int sn = half * 16 + s16 + 1 < SC_CH ? half * 16 + s16 + 1 : SC_CH - 1;
                    const LAS unsigned char* sp = buf + sn * SC_STEP;
                    const f32x4 w4n = *(const LAS f32x4*)(sp), kd4n = *(const LAS f32x4*)(sp + 256), bb4n = *(const LAS f32x4*)(sp + 512), kk4n = *(const LAS f32x4*)(sp + 768), r4n = *(const LAS f32x4*)(sp + 1024);
                    const float vvn = *(const LAS float*)(vbuf + sn * SC_STEP);
                    const f32x2 k01 = __builtin_shufflevector(kk4, kk4, 0, 1), k23 = __builtin_shufflevector(kk4, kk4, 2, 3);
                    f32x2 t2 = S01 * k01; t2 = S23 * k23 + t2;
                    const float sa = (VAR & 2) ? -(t2[0] + t2[1]) : -rsum16(t2[0] + t2[1]);
                    const f32x2 w01 = __builtin_shufflevector(w4, w4, 0, 1), w23 = __builtin_shufflevector(w4, w4, 2, 3);
                    const f32x2 d01 = __builtin_shufflevector(kd4, kd4, 0, 1), d23 = __builtin_shufflevector(kd4, kd4, 2, 3);
                    const f32x2 b01 = __builtin_shufflevector(bb4, bb4, 0, 1), b23 = __builtin_shufflevector(bb4, bb4, 2, 3);
                    S01 = b01 * sa + (d01 * vv + S01 * w01); S23 = b23 * sa + (d23 * vv + S23 * w23);
                    const f32x2 r01 = __builtin_shufflevector(r4, r4, 0, 1), r23 = __builtin_shufflevector(r4, r4, 2, 3);
                    f32x2 u2 = S01 * r01; u2 = S23 * r23 + u2;
                    yp[s16] = (VAR & 4) ? 0.f : (u2[0] + u2[1]);
                    w4 = w4n; kd4 = kd4n; bb4 = bb4n; kk4 = kk4n; r4 = r4n; vv = vvn;
                }
                float ykeep;
                {
#define DPPMOV(x, ctrl) __builtin_bit_cast(float, __builtin_amdgcn_update_dpp(0, __builtin_bit_cast(int, (x)), (ctrl), 0xf, 0xf, false))
                    const bool b3 = (kq & 8) != 0, b2 = (kq & 4) != 0, b1 = (kq & 2) != 0, b0 = (kq & 1) != 0;
#pragma unroll
                    for (int q = 0; q < 8; ++q) { const float keep = b3 ? yp[q + 8] : yp[q], send = b3 ? yp[q] : yp[q + 8]; yp[q] = keep + DPPMOV(send, 0x128); }
#pragma unroll
                    for (int q = 0; q < 4; ++q) { const float keep = b2 ? yp[q + 4] : yp[q], send = b2 ? yp[q] : yp[q + 4]; yp[q] = keep + DPPMOV(send, 0x141); }
#pragma unroll
                    for (int q = 0; q < 2; ++q) { const float keep = b1 ? yp[q + 2] : yp[q], send = b1 ? yp[q] : yp[q + 2]; yp[q] = keep + DPPMOV(send, 0x4E); }
                    { const float keep = b0 ? yp[1] : yp[0], send = b0 ? yp[0] : yp[1]; ykeep = keep + DPPMOV(send, 0xB1); }
#undef DPPMOV
                }
                const int n = c * SC_CH + half * 16 + kq;
                if (VAR == 0) *(GAS float*)(Y + (size_t)scan_row(b, d, n) * 256 + h * 64 + vrow) = ykeep; else asm volatile("" :: "v"(ykeep));
            }
        }
        asm volatile("s_waitcnt lgkmcnt(0)" ::: "memory"); __builtin_amdgcn_s_barrier(); asm volatile("" ::: "memory");
    }
    __syncthreads();
}
constexpr int NPH_LAYER = 13, NPHASE = 1 + NPH_LAYER * DEPTH + 1;
struct Args { const float* in[43]; float* out; unsigned char* ws; int ph_lo, ph_hi; };
DI void wg_sync() { __syncthreads(); }
#ifdef MIX_MERGE
DI void mix_wait(unsigned* p, unsigned n) {
    if (threadIdx.x == 0) { unsigned sp = 0; while (xb_ld(p) < n) { __builtin_amdgcn_s_sleep(4); if (++sp > (1u << 22)) break; }
        __builtin_amdgcn_fence(__ATOMIC_ACQUIRE, "agent"); asm volatile("s_waitcnt vmcnt(0)" ::: "memory"); }
    wg_sync();
}
DI void mix_publish(unsigned* p, unsigned n) {
    asm volatile("s_waitcnt vmcnt(0)" ::: "memory"); wg_sync();
    if (threadIdx.x == 0) { __builtin_amdgcn_fence(__ATOMIC_RELEASE, "agent"); asm volatile("s_waitcnt vmcnt(0)" ::: "memory"); (void)xb_add(p, n); }
}
DI void mix_merge_tail(const Frame& F0, int l) {
    constexpr int NFCH = NROW / 64;
    {
        Frame Q = relane(F0);
        unsigned* sy = Q.ctl + CW_SYNC + l * 256;
        mix_wait(sy, (unsigned)ATT_NUNITS);
#ifdef PROBE_SEL
        if (blockIdx.x == 255 && threadIdx.x == 0) ((unsigned long long*)(F0.ws + 7 * MiB))[128 + l] = __builtin_amdgcn_s_memrealtime();
#endif
        int nch = 0;
        for (;;) {
            if (Q.tid == 0) Q.MISC[16] = xb_add(sy + 64, 1u);
            wg_sync();
            const int ch = (int)Q.MISC[16];
            wg_sync();
            if (ch >= NFCH) break;
            finish_rows<2>(Q, l, ch * 64, ch * 64 + 64, 1); ++nch;
        }
        if (nch > 0) mix_publish(sy + 128, (unsigned)nch);
        mix_wait(sy + 128, (unsigned)NFCH);
#ifdef PROBE_SEL
        if (blockIdx.x == 255 && threadIdx.x == 0) ((unsigned long long*)(F0.ws + 7 * MiB))[136 + l] = __builtin_amdgcn_s_memrealtime();
#endif
    }
    for (;;) {
        Frame Q = relane(F0);
        int ll = l; asm volatile("" : "+s"(ll));
        if (Q.tid == 0) Q.MISC[16] = xb_add(Q.ctl + CW_SYNC + ll * 256 + 192, 1u);
        wg_sync();
        const int it = (int)Q.MISC[16];
        wg_sync();
        const int lat = (ll == DEPTH - 1);
        if (it >= 3 * (lat ? 256 : 264)) break;
        const int ti = it / 3, br = 1 + it % 3;
        unsigned char* wl = Q.ws + ((ll & 1) ? WS_WL : WS_WLB);
        pg8::Gemm g{(const char*)(Q.ws + WS_YALL), (const char*)(wl + WL_WBR), 1024, 256, 256};
        SchedMerge S{Q.G, ti, lat, br, 1, 1};
        bf16_t* dst = (bf16_t*)(Q.ws + (br == 1 ? WS_HB : WS_OPART)) + (size_t)(br == 3 ? 1 : 0) * NROW * 1024;
        EpiMergeP E{FP(Q), dst};
        pg8::gemm_phase(Q.lds, g, S, E, Q.wave);
    }
}
#endif
template <int NS>
DI void ctx_splitk_tail(const Frame& F0, int l, const char* A, const char* Bt, int ld, int which, int cw) {
    Frame Q = relane(F0);
    const int kc = ld / NS;
    pg8::Gemm g2{A, Bt, ld, ld, kc};
    SchedCtxK S2{Q.G, Q.bx, NS, kc, ld, ld}; EpiSlab E2{(float*)(Q.ws + WS_SLAB)};
    pg8::gemm_phase(Q.lds, g2, S2, E2, Q.wave);
    const int sl = Q.bx % NS, t = Q.bx / NS, pn = t & 3, pm = (t >> 2) ? 33 : 0;
    unsigned* cnt = Q.ctl + CW_SLABCNT + l * 64 + cw + t;
    mix_publish(cnt, 1u);
    mix_wait(cnt, (unsigned)NS);
    constexpr int RPS = (256 + NS - 1) / NS;
    const int r0 = sl * RPS, r1 = r0 + RPS < 256 ? r0 + RPS : 256;
    const float* slab = (const float*)(Q.ws + WS_SLAB);
    const float* gv = FMOD(Q) + (size_t)l * 3 * 6144 + ((size_t)2 * 6 + which) * 1024 + pn * 256 + 4 * (Q.tid & 63);
    const f32x4 gg = *(const GAS f32x4*)gv;
    for (int r = r0 + (Q.tid >> 6); r < r1; r += 8) {
        const size_t so = ((size_t)((pm == 33 ? 256 : 0) + r)) * 1024 + pn * 256 + 4 * (Q.tid & 63);
        f32x4 a = *(const GAS f32x4*)(slab + so);
#pragma unroll
        for (int q = 1; q < NS; ++q) a = a + *(const GAS f32x4*)(slab + (size_t)q * 512 * 1024 + so);
        float* xp = FX(Q) + ((size_t)pm * 256 + r) * 1024 + pn * 256 + 4 * (Q.tid & 63);
        *(GAS f32x4*)xp = *(const GAS f32x4*)xp + gg * a;
    }
}
#ifdef NOPK
#define KATTR __attribute__((target("no-packed-fp32-ops")))
#else
#define KATTR
#endif
__global__ void __launch_bounds__(512, 2) KATTR hfb_fwd(Args args) {
    extern __shared__ __attribute__((aligned(16))) unsigned char lds_raw[];
    Frame F;
    F.lds = (LAS unsigned char*)lds_raw;
    F.MISC = (volatile LAS unsigned*)(F.lds + MISC_OFF);
    F.tid = threadIdx.x; F.lane = F.tid & 63; F.wave = __builtin_amdgcn_readfirstlane(F.tid >> 6);
    F.bx = blockIdx.x; F.G = gridDim.x; { const int bx = blockIdx.x; F.vcu = (F.G % 8 == 0) ? (bx % 8) * (F.G / 8) + bx / 8 : bx; }
    F.ws = args.ws; F.ctl = (unsigned*)(args.ws + WS_CTL); F.out = args.out;
    for (int u = F.tid; u < (LDS_BYTES - MISC_OFF) / 4; u += 512) ((LAS unsigned*)(F.lds + MISC_OFF))[u] = 0u;
    wg_sync();
    const int lo = args.ph_lo, hi = args.ph_hi;
    XcdBarrier bar; bar.bar = F.ctl + CW_BAR; bar.x = 0; bar.st = nullptr;
    if (hi - lo > 1) bar = xcd_barrier_post(F.ctl + CW_BAR, F.MISC + 8);
#ifndef PH_MASK
#define PH_MASK 0xFFFFF
#endif
#define IN(k) (lo <= (k) && (k) < hi)
#define INL(j) ((((PH_MASK) >> (j)) & 1) && IN(pb + (j)))
#ifndef SKEW_K1024
#define SKEW_K1024 0
#endif
#ifndef SKEW_K3584
#define SKEW_K3584 0
#endif
#ifndef DUP_MASK
#define DUP_MASK 0
#endif
#define NREP(j) ((((DUP_MASK) >> (j)) & 1) ? 2 : 1)
#define REPBAR(j) do { if (rep + 1 < NREP(j) && hi - lo > 1) xcd_barrier_t<false>(bar); } while (0)
#ifndef PROBE_AMP
#define PROBE_AMP 4
#endif
#ifdef PROBE_SEL
    unsigned long long* const stamps = (unsigned long long*)(F.ws + 7 * MiB);
#define STAMP(i) do { if (blockIdx.x == 0 && threadIdx.x == 0) { stamps[(i)] = __builtin_amdgcn_s_memrealtime(); } } while (0)
#define STAMPB(i) do { if (blockIdx.x == 255 && threadIdx.x == 0) { stamps[(i)] = __builtin_amdgcn_s_memrealtime(); } } while (0)
#else
#define STAMP(i) do { } while (0)
#define STAMPB(i) do { } while (0)
#endif
#define SEAM(k) do { if (IN(k) && IN((k) + 1)) xcd_barrier_t<false>(bar); STAMP((k) + 1); } while (0)
    const int bx = blockIdx.x;

    STAMP(96);
    if (((PH_MASK >> 16) & 1) && IN(0)) { Frame Q = relane(F); p0_prologue(Q); }
    STAMP(0);
    if (hi - lo > 1) xcd_barrier_t<true>(bar);

    STAMP(1);
    for (int l = 0; l < DEPTH; ++l) {
        const int pb = 1 + NPH_LAYER * l;
        if (INL(0)) { Frame Q = relane(F); norm_phase<0>(Q, l); } SEAM(pb + 0);
        if (INL(1)) {
            Frame Q = relane(F); unsigned char* wl = Q.ws + ((l & 1) ? WS_WL : WS_WLB);
            pg8::Gemm g{(const char*)FHB(Q), (const char*)(wl + WL_WIN), 1024, 1024, 1024};
            SchedGrid S; S.T.init(NPANEL, NP_GEMM / 256, Q.G, Q.bx); S.lda = 1024; S.ldb = 1024; S.acol = 0; S.lat = 0;
            EpiWin E{FP(Q), 10, 0};
#ifdef DUP_NULL_WIN
            pg8::gemm_phase(Q.lds, g, S, E, Q.wave); if (hi - lo > 1) xcd_barrier_t<false>(bar);
            #if DUP_NULL_WIN == 1
            { EpiNull E0{FP(Q)}; pg8::gemm_phase(Q.lds, g, S, E0, Q.wave); }
#elif DUP_NULL_WIN == 2
            { EpiWin E0{(bf16_t*)(Q.ws + WS_RR), 1000, 0}; pg8::gemm_phase(Q.lds, g, S, E0, Q.wave); }
#elif DUP_NULL_WIN == 3
            { EpiWin E0{(bf16_t*)(Q.ws + WS_RR), 10, 0}; pg8::gemm_phase(Q.lds, g, S, E0, Q.wave); }
#elif DUP_NULL_WIN == 5
            { EpiWin E0{(bf16_t*)(Q.ws + WS_RR), 0, 0}; pg8::gemm_phase(Q.lds, g, S, E0, Q.wave); }
#else
            { EpiWin E0{(bf16_t*)(Q.ws + WS_RR), 1000, 1}; pg8::gemm_phase(Q.lds, g, S, E0, Q.wave); }
#endif
#else
            for (int rep = 0; rep < NREP(1); ++rep) { pg8::gemm_phase(Q.lds, g, S, E, Q.wave, SKEW_K1024); REPBAR(1); }
#endif
        } SEAM(pb + 1);
        if (INL(2)) { Frame Q = relane(F); prep_phase(Q, l); } SEAM(pb + 2);
        if (INL(3)) {
            Frame Q = relane(F); unsigned char* wl = Q.ws + ((l & 1) ? WS_WL : WS_WLB);
            pg8::Gemm g{(const char*)FP(Q), (const char*)(wl + WL_L1), LDP, 256, 256};
            SchedL3B S{Q.G, Q.bx};
            EpiL3B E{(bf16_t*)(Q.ws + WS_T), (bf16_t*)(Q.ws + WS_QMLA), (bf16_t*)(Q.ws + WS_KMLA), (bf16_t*)(Q.ws + WS_VMLA), (const float*)(Q.ws + WS_ROPE32)};
            for (int rep = 0; rep < NREP(3); ++rep) { pg8::gemm_phase(Q.lds, g, S, E, Q.wave); REPBAR(3); }
        } SEAM(pb + 3);
        if (INL(4)) {
            Frame Q = relane(F); unsigned char* wl = Q.ws + ((l & 1) ? WS_WL : WS_WLB);
            pg8::Gemm g{(const char*)(Q.ws + WS_T), (const char*)(wl + WL_L2), 1536, 256, 256};
            SchedL3C S{Q.G, Q.bx, l};
            EpiL3C E{l, inp(I_W0) + l * 512, inp(I_A0) + l * 512, inp(I_V0) + (l > 0 ? l - 1 : 0) * 256, inp(I_KA) + l * 256,
                     (float*)(Q.ws + WS_W), (bf16_t*)(Q.ws + WS_KD), (bf16_t*)(Q.ws + WS_BB), (const bf16_t*)(Q.ws + WS_KR), (const bf16_t*)(Q.ws + WS_KK),
                     (bf16_t*)(Q.ws + WS_V), (const bf16_t*)(Q.ws + WS_VF), (bf16_t*)(Q.ws + WS_G)};
            pg8::gemm_phase(Q.lds, g, S, E, Q.wave);
        } SEAM(pb + 4);
        if (INL(5)) {
            Frame Q = relane(F); unsigned char* wl = Q.ws + ((l & 1) ? WS_WL : WS_WLB);

#ifndef DUP_MIX
#define DUP_MIX 3
#endif
            for (int rep = 0; rep < NREP(5); ++rep) {
            if (Q.bx < SCAN_NWG && (rep == 0 || (DUP_MIX & 1))) scan_phase<0>(Q, Q.bx);
            STAMP(64 + l);
#ifdef PROBE_SEL
            if (Q.bx < SCAN_NWG && threadIdx.x == 0) stamps[192 + l * 64 + Q.bx] = __builtin_amdgcn_s_memrealtime();
#endif
#ifdef SCAN_VARIANT
            if (Q.bx < SCAN_NWG) scan_phase<SCAN_VARIANT>(Q, Q.bx);
            STAMP(80 + l);
#endif
            if (rep == 0 || (DUP_MIX & 2)) {
                const int x0 = (int)(xb_xcc_id() & 7u);
                if (Q.tid < 8) Q.MISC[32 + Q.tid] = __hip_atomic_load(Q.ctl + CW_ATTQ + ((l * 2 + rep) * 8 + Q.tid) * 64, __ATOMIC_RELAXED, __HIP_MEMORY_SCOPE_AGENT);
                wg_sync();
                int ndone = 0;
                for (int qi = 0; qi < 8; ++qi) {
                    const int x = (x0 + qi) & 7, xb_ = x >> 2, xh_ = x & 3;
                    if (Q.MISC[32 + x] >= 163u) continue;
                    for (;;) {
                        if (Q.tid == 0) Q.MISC[16] = __hip_atomic_fetch_add(Q.ctl + CW_ATTQ + ((l * 2 + rep) * 8 + x) * 64, 1u, __ATOMIC_RELAXED, __HIP_MEMORY_SCOPE_AGENT);
                        wg_sync();
                        const int j = (int)Q.MISC[16];
                        wg_sync();
                        if (j >= 163) break;
                        int idx;
                        if (j < 128) { const int kind = j >> 6, jj = j & 63, split = jj >> 5, qb = jj & 31; idx = (kind << 9) | (xb_ << 8) | (xh_ << 6) | (qb << 1) | split; }
                        else if (j < 160) idx = 1024 + ((xb_ << 7) | (xh_ << 5) | (j - 128));
                        else idx = 1280 + (((j - 160) << 3) | (xb_ << 2) | xh_);
                        attn_run_unit(Q, l, idx); ++ndone;
                    }
                }
#ifdef MIX_MERGE
                if (ndone > 0) mix_publish(Q.ctl + CW_SYNC + l * 256, (unsigned)ndone);
#endif
            }
            REPBAR(5); }
            STAMPB(112 + l);
            {
                constexpr int CONV_DEFER = 8 * 896 + 2 * 1792;
                const int nown = (l & 1) ? CONV_DEFER : 0;
                constexpr int TOT_DENSE = 2944 + 1792 + 896, TOT_MOE = 2944 + 8 * 1792 + 8 * 896;
                const int tot_own = TOT_MOE;
                const int nnext = l + 1 < DEPTH ? (((l + 1) & 1) ? TOT_MOE - CONV_DEFER : TOT_DENSE) : 0;
                for (;;) {
                    if (Q.tid == 0) Q.MISC[16] = __hip_atomic_fetch_add(Q.ctl + CW_CONVQ + l * 64, 1u, __ATOMIC_RELAXED, __HIP_MEMORY_SCOPE_AGENT);
                    wg_sync();
                    const int p = (int)Q.MISC[16] * 64;
                    wg_sync();
                    if (p >= nown + nnext) break;
                    const bool own = p < nown;
                    int cl = own ? l : l + 1, a0 = own ? tot_own - CONV_DEFER + p : p - nown, lim = own ? tot_own : nnext;
                    int a1 = a0 + 64 < lim ? a0 + 64 : lim;
                    asm volatile("" : "+s"(cl), "+s"(a0), "+s"(a1));
                    convert_layer_weights(Q, cl, ConvSel{1, a0, a1});
                }
            }
            STAMPB(120 + l);
#ifdef MIX_MERGE
            mix_merge_tail(F, l);
            STAMPB(144 + l);
#endif
        } SEAM(pb + 5);
        if (INL(6)) { Frame Q = relane(F); for (int rep = 0; rep < NREP(6); ++rep) { finish_phase(Q, l); REPBAR(6); } } SEAM(pb + 6);
        if (INL(7)) {
            Frame Q = relane(F); unsigned char* wl = Q.ws + ((l & 1) ? WS_WL : WS_WLB);
            pg8::Gemm g{(const char*)(Q.ws + WS_YALL), (const char*)(wl + WL_WBR), 1024, 256, 256};
#ifdef MIX_MERGE
            SchedMerge S{Q.G, Q.bx, l == DEPTH - 1, 0, 1, 0};
            EpiMergeA E{FP(Q), FHB(Q), (const bf16_t*)(Q.ws + WS_OPART), (const bf16_t*)(Q.ws + WS_OPART) + (size_t)NROW * 1024};
#else
            SchedMerge S{Q.G, Q.bx, l == DEPTH - 1, 0, 4, 0};
            EpiMerge E{FP(Q), FHB(Q), 0};
#endif
            for (int rep = 0; rep < NREP(7); ++rep) { pg8::gemm_phase(Q.lds, g, S, E, Q.wave); REPBAR(7); }
        } SEAM(pb + 7);
        if (INL(8)) {
            Frame Q = relane(F); unsigned char* wl = Q.ws + ((l & 1) ? WS_WL : WS_WLB);
            pg8::Gemm g{(const char*)FHB(Q), (const char*)(wl + WL_WOUT), 1024, 1024, 1024};
            SchedGrid S; S.lat = (l == DEPTH - 1); S.T.init(S.lat ? 64 : NPANEL, 4, Q.G, Q.bx); S.lda = 1024; S.ldb = 1024; S.acol = 0;
            EpiResid E{FX(Q), FMOD(Q) + (size_t)l * 3 * 6144, 2};
            pg8::gemm_phase(Q.lds, g, S, E, Q.wave);
        } SEAM(pb + 8);
        if (INL(9)) { Frame Q = relane(F); norm_phase<1>(Q, l); } SEAM(pb + 9);
#ifndef DIAG_DENSE_ONLY
#define DIAG_DENSE_ONLY 0
#endif
#ifndef DIAG_MOE_ONLY
#define DIAG_MOE_ONLY 0
#endif
        if (!DIAG_DENSE_ONLY && ((l & 1) || DIAG_MOE_ONLY)) {
            if (INL(10)) { Frame Q = relane(F); moe_gather(Q, l); } SEAM(pb + 10);
            if (INL(11)) {
                Frame Q = relane(F); unsigned char* wl = Q.ws + ((l & 1) ? WS_WL : WS_WLB);
                pg8::Gemm g{(const char*)(Q.ws + WS_XG), (const char*)(wl + WL_W13), 1024, 1024, 1024};
                SchedMoe S; S.G = Q.G; S.c = Q.bx; S.ncol = 28; S.lda = 1024; S.ldb = 1024; S.nrowB = 7168; moe_panels(Q, l, S.cp);
                EpiSwiGlu E{(bf16_t*)(Q.ws + WS_UG), 1};
                for (int rep = 0; rep < NREP(11); ++rep) { pg8::gemm_phase(Q.lds, g, S, E, Q.wave, SKEW_K1024); REPBAR(11); }
            } SEAM(pb + 11);
            if (INL(12)) {
                Frame Q = relane(F); unsigned char* wl = Q.ws + ((l & 1) ? WS_WL : WS_WLB);
                pg8::Gemm g{(const char*)(Q.ws + WS_UG), (const char*)(wl + WL_W2), DFF, DFF, DFF};
                SchedMoe S; S.G = Q.G; S.c = Q.bx; S.ncol = 4; S.lda = DFF; S.ldb = DFF; S.nrowB = 1024; moe_panels(Q, l, S.cp);
                EpiMoeDown E{(bf16_t*)(Q.ws + WS_YG), (const float*)(Q.ws + WS_ROWGATE)};
                pg8::gemm_phase(Q.lds, g, S, E, Q.wave, SKEW_K3584);
            } SEAM(pb + 12);
        } else {
            if (INL(11)) {
                Frame Q = relane(F); unsigned char* wl = Q.ws + ((l & 1) ? WS_WL : WS_WLB);
                pg8::Gemm g{(const char*)FHB(Q), (const char*)(wl + WL_W13), 1024, 1024, 1024};
                SchedGrid S; S.T.init(NPANEL, 28, Q.G, Q.bx); S.lda = 1024; S.ldb = 1024; S.acol = 0; S.lat = 0;
                EpiSwiGlu E{(bf16_t*)(Q.ws + WS_U), 0};
                for (int rep = 0; rep < NREP(11); ++rep) { pg8::gemm_phase(Q.lds, g, S, E, Q.wave, SKEW_K1024); REPBAR(11); }
            } SEAM(pb + 11);
            if (INL(12)) {
                Frame Q = relane(F); unsigned char* wl = Q.ws + ((l & 1) ? WS_WL : WS_WLB);
                pg8::Gemm g{(const char*)(Q.ws + WS_U), (const char*)(wl + WL_W2D), DFF, DFF, DFF};
                SchedLat S; S.T.init(64, 4, Q.G, Q.bx); S.lda = DFF; S.ldb = DFF;
                EpiResid E{FX(Q), FMOD(Q) + (size_t)l * 3 * 6144, 5};
                pg8::gemm_phase(Q.lds, g, S, E, Q.wave, SKEW_K3584);
                if (Q.bx < 8 * 7) { wg_sync(); ctx_splitk_tail<7>(F, l, (const char*)(Q.ws + WS_U), (const char*)(wl + WL_W2D), DFF, 5, 0); }
            } SEAM(pb + 12);
        }
    }
    if (((PH_MASK >> 17) & 1) && IN(NPHASE - 1)) { Frame Q = relane(F); float probe_scale = 1.0f;

        norm_phase<2>(Q, DEPTH - 1, probe_scale);
#ifdef PROBE_SEL
        if (blockIdx.x == 0 && threadIdx.x == 0) {
            const unsigned long long* st = stamps; unsigned long long dt = 0;
            if (PROBE_SEL < 13) { for (int l = 0; l < DEPTH; ++l) dt += st[2 + 13 * l + PROBE_SEL] - st[1 + 13 * l + PROBE_SEL]; }
            else if (PROBE_SEL == 13) dt = st[1] - st[0];
            else if (PROBE_SEL == 17) dt = st[0] - st[96];
            else if (PROBE_SEL == 22) { for (int l = 0; l < DEPTH; ++l) { unsigned long long mx = 0; for (int b = 0; b < 64; ++b) { const unsigned long long v = st[192 + l * 64 + b]; mx = v > mx ? v : mx; } dt += mx - st[1 + 13 * l + 5]; } }
            else if (PROBE_SEL == 19) { for (int l = 0; l < DEPTH; ++l) dt += st[128 + l] - st[1 + 13 * l + 5]; }
            else if (PROBE_SEL == 20) { for (int l = 0; l < DEPTH; ++l) dt += st[136 + l] - st[1 + 13 * l + 5]; }
            else if (PROBE_SEL == 21) { for (int l = 0; l < DEPTH; ++l) dt += st[144 + l] - st[1 + 13 * l + 5]; }
            else if (PROBE_SEL == 16) { for (int l = 0; l < DEPTH; ++l) dt += st[112 + l] - st[1 + 13 * l + 5]; }
            else if (PROBE_SEL == 18) { for (int l = 0; l < DEPTH; ++l) dt += st[120 + l] - st[1 + 13 * l + 5]; }
            else if (PROBE_SEL == 15) { for (int l = 0; l < DEPTH; ++l) dt += st[64 + l] - st[1 + 13 * l + 5]; }
            else { for (int l = 0; l < DEPTH; ++l) dt += st[80 + l] - st[64 + l]; }
            const unsigned long long t0 = __builtin_amdgcn_s_memrealtime();
            while (__builtin_amdgcn_s_memrealtime() - t0 < (unsigned long long)PROBE_AMP * dt) __builtin_amdgcn_s_sleep(32);
        }
#endif
        }
#undef IN
#undef SEAM
}

extern "C" void kernel_launch(void* const* d_in, const int* in_sizes, int n_in, void* d_out, int out_size, void* d_ws, size_t ws_size, hipStream_t stream) {
    static int grid = 0;
    if (grid == 0) {
        if (n_in != 43 || out_size != NB * SEQ * DM || ws_size < WS_END) { fprintf(stderr, "kernel_launch: unexpected problem (n_in %d, out %d, ws %zu < %zu)\n", n_in, out_size, ws_size, (size_t)WS_END); grid = -1; return; }
        int dev = 0, cus = 0, per_cu = 0;
        if (hipGetDevice(&dev) != hipSuccess || hipDeviceGetAttribute(&cus, hipDeviceAttributeMultiprocessorCount, dev) != hipSuccess) { grid = -1; return; }
        if (hipFuncSetAttribute((const void*)hfb_fwd, hipFuncAttributeMaxDynamicSharedMemorySize, LDS_BYTES) != hipSuccess) { fprintf(stderr, "kernel_launch: hipFuncSetAttribute failed\n"); grid = -1; return; }
        if (hipOccupancyMaxActiveBlocksPerMultiprocessor(&per_cu, (const void*)hfb_fwd, 512, LDS_BYTES) != hipSuccess || per_cu < 1) { fprintf(stderr, "kernel_launch: occupancy query says %d\n", per_cu); }
        (void)hipGetLastError();
        grid = cus < 256 ? cus : 256;
        if (grid < 128) { grid = -1; return; }
    }
    if (grid < 0) return;
    (void)in_sizes;
    hipMemsetAsync((char*)d_ws + WS_CTL, 0, CTL_BYTES, stream);
    Args a{};
    for (int i = 0; i < 43; ++i) a.in[i] = (const float*)d_in[i];
    a.out = (float*)d_out; a.ws = (unsigned char*)d_ws;
#if MK_N_LAUNCHES == 1
    a.ph_lo = 0; a.ph_hi = NPHASE;
    hipLaunchKernelGGL(hfb_fwd, dim3(grid), dim3(512), LDS_BYTES, stream, a);
#else
    for (int p = 0; p < NPHASE; ++p) {
        const int l = (p - 1) / NPH_LAYER, k = (p - 1) % NPH_LAYER;
        if (p >= 1 && p < NPHASE - 1 && k == 10 && !(l & 1)) continue;
        a.ph_lo = p; a.ph_hi = p + 1;
        hipLaunchKernelGGL(hfb_fwd, dim3(grid), dim3(512), LDS_BYTES, stream, a);
    }
#endif
}
```
